# Optimizing an MI355X kernel written in HIP

```python
import jax, jax.numpy as jnp
from jax import lax
import numpy as np

D_MODEL = 1024
BATCH = 8
SEQ = 4096
DEPTH = 2

GLA_HEADS = 4
GLA_DK = 32
GLA_DV = 64
GLA_RANK = 16
GLA_GATE_NORM = 16.0
GLA_CHUNK = 64
RET_HEADS = 4
RET_DK = 64
RET_DV = 64
RET_CHUNK = 128
ROPE_BASE = 10000.0
SB_HEADS = 8
SB_DK = 64
SB_DV = 64
SB_BLOCK = 128
D_MIX = GLA_HEADS * GLA_DV + RET_HEADS * RET_DV + SB_HEADS * SB_DV
D_FF = -(-8 * D_MODEL // (3 * 256)) * 256
ADA_SCALE = 0.5
EPS = 1e-6

IN_SIZES = (GLA_HEADS * GLA_DK, GLA_HEADS * GLA_DK, GLA_HEADS * GLA_DV, GLA_HEADS * GLA_DV, GLA_RANK,
            RET_HEADS * RET_DK, RET_HEADS * RET_DK, RET_HEADS * RET_DV, RET_HEADS * RET_DV,
            SB_HEADS * SB_DK, SB_HEADS * SB_DK, SB_HEADS * SB_DV)
IN_COLS = sum(IN_SIZES)
SPLIT_POINTS = tuple(int(s) for s in np.cumsum(IN_SIZES)[:-1])

kernel_name = "hybrid_gla_retnet_stickbreak_adaln"


def rms_norm(x, g):
    xf = x.astype(jnp.float32)
    y = xf * lax.rsqrt(jnp.mean(xf * xf, axis=-1, keepdims=True) + EPS)
    return (y * g.astype(jnp.float32)).astype(x.dtype)


def gla_mixer(q, k, v, log_a):
    B, S, H, dk = q.shape
    dv = v.shape[-1]
    C = GLA_CHUNK
    N = S // C

    def to_chunks(t):
        return t.reshape(B, N, C, H, t.shape[-1]).transpose(1, 0, 3, 2, 4)

    qc, kc, vc, ac = (to_chunks(t) for t in (q * dk ** -0.5, k, v, log_a))
    causal = jnp.tril(jnp.ones((C, C), dtype=bool))[:, :, None]

    def step(state, inp):
        qi, ki, vi, ai = inp
        b = jnp.cumsum(ai, axis=2)
        diff = b[:, :, :, None, :] - b[:, :, None, :, :]
        decay = jnp.exp(jnp.where(causal, diff, -jnp.inf))
        scores = jnp.einsum('bhtd,bhsd,bhtsd->bhts', qi, ki, decay)
        o = (jnp.einsum('bhts,bhsv->bhtv', scores, vi)
             + jnp.einsum('bhtd,bhdv->bhtv', qi * jnp.exp(b), state))
        b_last = b[:, :, -1:, :]
        state = (jnp.exp(b_last[:, :, 0, :, None]) * state
                 + jnp.einsum('bhsd,bhsv->bhdv', ki * jnp.exp(b_last - b), vi))
        return state, o

    state0 = jnp.zeros((B, H, dk, dv), jnp.float32)
    _, o = lax.scan(step, state0, (qc, kc, vc, ac))
    return o.transpose(1, 0, 3, 2, 4).reshape(B, S, H, dv)


def rotary(t, pos):
    d = t.shape[-1]
    inv = ROPE_BASE ** (-jnp.arange(0, d, 2, dtype=jnp.float32) / d)
    ang = pos.astype(jnp.float32)[:, None] * inv[None, :]
    cos = jnp.cos(ang)[None, :, None, :]
    sin = jnp.sin(ang)[None, :, None, :]
    t1, t2 = t[..., 0::2], t[..., 1::2]
    return jnp.stack([t1 * cos - t2 * sin, t1 * sin + t2 * cos], axis=-1).reshape(t.shape)


def retention_mixer(q, k, v):
    B, S, H, dk = q.shape
    dv = v.shape[-1]
    C = RET_CHUNK
    N = S // C
    pos = jnp.arange(S)
    q = rotary(q, pos)
    k = rotary(k, pos) * dk ** -0.5
    log_g = jnp.log(1.0 - 2.0 ** (-5.0 - jnp.arange(H, dtype=jnp.float32)))

    def to_chunks(t):
        return t.reshape(B, N, C, H, t.shape[-1]).transpose(0, 3, 1, 2, 4)

    qc, kc, vc = to_chunks(q), to_chunks(k), to_chunks(v)
    idx = jnp.arange(C, dtype=jnp.float32)
    rel = idx[:, None] - idx[None, :]
    dmat = jnp.where(rel >= 0, jnp.exp(log_g[:, None, None] * jnp.maximum(rel, 0.0)), 0.0)
    scores = jnp.einsum('bhntd,bhnsd->bhnts', qc, kc) * dmat[None, :, None]
    o_intra = jnp.einsum('bhnts,bhnsv->bhntv', scores, vc)

    zeta = jnp.exp(log_g[:, None] * (C - 1.0 - idx)[None, :])
    kv = jnp.einsum('bhnsd,bhnsv->nbhdv', kc * zeta[None, :, None, :, None], vc)
    gamma_c = jnp.exp(log_g * C)[None, :, None, None]

    def step(r, kv_i):
        return gamma_c * r + kv_i, r

    _, r_prev = lax.scan(step, jnp.zeros((B, H, dk, dv), jnp.float32), kv)
    xi = jnp.exp(log_g[:, None] * (idx + 1.0)[None, :])
    o_inter = jnp.einsum('bhntd,nbhdv->bhntv', qc * xi[None, :, None, :, None], r_prev)
    o = o_intra + o_inter
    return o.transpose(0, 2, 3, 1, 4).reshape(B, S, H, dv)


def stick_breaking_mixer(q, k, v):
    B, S, H, d = q.shape
    T = SB_BLOCK
    q = q.transpose(0, 2, 1, 3) * d ** -0.5
    k = k.transpose(0, 2, 1, 3)
    v = v.transpose(0, 2, 1, 3)
    outs = []
    for i in range(S // T):
        end = (i + 1) * T
        qb, kb, vb = q[:, :, i * T:end], k[:, :, :end], v[:, :, :end]
        z = jnp.einsum('bhtd,bhsd->bhts', qb, kb)
        mask = jnp.arange(end)[None, :] < (i * T + jnp.arange(T))[:, None]
        log_1m = jnp.where(mask, jax.nn.log_sigmoid(-z), 0.0)
        log_a = jax.nn.log_sigmoid(z) + lax.cumsum(log_1m, axis=3, reverse=True) - log_1m
        attn = jnp.where(mask, jnp.exp(log_a), 0.0)
        outs.append(jnp.einsum('bhts,bhsv->bhtv', attn, vb))
    o = jnp.concatenate(outs, axis=2)
    return o.transpose(0, 2, 1, 3)


def hybrid_mixer(h, w_in, gla_wa2, gla_ba, gla_norm_g, ret_norm_g, w_out):
    B, S, _ = h.shape
    proj = jnp.einsum('bsd,de->bse', h, w_in).astype(jnp.float32)
    gq, gk, gv, gg, gr, rq, rk, rv, rg, sq, sk, sv = jnp.split(proj, SPLIT_POINTS, axis=-1)

    def heads(t, n):
        return t.reshape(B, S, n, -1)

    log_a = jax.nn.log_sigmoid(gr @ gla_wa2.astype(jnp.float32) + gla_ba.astype(jnp.float32)) / GLA_GATE_NORM
    o_gla = gla_mixer(heads(gq, GLA_HEADS), heads(gk, GLA_HEADS), heads(gv, GLA_HEADS), heads(log_a, GLA_HEADS))
    o_gla = rms_norm(o_gla, gla_norm_g).reshape(B, S, -1) * jax.nn.silu(gg)
    o_ret = retention_mixer(heads(rq, RET_HEADS), heads(rk, RET_HEADS), heads(rv, RET_HEADS))
    o_ret = rms_norm(o_ret, ret_norm_g).reshape(B, S, -1) * jax.nn.silu(rg)
    o_sb = stick_breaking_mixer(heads(sq, SB_HEADS), heads(sk, SB_HEADS), heads(sv, SB_HEADS)).reshape(B, S, -1)

    o = jnp.concatenate([o_gla, o_ret, o_sb], axis=-1).astype(h.dtype)
    return jnp.einsum('bse,ed->bsd', o, w_out)


def swiglu(h, wg, wu, wd):
    a = jnp.einsum('bsd,df->bsf', h, wg)
    b = jnp.einsum('bsd,df->bsf', h, wu)
    return jnp.einsum('bsf,fd->bsd', jax.nn.silu(a) * b, wd)


def setup_inputs(seed: int = 0) -> dict:
    key = jax.random.key(seed)
    ks = jax.random.split(key, 16)
    L, D = DEPTH, D_MODEL

    def nrm(k, shape, fan_in):
        return jax.random.normal(k, shape, jnp.float32) * fan_in ** -0.5

    def small(k, shape):
        return 0.02 * jax.random.normal(k, shape, jnp.float32)

    return {
        'x': jax.random.normal(ks[0], (BATCH, SEQ, D), jnp.float32),
        'c': jax.random.normal(ks[1], (BATCH, D), jnp.float32),
        'ada_w': nrm(ks[2], (L, D, 6 * D), D) * ADA_SCALE,
        'ada_b': small(ks[3], (L, 6 * D)),
        'norm1_g': 1.0 + small(ks[4], (L, D)),
        'norm2_g': 1.0 + small(ks[5], (L, D)),
        'w_in': nrm(ks[6], (L, D, IN_COLS), D),
        'gla_wa2': nrm(ks[7], (L, GLA_RANK, GLA_HEADS * GLA_DK), GLA_RANK),
        'gla_ba': small(ks[8], (L, GLA_HEADS * GLA_DK)),
        'gla_norm_g': 1.0 + small(ks[9], (L, GLA_DV)),
        'ret_norm_g': 1.0 + small(ks[10], (L, RET_DV)),
        'w_out': nrm(ks[11], (L, D_MIX, D), D_MIX),
        'ffn_wg': nrm(ks[12], (L, D, D_FF), D),
        'ffn_wu': nrm(ks[13], (L, D, D_FF), D),
        'ffn_wd': nrm(ks[14], (L, D_FF, D), D_FF),
        'final_g': 1.0 + small(ks[15], (D,)),
    }


def reference(x, c, ada_w, ada_b, norm1_g, norm2_g, w_in, gla_wa2, gla_ba, gla_norm_g,
              ret_norm_g, w_out, ffn_wg, ffn_wu, ffn_wd, final_g):
    cs = jax.nn.silu(c)
    for l in range(DEPTH):
        mod = cs @ ada_w[l] + ada_b[l]
        sh1, sc1, g1, sh2, sc2, g2 = (m[:, None, :] for m in jnp.split(mod, 6, axis=-1))
        h = rms_norm(x, norm1_g[l]) * (1.0 + sc1) + sh1
        x = x + g1 * hybrid_mixer(h, w_in[l], gla_wa2[l], gla_ba[l], gla_norm_g[l], ret_norm_g[l], w_out[l])
        h = rms_norm(x, norm2_g[l]) * (1.0 + sc2) + sh2
        x = x + g2 * swiglu(h, ffn_wg[l], ffn_wu[l], ffn_wd[l])
    return rms_norm(x, final_g)
```

```cpp
#include <hip/hip_runtime.h>
#include <cstdio>
#include <cstdint>
constexpr int NWAVES = 8;
constexpr int BATCH = 8, SEQ = 4096, DM = 1024, M = BATCH * SEQ, DEPTH = 2;
constexpr int NIN = 3584, NIN_SRC = 3344, DFF = 2816, NUP = 5632, MODLD = 6144;
constexpr float SB_THR = -110.0f;

constexpr size_t MiB = 1u << 20;
constexpr size_t WS_CTL = 0;
constexpr size_t WS_SS = 1 * MiB;
constexpr size_t WS_MOD = 2 * MiB;
constexpr size_t CTL_ZERO_BYTES = 3 * MiB;
constexpr size_t WS_CBIN = 3 * MiB;
constexpr size_t WS_CBUP = 3 * MiB + 512 * 1024;
constexpr size_t WS_ROT = 4 * MiB;
constexpr size_t WS_WIN = 8 * MiB;
constexpr size_t WS_WOUT = 22 * MiB;
constexpr size_t WS_WUP = 26 * MiB;
constexpr size_t WS_WDN = 48 * MiB;
constexpr size_t WS_XA = 64 * MiB;
constexpr size_t WS_OM = 128 * MiB;
constexpr size_t WS_GQ = 192 * MiB, WS_GK = 200 * MiB, WS_GV = 208 * MiB, WS_GG = 224 * MiB;
constexpr size_t WS_RQ = 240 * MiB, WS_RK = 256 * MiB, WS_RV = 272 * MiB, WS_RG = 288 * MiB;
constexpr size_t WS_SQ = 304 * MiB, WS_SK = 336 * MiB, WS_SV = 368 * MiB;
constexpr size_t WS_GR = 400 * MiB;
constexpr size_t WS_GA = 402 * MiB;
constexpr size_t WS_HB = 192 * MiB;
constexpr size_t WS_END = 418 * MiB;
constexpr int CW_BAR = 4096;

constexpr int RING_OFF = 0, RING_BYTES = 131072;
constexpr int LDSCTL_OFF = RING_BYTES, MISC_OFF = LDSCTL_OFF + 320;
constexpr int LDS_BYTES = 147456;

namespace pg8 {
#define PG8_LAS __attribute__((address_space(3)))
typedef unsigned short bf16_t;
typedef short bf16x8 __attribute__((ext_vector_type(8)));
typedef float f32x4 __attribute__((ext_vector_type(4)));
typedef unsigned u32x4 __attribute__((ext_vector_type(4)));
constexpr int BM = 256, BK = 64, HALF = 128, HTB = HALF * BK * 2  , STAGE_BYTES = 8 * HTB, NXCD = 8, WGM = 8;

__host__ __device__ __forceinline__ int lds_byte(int r, int c) { const int st = (r >> 4) * 2 + (c >> 5), rr = r & 15, cc = c & 31, ob = rr * 64 + cc * 2; return st * 1024 + (ob ^ (((ob >> 9) & 1) << 5)); }
__host__ __device__ __forceinline__ void stage_rc(int b, int& R, int& C) { const int st = b / 1024, sb = b % 1024, swz = sb ^ (((sb >> 9) & 1) << 5); R = (st >> 1) * 16 + swz / 64; C = (st & 1) * 32 + (swz % 64) / 2; }
__host__ __device__ __forceinline__ int perm32(int rho) { const int n = rho >> 4, i = rho & 15; return 8 * (i >> 2) + 4 * n + (i & 3); }

struct Unit { int pm, pn; };
struct Gemm { const bf16_t* A; const bf16_t* Bt; int M, N, K; };

struct StaticOrder {
    int nM, nN, nwg, G, c;
    __host__ __device__ void init(int M, int N, int G_, int c_) { nM = M / BM; nN = N / BM; nwg = nM * nN; G = G_; c = c_; }
    __host__ __device__ bool next(int i, Unit& u) const {
        const long L = (long)i * G + c; if (L >= nwg) return false;
        int wgid = (int)L; { const int q = nwg / NXCD, r = nwg % NXCD, xcd = wgid % NXCD, off = wgid / NXCD; wgid = (xcd < r ? xcd * (q + 1) : r * (q + 1) + (xcd - r) * q) + off; }
        const int nig = WGM * nN, gid = wgid / nig, fm = gid * WGM, gsz = (nM - fm) < WGM ? (nM - fm) : WGM;
        u.pm = fm + ((wgid % nig) % gsz); u.pn = (wgid % nig) / gsz; return true;
    }
    __device__ __forceinline__ void a_ready(const Unit&) const {}
    __device__ __forceinline__ void done(const Unit&) const {}
};

__device__ __forceinline__ unsigned cvt_pk_bf16(float lo, float hi) { unsigned r; asm volatile("v_cvt_pk_bf16_f32 %0, %1, %2" : "=v"(r) : "v"(lo), "v"(hi)); return r; }
constexpr int NIN = ::NIN, NUP = ::NUP, DFFC = ::DFF, DMC = ::DM, MODLD = ::MODLD;
__device__ __forceinline__ float silu_f(float a) { return a * __builtin_amdgcn_rcpf(1.0f + __expf(-a)); }
__device__ __forceinline__ u32x4 pack8(const f32x4 v0, const f32x4 v1) { u32x4 w; w.x = cvt_pk_bf16(v0[0], v0[1]); w.y = cvt_pk_bf16(v0[2], v0[3]); w.z = cvt_pk_bf16(v1[0], v1[1]); w.w = cvt_pk_bf16(v1[2], v1[3]); return w; }

struct EpiInProj {
    static constexpr bool PERM = true, AFTER_DRAIN = false;
    const float* ss; const float* cb; const float* rot; unsigned char* ws;
    __device__ __forceinline__ void operator()(const f32x4 (&acc)[2][2][4][2], const Unit& u, int wr, int wc, int fr, int fq) const {
        const int pn = u.pn, b = u.pm >> 4;
        const int row0 = u.pm * BM + wr * 64 + fr; const int cl = wc * 32 + 8 * fq;
        float rs[2][4];
#pragma unroll
        for (int ai = 0; ai < 2; ++ai)
#pragma unroll
            for (int m = 0; m < 4; ++m) rs[ai][m] = __builtin_amdgcn_rsqf(ss[row0 + ai * HALF + m * 16] * (1.0f / 1024.0f) + 1e-6f);
#pragma unroll
        for (int bj = 0; bj < 2; ++bj) {
            const float* cbp = cb + (size_t)b * NIN + pn * BM + bj * HALF + cl;
            const f32x4 c0 = *(const f32x4*)(cbp), c1 = *(const f32x4*)(cbp + 4);
            unsigned long long off; int ldl, colb = bj * HALF, kind = 0; float sc = 1.0f;
            if (pn == 0) { ldl = 7; colb = 0; if (bj == 0) { off = WS_GQ; sc = 0.17677669529663687f; } else { off = WS_GK; } }
            else if (pn == 1) { off = WS_GV; ldl = 8; }
            else if (pn == 2) { off = WS_GG; ldl = 8; }
            else if (pn == 3) { off = WS_RQ; ldl = 8; kind = 1; }
            else if (pn == 4) { off = WS_RK; ldl = 8; kind = 1; sc = 0.125f; }
            else if (pn == 5) { off = WS_RV; ldl = 8; }
            else if (pn == 6) { off = WS_RG; ldl = 8; }
            else if (pn <= 8) { off = WS_SQ; ldl = 9; colb += (pn - 7) * BM; sc = 0.125f; }
            else if (pn <= 10) { off = WS_SK; ldl = 9; colb += (pn - 9) * BM; }
            else if (pn <= 12) { off = WS_SV; ldl = 9; colb += (pn - 11) * BM; }
            else { off = WS_GR; ldl = 4; kind = 2; }
            off = ((unsigned long long)__builtin_amdgcn_readfirstlane((unsigned)(off >> 20))) << 20; ldl = __builtin_amdgcn_readfirstlane(ldl); colb = __builtin_amdgcn_readfirstlane(colb); kind = __builtin_amdgcn_readfirstlane(kind);
            asm volatile("" : "+s"(off), "+s"(ldl), "+s"(colb), "+s"(kind));
            unsigned char* dstb = ws + off;
            if (kind == 2) {
                if (bj == 0 && cl < 16) {
#pragma unroll
                    for (int ai = 0; ai < 2; ++ai)
#pragma unroll
                        for (int m = 0; m < 4; ++m) { const int row = row0 + ai * HALF + m * 16; const float r = rs[ai][m]; float* gp = (float*)dstb + (size_t)row * 16 + cl;
                            *(f32x4*)(gp) = acc[ai][bj][m][0] * r + c0; *(f32x4*)(gp + 4) = acc[ai][bj][m][1] * r + c1; }
                }
            } else {
                const int i0 = (cl & 63) >> 1;
#pragma unroll
                for (int ai = 0; ai < 2; ++ai)
#pragma unroll
                    for (int m = 0; m < 4; ++m) { const int row = row0 + ai * HALF + m * 16; const float r = rs[ai][m];
                        f32x4 v0 = acc[ai][bj][m][0] * r + c0, v1 = acc[ai][bj][m][1] * r + c1;
                        if (kind == 1) { const int pos = row & 4095; const f32x4 t0 = *(const f32x4*)(rot + ((size_t)pos * 32 + i0) * 2), t1 = *(const f32x4*)(rot + ((size_t)pos * 32 + i0 + 2) * 2);
                            const f32x4 w0 = {v0[0] * t0[0] - v0[1] * t0[1], v0[0] * t0[1] + v0[1] * t0[0], v0[2] * t0[2] - v0[3] * t0[3], v0[2] * t0[3] + v0[3] * t0[2]};
                            const f32x4 w1 = {v1[0] * t1[0] - v1[1] * t1[1], v1[0] * t1[1] + v1[1] * t1[0], v1[2] * t1[2] - v1[3] * t1[3], v1[2] * t1[3] + v1[3] * t1[2]};
                            v0 = w0; v1 = w1; }
                        v0 = v0 * sc; v1 = v1 * sc;
                        *(u32x4*)(dstb + ((((size_t)row << ldl) + (size_t)(colb + cl)) << 1)) = pack8(v0, v1); }
            }
        }
    }
};

struct EpiResid {
    static constexpr bool PERM = true, AFTER_DRAIN = false;
    const float* xin; float* xout; const float* gate;
    bf16_t* xa; const float* ng; const float* scn; float* ssn; int write_xa;
    __device__ __forceinline__ void operator()(const f32x4 (&acc)[2][2][4][2], const Unit& u, int wr, int wc, int fr, int fq) const {
        const int b = u.pm >> 4; const int row0 = u.pm * BM + wr * 64 + fr;
        f32x4 g[2][2], a[2][2];
#pragma unroll
        for (int bj = 0; bj < 2; ++bj) { const int col = u.pn * BM + bj * HALF + wc * 32 + 8 * fq;
#pragma unroll
            for (int n = 0; n < 2; ++n) { g[bj][n] = *(const f32x4*)(gate + (size_t)b * MODLD + col + 4 * n);
                if (write_xa) a[bj][n] = *(const f32x4*)(ng + col + 4 * n) * (*(const f32x4*)(scn + (size_t)b * MODLD + col + 4 * n) + 1.0f); else a[bj][n] = (f32x4){0.f, 0.f, 0.f, 0.f}; } }
#pragma unroll
        for (int ai = 0; ai < 2; ++ai)
#pragma unroll
            for (int m = 0; m < 4; ++m) { const int row = row0 + ai * HALF + m * 16; float sq = 0.f;
#pragma unroll
                for (int bj = 0; bj < 2; ++bj) { const size_t off = (size_t)row * DMC + u.pn * BM + bj * HALF + wc * 32 + 8 * fq;
                    const f32x4 x0 = *(const f32x4*)(xin + off), x1 = *(const f32x4*)(xin + off + 4);
                    const f32x4 y0 = x0 + g[bj][0] * acc[ai][bj][m][0], y1 = x1 + g[bj][1] * acc[ai][bj][m][1];
                    *(f32x4*)(xout + off) = y0; *(f32x4*)(xout + off + 4) = y1;
                    sq += (y0[0] * y0[0] + y0[1] * y0[1]) + (y0[2] * y0[2] + y0[3] * y0[3]) + (y1[0] * y1[0] + y1[1] * y1[1]) + (y1[2] * y1[2] + y1[3] * y1[3]);
                    if (write_xa) *(u32x4*)(xa + off) = pack8(y0 * a[bj][0], y1 * a[bj][1]); }
                sq += __shfl_xor(sq, 16); sq += __shfl_xor(sq, 32);
                if (fq == 0) __hip_atomic_fetch_add(ssn + row, sq, __ATOMIC_RELAXED, __HIP_MEMORY_SCOPE_AGENT); }
    }
};

struct EpiFfnUp {
    static constexpr bool PERM = true, AFTER_DRAIN = false;
    const float* ss; const float* cb; bf16_t* hb;
    __device__ __forceinline__ void operator()(const f32x4 (&acc)[2][2][4][2], const Unit& u, int wr, int wc, int fr, int fq) const {
        const int b = u.pm >> 4; const int row0 = u.pm * BM + wr * 64 + fr; const int cw = wc * 32 + 8 * fq;
        const float* cbp = cb + (size_t)b * NUP + u.pn * BM + cw;
        const f32x4 cg0 = *(const f32x4*)(cbp), cg1 = *(const f32x4*)(cbp + 4), cu0 = *(const f32x4*)(cbp + HALF), cu1 = *(const f32x4*)(cbp + HALF + 4);
#pragma unroll
        for (int ai = 0; ai < 2; ++ai)
#pragma unroll
            for (int m = 0; m < 4; ++m) { const int row = row0 + ai * HALF + m * 16;
                const float r = __builtin_amdgcn_rsqf(ss[row] * (1.0f / 1024.0f) + 1e-6f);
                const f32x4 g0 = acc[ai][0][m][0] * r + cg0, g1 = acc[ai][0][m][1] * r + cg1, u0 = acc[ai][1][m][0] * r + cu0, u1 = acc[ai][1][m][1] * r + cu1;
                f32x4 h0, h1;
#pragma unroll
                for (int e = 0; e < 4; ++e) { h0[e] = silu_f(g0[e]) * u0[e]; h1[e] = silu_f(g1[e]) * u1[e]; }
                *(u32x4*)(hb + (size_t)row * DFFC + u.pn * HALF + cw) = pack8(h0, h1); }
    }
};
template <class Epi, class Sched, bool ALIGN_EPI = false, bool SP2 = false>
__device__ __forceinline__ void gemm_phase(PG8_LAS unsigned char* lds, const Gemm g, const Sched& S, const Epi& E) {
    int tid = threadIdx.x; asm volatile("" : "+v"(tid));
    const int wid = __builtin_amdgcn_readfirstlane(tid >> 6), lane = tid & 63, wr = wid >> 2, wc = wid & 3, fr = lane & 15, fq = lane >> 4;
    const int K = g.K, nt = K / BK;
    unsigned voffA[2], voffB[2];
#pragma unroll
    for (int i = 0; i < 2; ++i) { int R, C; stage_rc(tid * 16 + i * 8192, R, C); const int Rb = Epi::PERM ? ((R & ~31) + perm32(R & 31)) : R;
        voffA[i] = (unsigned)(R * K + C) * 2u; voffB[i] = (unsigned)(Rb * K + C) * 2u; }
    const size_t kstep = (size_t)(BK * 2);
    const size_t hstep = (size_t)HALF * K * 2;
    const size_t tstep = 2 * hstep;
    const unsigned ldsw = (unsigned)wid * 1024u;
    const int aoff = lds_byte(wr * 64 + fr, fq * 8), boff = lds_byte(wc * 32 + fr, fq * 8);
#define PG8_SA(b, h) (((b) * 2 + (h)) * HTB)
#define PG8_SB(b, h) ((4 + (b) * 2 + (h)) * HTB)
#define PG8_STAGE(bufoff, gbase, voff) do { _Pragma("unroll") for (int _i = 0; _i < 2; ++_i) \
        __builtin_amdgcn_global_load_lds((const unsigned*)((const char*)(gbase) + (voff)[_i]), (PG8_LAS unsigned*)(lds + (bufoff) + ldsw + _i * 8192), 16, 0, 0); } while (0)
#define PG8_LDA(dst, b, h) do { _Pragma("unroll") for (int m = 0; m < 4; ++m) _Pragma("unroll") for (int k = 0; k < 2; ++k) dst[m][k] = *(const PG8_LAS bf16x8*)(lds + PG8_SA(b, h) + aoff + m * 2048 + k * 1024); } while (0)
#define PG8_LDB(dst, b, h) do { _Pragma("unroll") for (int n = 0; n < 2; ++n) _Pragma("unroll") for (int k = 0; k < 2; ++k) dst[n][k] = *(const PG8_LAS bf16x8*)(lds + PG8_SB(b, h) + boff + n * 2048 + k * 1024); } while (0)
#define PG8_MMA(ai, bj, At, Bt) do { __builtin_amdgcn_s_setprio(1); _Pragma("unroll") for (int m = 0; m < 4; ++m) _Pragma("unroll") for (int n = 0; n < 2; ++n) _Pragma("unroll") for (int k = 0; k < 2; ++k) \
        acc[ai][bj][m][n] = __builtin_amdgcn_mfma_f32_16x16x32_bf16(Bt[n][k], At[m][k], acc[ai][bj][m][n], 0, 0, 0); __builtin_amdgcn_s_setprio(0); } while (0)
#define PG8_WAIT_V(n) asm volatile("s_waitcnt vmcnt(" #n ")" ::: "memory")
#define PG8_WAIT_L(n) asm volatile("s_waitcnt lgkmcnt(" #n ")" ::: "memory")
#define PG8_BAR __builtin_amdgcn_s_barrier()
#define PG8_SCHED __builtin_amdgcn_sched_barrier(0)
    Unit cur, nxt; int ui = 0;
    if (!S.next(0, cur)) return;
    f32x4 acc[2][2][4][2];
#pragma unroll
    for (int a = 0; a < 2; ++a)
#pragma unroll
        for (int b = 0; b < 2; ++b)
#pragma unroll
            for (int m = 0; m < 4; ++m)
#pragma unroll
                for (int n = 0; n < 2; ++n) acc[a][b][m][n] = (f32x4){0.f, 0.f, 0.f, 0.f};
    bf16x8 At[4][2], B0[2][2], B1[2][2];
    const char* cA = (const char*)g.A + (size_t)cur.pm * tstep; const char* cB = (const char*)g.Bt + (size_t)cur.pn * tstep;
    S.a_ready(cur);
    if constexpr (SP2) {
        PG8_STAGE(PG8_SB(0, 0), cB, voffB); PG8_STAGE(PG8_SB(0, 1), cB + hstep, voffB); PG8_STAGE(PG8_SA(0, 0), cA, voffA); PG8_STAGE(PG8_SA(0, 1), cA + hstep, voffA);
        if (wr == 1) PG8_BAR;
        PG8_WAIT_V(2); PG8_BAR;
        PG8_STAGE(PG8_SB(1, 0), cB + kstep, voffB); PG8_STAGE(PG8_SA(1, 0), cA + kstep, voffA); PG8_STAGE(PG8_SB(1, 1), cB + hstep + kstep, voffB);
        PG8_WAIT_V(6); PG8_BAR;
    } else {
        PG8_STAGE(PG8_SB(0, 0), cB, voffB); PG8_STAGE(PG8_SA(0, 0), cA, voffA); PG8_STAGE(PG8_SB(0, 1), cB + hstep, voffB); PG8_STAGE(PG8_SA(0, 1), cA + hstep, voffA);
        if (wr == 1) PG8_BAR;
        PG8_WAIT_V(4); PG8_BAR;
        PG8_STAGE(PG8_SB(1, 0), cB + kstep, voffB); PG8_STAGE(PG8_SA(1, 0), cA + kstep, voffA); PG8_STAGE(PG8_SB(1, 1), cB + hstep + kstep, voffB);
        PG8_WAIT_V(6); PG8_BAR;
    }
    for (;;) {
        const bool has_next = S.next(ui + 1, nxt);
        const char* nA = has_next ? (const char*)g.A + (size_t)nxt.pm * tstep : cA; const char* nB = has_next ? (const char*)g.Bt + (size_t)nxt.pn * tstep : cB;
        for (int t = 0; t < nt; t += 2) {
            const bool last = (t == nt - 2);
            const char* a1 = cA + (size_t)(t + 1) * kstep;
            const char* a2 = last ? nA : cA + (size_t)(t + 2) * kstep; const char* b2 = last ? nB : cB + (size_t)(t + 2) * kstep;
            const char* a3 = a2 + kstep; const char* b3 = b2 + kstep;
            if (last && has_next) S.a_ready(nxt);
            if constexpr (SP2) {
            PG8_LDB(B0, 0, 0); PG8_LDB(B1, 0, 1); PG8_SCHED; PG8_LDA(At, 0, 0); PG8_STAGE(PG8_SA(1, 1), a1 + hstep, voffA);
            PG8_WAIT_V(8); PG8_WAIT_L(0); PG8_BAR; PG8_MMA(0, 0, At, B0); PG8_MMA(0, 1, At, B1); PG8_BAR; PG8_SCHED;
            PG8_LDA(At, 0, 1); PG8_STAGE(PG8_SB(0, 0), b2, voffB); PG8_STAGE(PG8_SB(0, 1), b2 + hstep, voffB); PG8_STAGE(PG8_SA(0, 0), a2, voffA);
            PG8_WAIT_V(8); PG8_WAIT_L(0); PG8_BAR; PG8_MMA(1, 0, At, B0); PG8_MMA(1, 1, At, B1); PG8_BAR; PG8_SCHED;
            PG8_LDB(B0, 1, 0); PG8_LDB(B1, 1, 1); PG8_SCHED; PG8_LDA(At, 1, 0); PG8_STAGE(PG8_SA(0, 1), a2 + hstep, voffA);
            PG8_WAIT_V(8); PG8_WAIT_L(0); PG8_BAR; PG8_MMA(0, 0, At, B0); PG8_MMA(0, 1, At, B1); PG8_BAR; PG8_SCHED;
            PG8_LDA(At, 1, 1); PG8_STAGE(PG8_SB(1, 0), b3, voffB); PG8_STAGE(PG8_SB(1, 1), b3 + hstep, voffB); PG8_STAGE(PG8_SA(1, 0), a3, voffA);
            PG8_WAIT_V(8); PG8_WAIT_L(0); PG8_BAR; PG8_MMA(1, 0, At, B0); PG8_MMA(1, 1, At, B1); PG8_BAR; PG8_SCHED;
            } else {
            PG8_LDB(B0, 0, 0); PG8_SCHED; PG8_LDA(At, 0, 0); PG8_STAGE(PG8_SA(1, 1), a1 + hstep, voffA);
            PG8_WAIT_L(8); PG8_BAR; PG8_WAIT_L(0); PG8_MMA(0, 0, At, B0); PG8_BAR; PG8_SCHED;
            PG8_LDB(B1, 0, 1); PG8_STAGE(PG8_SB(0, 0), b2, voffB);
            PG8_BAR; PG8_WAIT_L(0); PG8_MMA(0, 1, At, B1); PG8_BAR;
            PG8_LDA(At, 0, 1); PG8_STAGE(PG8_SA(0, 0), a2, voffA);
            PG8_BAR; PG8_WAIT_L(0); PG8_MMA(1, 0, At, B0); PG8_BAR; PG8_SCHED;
            PG8_STAGE(PG8_SB(0, 1), b2 + hstep, voffB);
            PG8_WAIT_V(6); PG8_BAR; PG8_MMA(1, 1, At, B1); PG8_BAR;
            PG8_LDB(B0, 1, 0); PG8_SCHED; PG8_LDA(At, 1, 0); PG8_STAGE(PG8_SA(0, 1), a2 + hstep, voffA);
            PG8_WAIT_L(8); PG8_BAR; PG8_WAIT_L(0); PG8_MMA(0, 0, At, B0); PG8_BAR; PG8_SCHED;
            PG8_LDB(B1, 1, 1); PG8_STAGE(PG8_SB(1, 0), b3, voffB);
            PG8_BAR; PG8_WAIT_L(0); PG8_MMA(0, 1, At, B1); PG8_BAR;
            PG8_LDA(At, 1, 1); PG8_STAGE(PG8_SA(1, 0), a3, voffA);
            PG8_BAR; PG8_WAIT_L(0); PG8_MMA(1, 0, At, B0); PG8_BAR; PG8_SCHED;
            PG8_STAGE(PG8_SB(1, 1), b3 + hstep, voffB);
            PG8_WAIT_V(6); PG8_BAR; PG8_MMA(1, 1, At, B1); PG8_BAR;
            }
        }
        if constexpr (ALIGN_EPI) { if (wr == 0) PG8_BAR; }
        if constexpr (!Epi::AFTER_DRAIN) { E(acc, cur, wr, wc, fr, fq); S.done(cur); }
        if (!has_next) break;
#pragma unroll
        for (int a = 0; a < 2; ++a)
#pragma unroll
            for (int b = 0; b < 2; ++b)
#pragma unroll
                for (int m = 0; m < 4; ++m)
#pragma unroll
                    for (int n = 0; n < 2; ++n) acc[a][b][m][n] = (f32x4){0.f, 0.f, 0.f, 0.f};
        cur = nxt; cA = nA; cB = nB; ++ui;
        if constexpr (ALIGN_EPI) { if (wr == 1) PG8_BAR; }
    }
    PG8_WAIT_V(0);
    if constexpr (!ALIGN_EPI) { if (wr == 0) PG8_BAR; }
    PG8_BAR;
    if constexpr (Epi::AFTER_DRAIN) { E.fused(acc, cur, wr, wc, fr, fq, lds, wid, lane); S.done(cur); }
#undef PG8_SA
#undef PG8_SB
#undef PG8_STAGE
#undef PG8_LDA
#undef PG8_LDB
#undef PG8_MMA
#undef PG8_WAIT_V
#undef PG8_WAIT_L
#undef PG8_BAR
#undef PG8_SCHED
}
}
#define GAS __attribute__((address_space(1)))
#define LAS __attribute__((address_space(3)))
typedef unsigned short bf16;
typedef unsigned v4u __attribute__((ext_vector_type(4)));
typedef float f32x4 __attribute__((ext_vector_type(4)));
typedef short bf16x8 __attribute__((ext_vector_type(8)));
typedef GAS unsigned gu32;
typedef GAS unsigned long long gu64;
#define RLX_AGENT __ATOMIC_RELAXED, __HIP_MEMORY_SCOPE_AGENT
#define LDS_WAIT() asm volatile("s_waitcnt lgkmcnt(0)" ::: "memory")
#define VM_WAIT() asm volatile("s_waitcnt vmcnt(0)" ::: "memory")
__device__ __forceinline__ unsigned long long rt() { return __builtin_amdgcn_s_memrealtime(); }
__device__ __forceinline__ unsigned f2bf(float f) { unsigned u = __builtin_bit_cast(unsigned, f); return (u + 0x7fffu + ((u >> 16) & 1u)) >> 16; }
__device__ __forceinline__ unsigned pk2(float lo, float hi) { return f2bf(lo) | (f2bf(hi) << 16); }
#define XB_TMO      128
#define XB_XCNT(j)  (256  + 64 * (j))
#define XB_XSUB(j)  (1280 + 64 * (j))
#define XB_XGEN(j)  (2304 + 64 * (j))
#define XB_TOP      3328
#define XB_TOPGEN   3392
#define XCD_BAR_WORDS 3456
#define XB_SPIN_CAP (1u << 18)

__device__ __forceinline__ unsigned xb_ld(unsigned* p)              { return __hip_atomic_load(p, __ATOMIC_RELAXED, __HIP_MEMORY_SCOPE_AGENT); }
__device__ __forceinline__ unsigned xb_add(unsigned* p, unsigned v) { return __hip_atomic_fetch_add(p, v, __ATOMIC_RELAXED, __HIP_MEMORY_SCOPE_AGENT); }
__device__ __forceinline__ unsigned xb_xcc_id() { return (unsigned)__builtin_amdgcn_s_getreg((3 << 11) | 20) & 0xFu; }
#define XB_SPIN(cond, bar) do { unsigned _sp = 0; while (cond) { __builtin_amdgcn_s_sleep(1); \
    if ((++_sp & 255u) == 0u) { if (xb_ld(&(bar)[XB_TMO])) break; if (_sp > XB_SPIN_CAP) { atomicAdd(&(bar)[XB_TMO], 1u); break; } } } } while (0)

struct XcdBarrier {
    unsigned* bar; unsigned x;
    volatile LAS unsigned* st;
};

__device__ __forceinline__ XcdBarrier xcd_barrier_post(unsigned* bar, volatile LAS unsigned* st) {
    XcdBarrier b; b.bar = bar; b.x = xb_xcc_id(); b.st = st;
    if (threadIdx.x == 0) (void)xb_add(&bar[XB_XCNT(b.x)], 1u);
    return b;
}
__device__ __forceinline__ void xcd_barrier_complete(unsigned* bar, unsigned x, unsigned& nloc, unsigned& nx) {
    const unsigned G = gridDim.x * gridDim.y * gridDim.z;
    unsigned sum, cnt, mine, sp = 0u;
    for (;;) {
        sum = 0u; cnt = 0u; mine = 0u;
#pragma unroll
        for (unsigned j = 0; j < 16; ++j) { const unsigned c = xb_ld(&bar[XB_XCNT(j)]); sum += c; cnt += (c > 0u) ? 1u : 0u; mine = (j == x) ? c : mine; }
        if (sum == G) break;
        __builtin_amdgcn_s_sleep(1);
        if ((++sp & 255u) == 0u) { if (xb_ld(&bar[XB_TMO])) break; if (sp > XB_SPIN_CAP) { atomicAdd(&bar[XB_TMO], 1u); break; } }
    }
    nloc = mine > 0u ? mine : 1u; nx = cnt > 0u ? cnt : 1u;
}

__device__ __forceinline__ void xcd_barrier(const XcdBarrier& b) {
    asm volatile("s_waitcnt vmcnt(0)" ::: "memory");
    __syncthreads();
    if (threadIdx.x == 0) {
        unsigned* bar = b.bar;
        __builtin_amdgcn_s_waitcnt(0);
        unsigned nloc = b.st[0], nx = b.st[1];
        if (nloc == 0u) { xcd_barrier_complete(bar, b.x, nloc, nx); b.st[0] = nloc; b.st[1] = nx; }
        const unsigned old = xb_add(&bar[XB_XSUB(b.x)], 1u);
        const unsigned gen = old / nloc;
        if (old + 1u == (gen + 1u) * nloc) {
            __builtin_amdgcn_fence(__ATOMIC_RELEASE, "agent");
            asm volatile("s_waitcnt vmcnt(0)" ::: "memory");
            const unsigned og = xb_add(&bar[XB_TOP], 1u);
            const unsigned tg = og / nx;
            if (og + 1u == (tg + 1u) * nx) xb_add(&bar[XB_TOPGEN], 1u);
            else XB_SPIN(xb_ld(&bar[XB_TOPGEN]) == tg, bar);
            __builtin_amdgcn_fence(__ATOMIC_ACQUIRE, "agent");
            xb_add(&bar[XB_XGEN(b.x)], 1u);
            asm volatile("s_waitcnt vmcnt(0)" ::: "memory");
        } else {
            XB_SPIN(xb_ld(&bar[XB_XGEN(b.x)]) == gen, bar);
            __builtin_amdgcn_fence(__ATOMIC_ACQUIRE, "agent");
            asm volatile("s_waitcnt vmcnt(0)" ::: "memory");
        }
    }
    __syncthreads();
}
__device__ __forceinline__ float bf2f(unsigned short h) { return __uint_as_float((unsigned)h << 16); }
__device__ __forceinline__ float wave_sum(float v) {
#pragma unroll
    for (int o = 1; o < 64; o <<= 1) v += __shfl_xor(v, o);
    return v;
}
__device__ __forceinline__ float rdl(float v, int l) { return __int_as_float(__builtin_amdgcn_readlane(__float_as_int(v), l)); }

__device__ __forceinline__ void tr_item(const float* W, int ldw, int k0, int srccol0, int nvalid, bf16* WT, int K, int dstrow0, LAS float* scr, int lane) {
#pragma unroll 8
    for (int i = 0; i < 32; ++i) { const int kk = 2 * i + (lane >> 5), c = lane & 31; scr[kk * 33 + c] = (c < nvalid) ? W[(size_t)(k0 + kk) * ldw + srccol0 + c] : 0.0f; }
    LDS_WAIT(); asm volatile("" ::: "memory");
    const int c = lane & 7;
#pragma unroll
    for (int j = 0; j < 4; ++j) { const int n = (lane >> 3) + 8 * j; const LAS float* s = scr + (8 * c) * 33 + n;
        v4u o; o.x = pk2(s[0 * 33], s[1 * 33]); o.y = pk2(s[2 * 33], s[3 * 33]); o.z = pk2(s[4 * 33], s[5 * 33]); o.w = pk2(s[6 * 33], s[7 * 33]);
        *(GAS v4u*)(WT + (size_t)(dstrow0 + n) * K + k0 + 8 * c) = o; }
    LDS_WAIT(); asm volatile("" ::: "memory");
}

struct Ptrs {
    const float *x, *c, *ada_w, *ada_b, *norm1_g, *norm2_g, *w_in, *gla_wa2, *gla_ba, *gla_norm_g, *ret_norm_g, *w_out, *ffn_wg, *ffn_wu, *ffn_wd, *final_g;
    float* out; unsigned char* ws;
};

__device__ __forceinline__ void sincos_acc(float angf, float& s, float& c) {
    const double x = (double)angf;
    const double kq = __builtin_rint(x * 0.63661977236758134308);
    const double r = (x - kq * 1.57079632679489655800e+00) - kq * 6.12323399573676603587e-17;
    const double r2 = r * r;
    double sp = -1.0 / 1307674368000.0; sp = sp * r2 + 1.0 / 6227020800.0; sp = sp * r2 - 1.0 / 39916800.0; sp = sp * r2 + 1.0 / 362880.0; sp = sp * r2 - 1.0 / 5040.0; sp = sp * r2 + 1.0 / 120.0; sp = sp * r2 - 1.0 / 6.0; sp = sp * r2 + 1.0; sp *= r;
    double cp = 1.0 / 20922789888000.0; cp = cp * r2 - 1.0 / 87178291200.0; cp = cp * r2 + 1.0 / 479001600.0; cp = cp * r2 - 1.0 / 3628800.0; cp = cp * r2 + 1.0 / 40320.0; cp = cp * r2 - 1.0 / 720.0; cp = cp * r2 + 1.0 / 24.0; cp = cp * r2 - 0.5; cp = cp * r2 + 1.0;
    const int q = (int)kq & 3;
    const double sv = (q == 0) ? sp : (q == 1) ? cp : (q == 2) ? -sp : -cp;
    const double cv = (q == 0) ? cp : (q == 1) ? -sp : (q == 2) ? -cp : sp;
    s = (float)sv; c = (float)cv;
}

template <int DK, bool GLA>
__device__ __forceinline__ void seq_recurrent_v0(const bf16* Qp, const bf16* Kp, const bf16* Vp, const bf16* Gp, const float* GAp, const float* ng, bf16* OMp, int b, int h, int lane, int om_off) {
    float S[DK];
#pragma unroll
    for (int d = 0; d < DK; ++d) S[d] = 0.f;
    const float gam = GLA ? 0.f : (1.0f - exp2f(-5.0f - (float)h));
    const float ngv = ng[lane];
    const int dl = lane & (DK - 1);
    constexpr int LQK = DK * 4;
    size_t row = (size_t)b * SEQ;
    float qv = bf2f(Qp[row * LQK + h * DK + dl]), kv = bf2f(Kp[row * LQK + h * DK + dl]), av = GLA ? GAp[row * 128 + h * 32 + dl] : 0.f;
    float vv = bf2f(Vp[row * 256 + h * 64 + lane]), gv = bf2f(Gp[row * 256 + h * 64 + lane]);
    for (int t = 0; t < SEQ; ++t) {
        const size_t rn = (size_t)b * SEQ + (t + 1 < SEQ ? t + 1 : t);
        const float qn = bf2f(Qp[rn * LQK + h * DK + dl]), kn = bf2f(Kp[rn * LQK + h * DK + dl]), an = GLA ? GAp[rn * 128 + h * 32 + dl] : 0.f;
        const float vn = bf2f(Vp[rn * 256 + h * 64 + lane]), gn = bf2f(Gp[rn * 256 + h * 64 + lane]);
        float o = 0.f;
#pragma unroll
        for (int d = 0; d < DK; ++d) { const float kd = rdl(kv, d), qd = rdl(qv, d);
            if (GLA) { const float ad = rdl(av, d); S[d] = fmaf(kd, vv, ad * S[d]); } else { S[d] = fmaf(kd, vv, gam * S[d]); }
            o = fmaf(qd, S[d], o); }
        const float ms = wave_sum(o * o) * (1.0f / 64.0f);
        const float y = o * __builtin_amdgcn_rsqf(ms + 1e-6f) * ngv * (gv / (1.0f + __expf(-gv)));
        OMp[((size_t)b * SEQ + t) * DM + om_off + h * 64 + lane] = (bf16)f2bf(y);
        qv = qn; kv = kn; av = an; vv = vn; gv = gn;
    }
}

__device__ __forceinline__ void sb_unit_v0(const bf16* SQ, const bf16* SK, const bf16* SV, bf16* OM, int unit, int lane) {
    const int bh = unit >> 6, qb = unit & 63, b = bh >> 3, h = bh & 7;
    const int t = qb * 64 + lane; const size_t row = (size_t)b * SEQ + t;
    float q[64], o[64];
    { const v4u* qp = (const v4u*)(SQ + row * 512 + h * 64);
#pragma unroll
      for (int i = 0; i < 8; ++i) { const v4u w = qp[i];
          q[8 * i + 0] = __uint_as_float(w.x << 16); q[8 * i + 1] = __uint_as_float(w.x & 0xffff0000u); q[8 * i + 2] = __uint_as_float(w.y << 16); q[8 * i + 3] = __uint_as_float(w.y & 0xffff0000u);
          q[8 * i + 4] = __uint_as_float(w.z << 16); q[8 * i + 5] = __uint_as_float(w.z & 0xffff0000u); q[8 * i + 6] = __uint_as_float(w.w << 16); q[8 * i + 7] = __uint_as_float(w.w & 0xffff0000u); } }
#pragma unroll
    for (int i = 0; i < 64; ++i) o[i] = 0.f;
    float R = 0.f;
    for (int j = 1; j <= SEQ; ++j) {
        const bool act = (t - j >= 0) && (R > SB_THR);
        if (!__any(act)) break;
        if (act) {
            const v4u* kp = (const v4u*)(SK + (row - j) * 512 + h * 64);
            float z = 0.f;
#pragma unroll
            for (int i = 0; i < 8; ++i) { const v4u w = kp[i];
                z = fmaf(q[8 * i + 0], __uint_as_float(w.x << 16), z); z = fmaf(q[8 * i + 1], __uint_as_float(w.x & 0xffff0000u), z); z = fmaf(q[8 * i + 2], __uint_as_float(w.y << 16), z); z = fmaf(q[8 * i + 3], __uint_as_float(w.y & 0xffff0000u), z);
                z = fmaf(q[8 * i + 4], __uint_as_float(w.z << 16), z); z = fmaf(q[8 * i + 5], __uint_as_float(w.z & 0xffff0000u), z); z = fmaf(q[8 * i + 6], __uint_as_float(w.w << 16), z); z = fmaf(q[8 * i + 7], __uint_as_float(w.w & 0xffff0000u), z); }
            const float e = __expf(-fabsf(z)), l1p = __logf(1.0f + e);
            const float lsz = fminf(z, 0.f) - l1p, l1m = fminf(-z, 0.f) - l1p;
            const float w = __expf(lsz + R);
            const v4u* vp = (const v4u*)(SV + (row - j) * 512 + h * 64);
#pragma unroll
            for (int i = 0; i < 8; ++i) { const v4u x = vp[i];
                o[8 * i + 0] = fmaf(w, __uint_as_float(x.x << 16), o[8 * i + 0]); o[8 * i + 1] = fmaf(w, __uint_as_float(x.x & 0xffff0000u), o[8 * i + 1]); o[8 * i + 2] = fmaf(w, __uint_as_float(x.y << 16), o[8 * i + 2]); o[8 * i + 3] = fmaf(w, __uint_as_float(x.y & 0xffff0000u), o[8 * i + 3]);
                o[8 * i + 4] = fmaf(w, __uint_as_float(x.z << 16), o[8 * i + 4]); o[8 * i + 5] = fmaf(w, __uint_as_float(x.z & 0xffff0000u), o[8 * i + 5]); o[8 * i + 6] = fmaf(w, __uint_as_float(x.w << 16), o[8 * i + 6]); o[8 * i + 7] = fmaf(w, __uint_as_float(x.w & 0xffff0000u), o[8 * i + 7]); }
            R += l1m;
        }
    }
    v4u* op = (v4u*)(OM + row * DM + 512 + h * 64);
#pragma unroll
    for (int i = 0; i < 8; ++i) { v4u w; w.x = pk2(o[8 * i + 0], o[8 * i + 1]); w.y = pk2(o[8 * i + 2], o[8 * i + 3]); w.z = pk2(o[8 * i + 4], o[8 * i + 5]); w.w = pk2(o[8 * i + 6], o[8 * i + 7]); op[i] = w; }
}

struct Args { const float* in[16]; float* out; unsigned char* ws; int ph_lo, ph_hi; };
__global__ void __launch_bounds__(NWAVES * 64, 2) mk_fwd(Args args) {
    extern __shared__ __attribute__((aligned(16))) unsigned char lds_raw[];
    LAS unsigned char* lds = (LAS unsigned char*)lds_raw;
    volatile LAS unsigned* MISC = (volatile LAS unsigned*)(lds + MISC_OFF);
    const int tid_k = threadIdx.x;
    const int G = gridDim.x; const int bx = blockIdx.x; const int NGW = G * NWAVES;
    typedef __attribute__((address_space(4))) const unsigned long long kargw_t;
    const kargw_t* kargs = (const kargw_t*)__builtin_amdgcn_kernarg_segment_ptr();
#define PH_BEGIN() const kargw_t* kq_ = kargs; asm volatile("" : "+s"(kq_)); int tid = tid_k; asm volatile("" : "+v"(tid)); const int lane = tid & 63, wave = __builtin_amdgcn_readfirstlane(tid >> 6); \
    const int vcu = (G % 8 == 0) ? (bx % 8) * (G / 8) + bx / 8 : bx; const int gw = vcu * NWAVES + wave; (void)lane; (void)wave; (void)vcu; (void)gw; \
    unsigned char* ws = (unsigned char*)(GAS unsigned char*)kq_[17]; float* out = (float*)(GAS float*)kq_[16]; (void)out; \
    gu32* ctl = (gu32*)(ws + WS_CTL); (void)ctl; float* SS = (float*)(ws + WS_SS); float* MOD = (float*)(ws + WS_MOD); float* CBIN = (float*)(ws + WS_CBIN); float* CBUP = (float*)(ws + WS_CBUP); float* ROT = (float*)(ws + WS_ROT); \
    bf16 *WIN = (bf16*)(ws + WS_WIN), *WOUT = (bf16*)(ws + WS_WOUT), *WUP = (bf16*)(ws + WS_WUP), *WDN = (bf16*)(ws + WS_WDN); \
    bf16 *XA = (bf16*)(ws + WS_XA), *OM = (bf16*)(ws + WS_OM), *HB = (bf16*)(ws + WS_HB); \
    bf16 *GQ = (bf16*)(ws + WS_GQ), *GK = (bf16*)(ws + WS_GK), *GV = (bf16*)(ws + WS_GV), *GG = (bf16*)(ws + WS_GG), *RQ = (bf16*)(ws + WS_RQ), *RK = (bf16*)(ws + WS_RK), *RV = (bf16*)(ws + WS_RV), *RG = (bf16*)(ws + WS_RG), \
         *SQ = (bf16*)(ws + WS_SQ), *SK = (bf16*)(ws + WS_SK), *SV = (bf16*)(ws + WS_SV); \
    float *GR = (float*)(ws + WS_GR), *GA = (float*)(ws + WS_GA); \
    (void)SS; (void)MOD; (void)CBIN; (void)CBUP; (void)ROT; (void)WIN; (void)WOUT; (void)WUP; (void)WDN; (void)XA; (void)OM; (void)HB; (void)GQ; (void)GK; (void)GV; (void)GG; (void)RQ; (void)RK; (void)RV; (void)RG; (void)SQ; (void)SK; (void)SV; (void)GR; (void)GA;
#define IN_PTR(i) ((const float*)(const GAS float*)kq_[i])
    for (int u = tid_k; u < (LDS_BYTES - LDSCTL_OFF) / 4; u += NWAVES * 64) ((LAS unsigned*)(lds + LDSCTL_OFF))[u] = 0u;
    __syncthreads();
    XcdBarrier bar; { PH_BEGIN(); bar = xcd_barrier_post((unsigned*)(ctl + CW_BAR), MISC + 8); }
#define GRID_BAR() xcd_barrier(bar)

    {
        PH_BEGIN(); const float *cvec = IN_PTR(1), *ada_w = IN_PTR(2), *ada_b = IN_PTR(3), *w_in = IN_PTR(6), *w_out = IN_PTR(11), *ffn_wg = IN_PTR(12), *ffn_wu = IN_PTR(13), *ffn_wd = IN_PTR(14);
        LAS float* tbl = (LAS float*)(lds + RING_OFF);
        for (int unit = bx; unit < 768; unit += G) {
            const int l = unit / 384, r = unit % 384, jb = r / 16, ks = r % 16;
            __syncthreads();
            { const float cv = cvec[(tid >> 6) * DM + ks * 64 + (tid & 63)]; tbl[tid] = cv / (1.0f + __expf(-cv)); }
            __syncthreads();
            const int j = jb * 256 + (tid & 255), kh = tid >> 8;
            float acc[8];
#pragma unroll
            for (int b = 0; b < 8; ++b) acc[b] = 0.f;
#pragma unroll 8
            for (int kk = 0; kk < 32; ++kk) { const int kl = kh * 32 + kk; const float w = ada_w[((size_t)l * DM + ks * 64 + kl) * MODLD + j];
#pragma unroll
                for (int b = 0; b < 8; ++b) acc[b] = fmaf(tbl[b * 64 + kl], w, acc[b]); }
            const float bias = (ks == 0 && kh == 0) ? ada_b[l * MODLD + j] : 0.f;
#pragma unroll
            for (int b = 0; b < 8; ++b) __hip_atomic_fetch_add(MOD + ((size_t)l * 8 + b) * MODLD + j, acc[b] + bias, __ATOMIC_RELAXED, __HIP_MEMORY_SCOPE_AGENT);
        }
        __syncthreads();
        LAS float* scr = (LAS float*)(lds + RING_OFF + wave * 16384);
        constexpr int I_IN = 16 * (NIN / 32), I_OUT = 16 * 32, I_UP = 16 * (NUP / 32), I_DN = (DFF / 64) * 32, I_L = I_IN + I_OUT + I_UP + I_DN;
        for (int it = gw; it < 2 * I_L; it += NGW) {
            const int l = it / I_L; int r = it % I_L;
            if (r < I_IN) { const int nblk = NIN / 32, kb = r / nblk, nb = r % nblk, n0 = nb * 32;
                int src, nv; if (n0 < 768) { src = n0; nv = 32; } else if (n0 < 3328) { src = n0 + 16; nv = 32; } else if (n0 == 3328) { src = 768; nv = 16; } else { src = 0; nv = 0; }
                tr_item(w_in + (size_t)l * DM * NIN_SRC, NIN_SRC, kb * 64, src, nv, WIN + (size_t)l * NIN * DM, DM, n0, scr, lane); continue; }
            r -= I_IN;
            if (r < I_OUT) { const int kb = r / 32, nb = r % 32; tr_item(w_out + (size_t)l * DM * DM, DM, kb * 64, nb * 32, 32, WOUT + (size_t)l * DM * DM, DM, nb * 32, scr, lane); continue; }
            r -= I_OUT;
            if (r < I_UP) { const int nblk = NUP / 32, kb = r / nblk, nb = r % nblk, n0 = nb * 32, tile = n0 >> 8, jj = n0 & 255;
                const float* W = (jj < 128) ? ffn_wg : ffn_wu; const int src = tile * 128 + (jj & 127);
                tr_item(W + (size_t)l * DM * DFF, DFF, kb * 64, src, 32, WUP + (size_t)l * NUP * DM, DM, n0, scr, lane); continue; }
            r -= I_UP;
            { const int kb = r / 32, nb = r % 32; tr_item(ffn_wd + (size_t)l * DFF * DM, DM, kb * 64, nb * 32, 32, WDN + (size_t)l * DM * DFF, DFF, nb * 32, scr, lane); }
        }
        for (int e = gw * 64 + lane; e < SEQ * 32; e += NGW * 64) { const int pos = e >> 5, i = e & 31;
            const float inv = powf(10000.0f, -(float)(2 * i) / 64.0f); const float ang = (float)pos * inv; float s, c; sincos_acc(ang, s, c);
            ROT[2 * e] = c; ROT[2 * e + 1] = s; }
    }
    GRID_BAR();
    {
        PH_BEGIN(); const float *x = IN_PTR(0), *norm1_g = IN_PTR(4);
        for (int grp = 0; grp < 4; ++grp) {
            const int l = grp >> 1, kind = grp & 1; const int NR = kind ? NUP : NIN;
            const bf16* W = kind ? (WUP + (size_t)l * NUP * DM) : (WIN + (size_t)l * NIN * DM);
            float* CB = kind ? (CBUP + (size_t)l * 8 * NUP) : (CBIN + (size_t)l * 8 * NIN);
            float sh[8][16];
#pragma unroll
            for (int b = 0; b < 8; ++b) { const float* sp = MOD + ((size_t)l * 8 + b) * MODLD + (kind ? 3 : 0) * DM;
#pragma unroll
                for (int j = 0; j < 2; ++j) { const f32x4 a = *(const f32x4*)(sp + j * 512 + lane * 8), c2 = *(const f32x4*)(sp + j * 512 + lane * 8 + 4);
                    sh[b][8 * j + 0] = a[0]; sh[b][8 * j + 1] = a[1]; sh[b][8 * j + 2] = a[2]; sh[b][8 * j + 3] = a[3]; sh[b][8 * j + 4] = c2[0]; sh[b][8 * j + 5] = c2[1]; sh[b][8 * j + 6] = c2[2]; sh[b][8 * j + 7] = c2[3]; } }
            for (int n = gw; n < NR; n += NGW) {
                float wv[16];
#pragma unroll
                for (int j = 0; j < 2; ++j) { const v4u w = *(const v4u*)(W + (size_t)n * DM + j * 512 + lane * 8);
                    wv[8 * j + 0] = __uint_as_float(w.x << 16); wv[8 * j + 1] = __uint_as_float(w.x & 0xffff0000u); wv[8 * j + 2] = __uint_as_float(w.y << 16); wv[8 * j + 3] = __uint_as_float(w.y & 0xffff0000u);
                    wv[8 * j + 4] = __uint_as_float(w.z << 16); wv[8 * j + 5] = __uint_as_float(w.z & 0xffff0000u); wv[8 * j + 6] = __uint_as_float(w.w << 16); wv[8 * j + 7] = __uint_as_float(w.w & 0xffff0000u); }
#pragma unroll
                for (int b = 0; b < 8; ++b) { float s = 0.f;
#pragma unroll
                    for (int i = 0; i < 16; ++i) s = fmaf(sh[b][i], wv[i], s);
                    s = wave_sum(s); if (lane == 0) CB[(size_t)b * NR + n] = s; }
            }
        }
        for (int m = gw; m < M; m += NGW) { const int b = m >> 12;
            const GAS f32x4* xr = (const GAS f32x4*)(x + (size_t)m * DM) + lane; float s = 0.f;
            GAS unsigned long long* o8 = (GAS unsigned long long*)(XA + (size_t)m * DM) + lane;
#pragma unroll
            for (int j = 0; j < 4; ++j) { const f32x4 v = xr[64 * j]; s += (v.x * v.x + v.y * v.y) + (v.z * v.z + v.w * v.w);
                const f32x4 a = *(const f32x4*)(norm1_g + j * 256 + lane * 4) * (*(const f32x4*)(MOD + (size_t)b * MODLD + DM + j * 256 + lane * 4) + 1.0f);
                const f32x4 y = v * a; o8[64 * j] = (unsigned long long)pk2(y.x, y.y) | ((unsigned long long)pk2(y.z, y.w) << 32); }
            s = wave_sum(s); if (lane == 0) SS[m] = s; }
    }
    GRID_BAR();

    for (int l = 0; l < DEPTH; ++l) {
        {
            PH_BEGIN();
            pg8::Gemm g{XA, WIN + (size_t)l * NIN * DM, M, NIN, DM}; pg8::StaticOrder S; S.init(M, NIN, G, bx);
            pg8::EpiInProj E{SS + (size_t)(2 * l) * M, CBIN + (size_t)l * 8 * NIN, ROT, ws};
            pg8::gemm_phase<pg8::EpiInProj, pg8::StaticOrder, true, true>(lds + RING_OFF, g, S, E);
        }
        GRID_BAR();
        {
            PH_BEGIN(); const float *gla_wa2 = IN_PTR(7), *gla_ba = IN_PTR(8);
            float w0[16], w1[16];
#pragma unroll
            for (int r = 0; r < 16; ++r) { w0[r] = gla_wa2[((size_t)l * 16 + r) * 128 + lane]; w1[r] = gla_wa2[((size_t)l * 16 + r) * 128 + 64 + lane]; }
            const float b0 = gla_ba[l * 128 + lane], b1 = gla_ba[l * 128 + 64 + lane];
            for (int m = gw; m < M; m += NGW) {
                const float grv = GR[(size_t)m * 16 + (lane & 15)];
                float u0 = b0, u1 = b1;
#pragma unroll
                for (int r = 0; r < 16; ++r) { const float gr = rdl(grv, r); u0 = fmaf(gr, w0[r], u0); u1 = fmaf(gr, w1[r], u1); }
                const float l0 = fminf(u0, 0.f) - __logf(1.0f + __expf(-fabsf(u0))), l1 = fminf(u1, 0.f) - __logf(1.0f + __expf(-fabsf(u1)));
                GA[(size_t)m * 128 + lane] = __expf(l0 * (1.0f / 16.0f)); GA[(size_t)m * 128 + 64 + lane] = __expf(l1 * (1.0f / 16.0f));
            }
        }
        GRID_BAR();
        {
            PH_BEGIN(); const float *gla_norm_g = IN_PTR(9), *ret_norm_g = IN_PTR(10);
            if (wave == 0 && vcu < 32) seq_recurrent_v0<32, true>(GQ, GK, GV, GG, GA, gla_norm_g + l * 64, OM, vcu >> 2, vcu & 3, lane, 0);
            else if (wave == 0 && vcu < 64) seq_recurrent_v0<64, false>(RQ, RK, RV, RG, nullptr, ret_norm_g + l * 64, OM, (vcu - 32) >> 2, (vcu - 32) & 3, lane, 256);
            for (int unit = gw; unit < 4096; unit += NGW) sb_unit_v0(SQ, SK, SV, OM, unit, lane);
        }
        GRID_BAR();
        {
            PH_BEGIN(); const float *x = IN_PTR(0), *norm2_g = IN_PTR(5); const float* MODL = MOD + (size_t)l * 8 * MODLD;
            pg8::Gemm g{OM, WOUT + (size_t)l * DM * DM, M, DM, DM}; pg8::StaticOrder S; S.init(M, DM, G, bx);
            pg8::EpiResid E{l == 0 ? x : out, out, MODL + 2 * DM, XA, norm2_g + l * DM, MODL + 4 * DM, SS + (size_t)(2 * l + 1) * M, 1};
            pg8::gemm_phase<pg8::EpiResid, pg8::StaticOrder, true, true>(lds + RING_OFF, g, S, E);
        }
        GRID_BAR();
        {
            PH_BEGIN();
            pg8::Gemm g{XA, WUP + (size_t)l * NUP * DM, M, NUP, DM}; pg8::StaticOrder S; S.init(M, NUP, G, bx);
            pg8::EpiFfnUp E{SS + (size_t)(2 * l + 1) * M, CBUP + (size_t)l * 8 * NUP, HB};
            pg8::gemm_phase<pg8::EpiFfnUp, pg8::StaticOrder, true, true>(lds + RING_OFF, g, S, E);
        }
        GRID_BAR();
        {
            PH_BEGIN(); const float *norm1_g = IN_PTR(4); const float* MODL = MOD + (size_t)l * 8 * MODLD;
            pg8::Gemm g{HB, WDN + (size_t)l * DM * DFF, M, DM, DFF}; pg8::StaticOrder S; S.init(M, DM, G, bx);
            const int nl = (l + 1 < DEPTH) ? l + 1 : l;
            pg8::EpiResid E{out, out, MODL + 5 * DM, XA, norm1_g + nl * DM, MOD + (size_t)nl * 8 * MODLD + 1 * DM, SS + (size_t)(2 * l + 2) * M, (l + 1 < DEPTH) ? 1 : 0};
            pg8::gemm_phase<pg8::EpiResid, pg8::StaticOrder, true, true>(lds + RING_OFF, g, S, E);
        }
        GRID_BAR();
    }
    {
        PH_BEGIN(); const float* final_g = IN_PTR(15);
        const float* ssf = SS + (size_t)(2 * DEPTH) * M;
        for (int m = gw; m < M; m += NGW) { const float r = __builtin_amdgcn_rsqf(ssf[m] * (1.0f / 1024.0f) + 1e-6f);
            GAS f32x4* xr = (GAS f32x4*)(out + (size_t)m * DM) + lane;
#pragma unroll
            for (int j = 0; j < 4; ++j) { const f32x4 v = xr[64 * j]; xr[64 * j] = v * r * (*(const f32x4*)(final_g + j * 256 + lane * 4)); } }
    }
}

extern "C" void kernel_launch(void* const* d_in, const int* in_sizes, int n_in, void* d_out, int out_size, void* d_ws, size_t ws_size, hipStream_t stream) {
    static int grid = 0;
    if (grid == 0) {
        if (n_in != 16 || in_sizes[0] != M * DM || out_size != M * DM || ws_size < WS_END) { fprintf(stderr, "kernel_launch: unexpected shapes (n_in %d, in0 %d, out %d, ws %zu); nothing launched\n", n_in, n_in > 0 ? in_sizes[0] : -1, out_size, ws_size); grid = -1; return; }
        int dev = 0, cus = 0, per_cu = 0;
        if (hipGetDevice(&dev) != hipSuccess || hipDeviceGetAttribute(&cus, hipDeviceAttributeMultiprocessorCount, dev) != hipSuccess) { grid = -1; return; }
        if (hipFuncSetAttribute((const void*)mk_fwd, hipFuncAttributeMaxDynamicSharedMemorySize, LDS_BYTES) != hipSuccess) { fprintf(stderr, "kernel_launch: hipFuncSetAttribute failed\n"); grid = -1; return; }
        if (hipOccupancyMaxActiveBlocksPerMultiprocessor(&per_cu, (const void*)mk_fwd, NWAVES * 64, LDS_BYTES) != hipSuccess || per_cu < 1) fprintf(stderr, "kernel_launch: note: occupancy query reports %d\n", per_cu);
        (void)hipGetLastError();
        grid = cus;
    }
    if (grid < 0) return;
    if (hipMemsetAsync((char*)d_ws + WS_CTL, 0, CTL_ZERO_BYTES, stream) != hipSuccess) { fprintf(stderr, "kernel_launch: memset failed\n"); return; }
    Args a{};
    for (int i = 0; i < 16; ++i) a.in[i] = (const float*)d_in[i];
    a.out = (float*)d_out; a.ws = (unsigned char*)d_ws; a.ph_lo = 0; a.ph_hi = 99;
    hipLaunchKernelGGL(mk_fwd, dim3(grid), dim3(NWAVES * 64), LDS_BYTES, stream, a);
}
```

```cpp
#include <hip/hip_runtime.h>
#include <cstdio>
#include <cstdint>
#define MIX_GLA_V1 1
#define MIX_RET_V1 1
#define MIX_SB_V1 1
#define PROBE_ON 0
constexpr int NWAVES = 8;
constexpr int BATCH = 8, SEQ = 4096, DM = 1024, M = BATCH * SEQ, DEPTH = 2;
constexpr int NIN = 3584, NIN_SRC = 3344, DFF = 2816, NUP = 5632, MODLD = 6144;
constexpr float SB_THR = -110.0f, SB_PMIN = 1.1754944e-38f;

constexpr size_t MiB = 1u << 20;
constexpr size_t WS_CTL = 0;
constexpr size_t WS_SS = 1 * MiB;
constexpr size_t WS_MOD = 2 * MiB + 512 * 1024;
constexpr size_t CTL_ZERO_BYTES = 2 * MiB + 512 * 1024;
constexpr size_t WS_CBIN = 3 * MiB;
constexpr size_t WS_CBUP = 3 * MiB + 512 * 1024;
constexpr size_t WS_ROT = 4 * MiB;
constexpr size_t WS_WIN = 8 * MiB;
constexpr size_t WS_WOUT = 22 * MiB;
constexpr size_t WS_WUP = 26 * MiB;
constexpr size_t WS_WDN = 48 * MiB;
constexpr size_t WS_XA = 64 * MiB;
constexpr size_t WS_OM = 128 * MiB;
constexpr size_t PBS = 26 * MiB;
constexpr size_t WS_GQ = 192 * MiB, WS_GK = 193 * MiB, WS_GV = 194 * MiB, WS_GG = 196 * MiB;
constexpr size_t WS_RQ = 198 * MiB, WS_RK = 200 * MiB, WS_RV = 202 * MiB, WS_RG = 204 * MiB;
constexpr size_t WS_SQ = 206 * MiB, WS_SK = 210 * MiB, WS_SV = 214 * MiB;
constexpr size_t WS_GR = 400 * MiB;
constexpr size_t WS_GA = 402 * MiB;
constexpr size_t WS_HB = 192 * MiB;
constexpr size_t WS_KVTG = 418 * MiB, WS_KVTR = 434 * MiB, WS_STG = 466 * MiB, WS_STR = 474 * MiB, WS_DEC = 490 * MiB;
constexpr size_t WS_END = 501 * MiB;
constexpr int CW_BAR = 4096;

constexpr int RING_OFF = 0, RING_BYTES = 131072;
constexpr int LDSCTL_OFF = RING_BYTES, MISC_OFF = LDSCTL_OFF + 320;
constexpr int LDS_BYTES = 163840;
constexpr int CBL_OFF = LDSCTL_OFF + 6144, RSL_OFF = CBL_OFF + 22528;

#if MIX_SB_V1
constexpr float SB_QSCALE = 0.125f * 1.4426950408889634f;
#else
constexpr float SB_QSCALE = 0.125f;
#endif
template <int OFF> __device__ __forceinline__ float shx(float v) {
    static_assert(OFF >= 1 && OFF < 32, "shx: OFF");
    return __builtin_bit_cast(float, __builtin_amdgcn_ds_swizzle(__builtin_bit_cast(int, v), (OFF << 10) | 0x1f));
}
__device__ __forceinline__ void swap32(float& a, float& b) { asm volatile("s_nop 1\n\tv_permlane32_swap_b32 %0, %1\n\ts_nop 1" : "+v"(a), "+v"(b)); }
__device__ __forceinline__ float add_x32(float v) {
    float a = v, b = v; swap32(a, b); return a + b;
}
__device__ __forceinline__ float get_x32(float v, int hi) {
    float a = v, b = v; swap32(a, b); return hi ? a : b;
}
__device__ __forceinline__ float sum32(float v) { v += shx<1>(v); v += shx<2>(v); v += shx<4>(v); v += shx<8>(v); v += shx<16>(v); return v; }
__device__ __forceinline__ unsigned long long ss_fix(float sq) { return (unsigned long long)(unsigned)(sq * 4096.0f) << 20; }
__device__ __forceinline__ float rstd_of(unsigned long long q) { const float s = (float)(unsigned)(q >> 20) * (1.0f / 4096.0f); return __builtin_amdgcn_rsqf(s * (1.0f / 1024.0f) + 1e-6f); }
__device__ __forceinline__ float row_rstd(const unsigned long long* ssq, size_t row) { const float s = (float)(unsigned)(ssq[row] >> 20) * (1.0f / 4096.0f); return __builtin_amdgcn_rsqf(s * (1.0f / 1024.0f) + 1e-6f); }
namespace pg8 {
#define PG8_LAS __attribute__((address_space(3)))
typedef unsigned short bf16_t;
typedef short bf16x8 __attribute__((ext_vector_type(8)));
typedef float f32x4 __attribute__((ext_vector_type(4)));
typedef unsigned u32x4 __attribute__((ext_vector_type(4)));
constexpr int BM = 256, BK = 64, HALF = 128, HTB = HALF * BK * 2  , STAGE_BYTES = 8 * HTB, NXCD = 8, WGM = 8;

__host__ __device__ __forceinline__ int lds_byte(int r, int c) { const int st = (r >> 4) * 2 + (c >> 5), rr = r & 15, cc = c & 31, ob = rr * 64 + cc * 2; return st * 1024 + (ob ^ (((ob >> 9) & 1) << 5)); }
__host__ __device__ __forceinline__ void stage_rc(int b, int& R, int& C) { const int st = b / 1024, sb = b % 1024, swz = sb ^ (((sb >> 9) & 1) << 5); R = (st >> 1) * 16 + swz / 64; C = (st & 1) * 32 + (swz % 64) / 2; }
__host__ __device__ __forceinline__ int perm32(int rho) { const int n = rho >> 4, i = rho & 15; return 8 * (i >> 2) + 4 * n + (i & 3); }

struct Unit { int pm, pn; };
struct Gemm { const bf16_t* A; const bf16_t* Bt; int M, N, K; size_t abx = 0; };

struct StaticOrder {
    int nM, nN, nwg, G, c;
    __host__ __device__ void init(int M, int N, int G_, int c_) { nM = M / BM; nN = N / BM; nwg = nM * nN; G = G_; c = c_; }
    __host__ __device__ bool next(int i, Unit& u) const {
        const long L = (long)i * G + c; if (L >= nwg) return false;
        int wgid = (int)L; { const int q = nwg / NXCD, r = nwg % NXCD, xcd = wgid % NXCD, off = wgid / NXCD; wgid = (xcd < r ? xcd * (q + 1) : r * (q + 1) + (xcd - r) * q) + off; }
        const int nig = WGM * nN, gid = wgid / nig, fm = gid * WGM, gsz = (nM - fm) < WGM ? (nM - fm) : WGM;
        u.pm = fm + ((wgid % nig) % gsz); u.pn = (wgid % nig) / gsz; return true;
    }
    __device__ __forceinline__ void a_ready(const Unit&) const {}
    __device__ __forceinline__ void done(const Unit&) const {}
};

typedef float cvt_f32x2_t __attribute__((ext_vector_type(2))); typedef __bf16 cvt_bf16x2_t __attribute__((ext_vector_type(2)));
__device__ __forceinline__ unsigned cvt_pk_bf16(float lo, float hi) { const cvt_f32x2_t v = {lo, hi}; const cvt_bf16x2_t b = __builtin_convertvector(v, cvt_bf16x2_t); return __builtin_bit_cast(unsigned, b); }
constexpr int NIN = ::NIN, NUP = ::NUP, DFFC = ::DFF, DMC = ::DM, MODLD = ::MODLD;
__device__ __forceinline__ float silu_f(float a) { return a * __builtin_amdgcn_rcpf(1.0f + __expf(-a)); }
__device__ __forceinline__ u32x4 pack8(const f32x4 v0, const f32x4 v1) { u32x4 w; w.x = cvt_pk_bf16(v0[0], v0[1]); w.y = cvt_pk_bf16(v0[2], v0[3]); w.z = cvt_pk_bf16(v1[0], v1[1]); w.w = cvt_pk_bf16(v1[2], v1[3]); return w; }

__device__ __forceinline__ void load_rstd8(const unsigned long long* sp, float (&rs)[2][4]) {
    unsigned long long raw[8];
    asm volatile("global_load_dwordx2 %0, %1, off" : "=v"(raw[0]) : "v"(sp));
    asm volatile("global_load_dwordx2 %0, %1, off offset:128" : "=v"(raw[1]) : "v"(sp));
    asm volatile("global_load_dwordx2 %0, %1, off offset:256" : "=v"(raw[2]) : "v"(sp));
    asm volatile("global_load_dwordx2 %0, %1, off offset:384" : "=v"(raw[3]) : "v"(sp));
    asm volatile("global_load_dwordx2 %0, %1, off offset:1024" : "=v"(raw[4]) : "v"(sp));
    asm volatile("global_load_dwordx2 %0, %1, off offset:1152" : "=v"(raw[5]) : "v"(sp));
    asm volatile("global_load_dwordx2 %0, %1, off offset:1280" : "=v"(raw[6]) : "v"(sp));
    asm volatile("global_load_dwordx2 %0, %1, off offset:1408" : "=v"(raw[7]) : "v"(sp));
    asm volatile("s_waitcnt vmcnt(0)" : "+v"(raw[0]), "+v"(raw[1]), "+v"(raw[2]), "+v"(raw[3]), "+v"(raw[4]), "+v"(raw[5]), "+v"(raw[6]), "+v"(raw[7]) :: "memory");
#pragma unroll
    for (int i = 0; i < 8; ++i) rs[i >> 2][i & 3] = rstd_of(raw[i]);
}

struct EpiInProj {
    static constexpr bool PERM = true, AFTER_DRAIN = false;
    const PG8_LAS float* cbl; const PG8_LAS float* rsl; int pm0; const float* rot; unsigned char* ws;
    template <bool ROT>
    __device__ __forceinline__ void tile(const f32x4 (&acc)[2][2][4][2], const float (&rs)[2][4], const f32x4 (&c0)[2], const f32x4 (&c1)[2], int pn, int row0, int cl, int bq) const {
        int clq = cl; asm volatile("" : "+v"(clq));
        const int i0 = (clq & 63) >> 1;
#pragma unroll
        for (int ai = 0; ai < 2; ++ai) {
            f32x4 t0[4], t1[4];
            if constexpr (ROT) {
#pragma unroll
                for (int m = 0; m < 4; ++m) { const int pos = (row0 + ai * HALF + m * 16) & 4095; t0[m] = *(const f32x4*)(rot + ((size_t)pos * 32 + i0) * 2); t1[m] = *(const f32x4*)(rot + ((size_t)pos * 32 + i0 + 2) * 2); }
                asm volatile("" ::: "memory");
            }
#pragma unroll
            for (int bj = 0; bj < 2; ++bj) {
                unsigned long long off; int ldl, colb = bj * HALF; float sc = 1.0f;
                if (ROT) { ldl = 8; if (pn == 3) { off = WS_RQ; } else { off = WS_RK; sc = 0.125f; } }
                else if (pn == 0) { ldl = 7; colb = 0; if (bj == 0) { off = WS_GQ; sc = 0.17677669529663687f; } else { off = WS_GK; } }
                else if (pn == 1) { off = WS_GV; ldl = 8; }
                else if (pn == 2) { off = WS_GG; ldl = 8; }
                else if (pn == 5) { off = WS_RV; ldl = 8; }
                else if (pn == 6) { off = WS_RG; ldl = 8; }
                else if (pn <= 8) { off = WS_SQ; ldl = 9; colb += (pn - 7) * BM; sc = SB_QSCALE; }
                else if (pn <= 10) { off = WS_SK; ldl = 9; colb += (pn - 9) * BM; }
                else { off = WS_SV; ldl = 9; colb += (pn - 11) * BM; }
                off = ((unsigned long long)__builtin_amdgcn_readfirstlane((unsigned)(off >> 20))) << 20; ldl = __builtin_amdgcn_readfirstlane(ldl); colb = __builtin_amdgcn_readfirstlane(colb);
                asm volatile("" : "+s"(off), "+s"(ldl), "+s"(colb));
                unsigned char* dstb = ws + off + (size_t)bq * (::PBS - ((size_t)4096 << (ldl + 1)));
#pragma unroll
                for (int m = 0; m < 4; ++m) { const int row = row0 + ai * HALF + m * 16; const float r = rs[ai][m];
                    f32x4 v0 = acc[ai][bj][m][0] * r + c0[bj], v1 = acc[ai][bj][m][1] * r + c1[bj];
                    if constexpr (ROT) {
                        const f32x4 w0 = {v0[0] * t0[m][0] - v0[1] * t0[m][1], v0[0] * t0[m][1] + v0[1] * t0[m][0], v0[2] * t0[m][2] - v0[3] * t0[m][3], v0[2] * t0[m][3] + v0[3] * t0[m][2]};
                        const f32x4 w1 = {v1[0] * t1[m][0] - v1[1] * t1[m][1], v1[0] * t1[m][1] + v1[1] * t1[m][0], v1[2] * t1[m][2] - v1[3] * t1[m][3], v1[2] * t1[m][3] + v1[3] * t1[m][2]};
                        v0 = w0; v1 = w1; }
                    v0 = v0 * sc; v1 = v1 * sc;
                    *(u32x4*)(dstb + ((((size_t)row << ldl) + (size_t)(colb + cl)) << 1)) = pack8(v0, v1); } }
        }
    }
    __device__ __forceinline__ void operator()(const f32x4 (&acc)[2][2][4][2], const Unit& u, int wr, int wc, int fr, int fq) const {
        const int pn = u.pn, b = u.pm >> 4;
        const int row0 = u.pm * BM + wr * 64 + fr; const int cl = wc * 32 + 8 * fq;
        f32x4 c0[2], c1[2];
#pragma unroll
        for (int bj = 0; bj < 2; ++bj) { const PG8_LAS float* cbp = cbl + pn * BM + bj * HALF + cl; c0[bj] = *(const PG8_LAS f32x4*)(cbp); c1[bj] = *(const PG8_LAS f32x4*)(cbp + 4); }
        float rs[2][4];
        { const PG8_LAS float* rp = rsl + (u.pm == pm0 ? 0 : 256) + wr * 64 + fr;
#pragma unroll
          for (int ai = 0; ai < 2; ++ai)
#pragma unroll
              for (int m = 0; m < 4; ++m) rs[ai][m] = rp[ai * HALF + m * 16]; }
        int kind = (pn == 3 || pn == 4) ? 1 : (pn == 13 ? 2 : 0);
        kind = __builtin_amdgcn_readfirstlane(kind); asm volatile("" : "+s"(kind));
        if (kind == 2) {
            int clg = cl; unsigned long long goff = WS_GR; asm volatile("" : "+v"(clg), "+s"(goff));
            if (clg < 16) { float* gbase = (float*)(ws + goff);
#pragma unroll
                for (int ai = 0; ai < 2; ++ai)
#pragma unroll
                    for (int m = 0; m < 4; ++m) { const int row = row0 + ai * HALF + m * 16; const float r = rs[ai][m]; float* gp = gbase + (size_t)row * 16 + clg;
                        *(f32x4*)(gp) = acc[ai][0][m][0] * r + c0[0]; *(f32x4*)(gp + 4) = acc[ai][0][m][1] * r + c1[0]; } }
        } else if (kind == 1) { tile<true>(acc, rs, c0, c1, pn, row0, cl, b); }
        else { tile<false>(acc, rs, c0, c1, pn, row0, cl, b); }
    }
};

struct EpiResid {
    static constexpr bool PERM = true, AFTER_DRAIN = false;
    const bf16_t* xin; bf16_t* xout;
    const PG8_LAS float* gl; const PG8_LAS float* al;
    bf16_t* xa; unsigned long long* ssn; int write_xa;
    __device__ __forceinline__ void operator()(const f32x4 (&acc)[2][2][4][2], const Unit& u, int wr, int wc, int fr, int fq) const {
        const int row0 = u.pm * BM + wr * 64 + fr;
        const int colb = u.pn * BM + wc * 32 + 8 * fq;
        unsigned voff = (unsigned)(((size_t)row0 * DMC + colb) * 2); asm volatile("" : "+v"(voff));
#define RES_CO(ai, bj, m) ((size_t)(((ai) * HALF + (m) * 16) * DMC + (bj) * HALF) * 2)
#define RES_LD(ai, bj, buf) { _Pragma("unroll") for (int m = 0; m < 4; ++m) xr[buf][m] = *(const u32x4*)((const char*)xin + RES_CO(ai, bj, m) + voff); }
        u32x4 xr[2][4]; f32x4 g0, g1, a0, a1;
        RES_LD(0, 0, 0) RES_LD(1, 0, 1)
        asm volatile("" ::: "memory");
        float sq[2][4] = {{0.f, 0.f, 0.f, 0.f}, {0.f, 0.f, 0.f, 0.f}};
#pragma unroll
        for (int q = 0; q < 4; ++q) {
            const int bj = q >> 1, ai = q & 1, buf = q & 1;
            if (ai == 0) { const int col = colb + bj * HALF;
                g0 = *(const PG8_LAS f32x4*)(gl + col); g1 = *(const PG8_LAS f32x4*)(gl + col + 4); a0 = *(const PG8_LAS f32x4*)(al + col); a1 = *(const PG8_LAS f32x4*)(al + col + 4); }
#pragma unroll
            for (int m = 0; m < 4; ++m) { const u32x4 w = xr[buf][m];
                const f32x4 x0 = {__uint_as_float(w.x << 16), __uint_as_float(w.x & 0xffff0000u), __uint_as_float(w.y << 16), __uint_as_float(w.y & 0xffff0000u)};
                const f32x4 x1 = {__uint_as_float(w.z << 16), __uint_as_float(w.z & 0xffff0000u), __uint_as_float(w.w << 16), __uint_as_float(w.w & 0xffff0000u)};
                const f32x4 y0 = x0 + g0 * acc[ai][bj][m][0], y1 = x1 + g1 * acc[ai][bj][m][1];
                *(u32x4*)((char*)xout + RES_CO(ai, bj, m) + voff) = pack8(y0, y1);
                sq[ai][m] += (y0[0] * y0[0] + y0[1] * y0[1]) + (y0[2] * y0[2] + y0[3] * y0[3]) + (y1[0] * y1[0] + y1[1] * y1[1]) + (y1[2] * y1[2] + y1[3] * y1[3]);
                if (write_xa) *(u32x4*)((char*)xa + RES_CO(ai, bj, m) + voff) = pack8(y0 * a0, y1 * a1); }
            asm volatile("" ::: "memory");
            if (q == 0) RES_LD(0, 1, 0)
            if (q == 1) RES_LD(1, 1, 1)
            asm volatile("" ::: "memory");
            if (bj == 1) {
#pragma unroll
                for (int m = 0; m < 4; ++m) { float s2 = sq[ai][m]; s2 += shx<16>(s2); s2 = add_x32(s2);
                    if (fq == 0) __hip_atomic_fetch_add(ssn + (row0 + ai * HALF + m * 16), ss_fix(s2), __ATOMIC_RELAXED, __HIP_MEMORY_SCOPE_AGENT); }
            }
        }
#undef RES_LD
#undef RES_CO
    }
};

struct EpiFfnUp {
    static constexpr bool PERM = true, AFTER_DRAIN = false;
    const PG8_LAS float* cbl; const PG8_LAS float* rsl; int pm0; bf16_t* hb;
    __device__ __forceinline__ void operator()(const f32x4 (&acc)[2][2][4][2], const Unit& u, int wr, int wc, int fr, int fq) const {
        const int b = u.pm >> 4; const int row0 = u.pm * BM + wr * 64 + fr; const int cw = wc * 32 + 8 * fq;
        const PG8_LAS float* cbp = cbl + u.pn * BM + cw;
        const f32x4 cg0 = *(const PG8_LAS f32x4*)(cbp), cg1 = *(const PG8_LAS f32x4*)(cbp + 4), cu0 = *(const PG8_LAS f32x4*)(cbp + HALF), cu1 = *(const PG8_LAS f32x4*)(cbp + HALF + 4);
        float rs[2][4];
        { const PG8_LAS float* rp = rsl + (u.pm == pm0 ? 0 : 256) + wr * 64 + fr;
#pragma unroll
          for (int ai = 0; ai < 2; ++ai)
#pragma unroll
              for (int m = 0; m < 4; ++m) rs[ai][m] = rp[ai * HALF + m * 16]; }
#pragma unroll
        for (int ai = 0; ai < 2; ++ai)
#pragma unroll
            for (int m = 0; m < 4; ++m) { const int row = row0 + ai * HALF + m * 16;
                const float r = rs[ai][m];
                const f32x4 g0 = acc[ai][0][m][0] * r + cg0, g1 = acc[ai][0][m][1] * r + cg1, u0 = acc[ai][1][m][0] * r + cu0, u1 = acc[ai][1][m][1] * r + cu1;
                f32x4 h0, h1;
#pragma unroll
                for (int e = 0; e < 4; ++e) { h0[e] = silu_f(g0[e]) * u0[e]; h1[e] = silu_f(g1[e]) * u1[e]; }
                *(u32x4*)(hb + (size_t)b * ((::PBS - (size_t)4096 * DFFC * 2) / 2) + (size_t)row * DFFC + u.pn * HALF + cw) = pack8(h0, h1); }
    }
};

struct EpiNull {
    static constexpr bool PERM = true, AFTER_DRAIN = false;
    float* sink;
    __device__ __forceinline__ void operator()(const f32x4 (&acc)[2][2][4][2], const Unit& u, int wr, int wc, int fr, int fq) const {
        f32x4 s = (f32x4){0.f, 0.f, 0.f, 0.f};
#pragma unroll
        for (int ai = 0; ai < 2; ++ai)
#pragma unroll
            for (int bj = 0; bj < 2; ++bj)
#pragma unroll
                for (int m = 0; m < 4; ++m)
#pragma unroll
                    for (int n = 0; n < 2; ++n) s += acc[ai][bj][m][n];
        sink[(size_t)(u.pm * 32 + u.pn) * 512 + (wr * 4 + wc) * 64 + fq * 16 + fr] = (s[0] + s[1]) + (s[2] + s[3]);
    }
};
template <class Epi, class Sched, bool ALIGN_EPI = false, bool SP2 = false>
__device__ __forceinline__ void gemm_phase(PG8_LAS unsigned char* lds, const Gemm g, const Sched& S, const Epi& E, int tid) {
    asm volatile("" : "+v"(tid));
    const int wid = __builtin_amdgcn_readfirstlane(tid >> 6), lane = tid & 63, wr = wid >> 2, wc = wid & 3, fr = lane & 15, fq = lane >> 4;
    const int K = g.K, nt = K / BK;
    unsigned voffA[2], voffB[2];
#pragma unroll
    for (int i = 0; i < 2; ++i) { int R, C; stage_rc(tid * 16 + i * 8192, R, C); const int Rb = Epi::PERM ? ((R & ~31) + perm32(R & 31)) : R;
        voffA[i] = (unsigned)(R * K + C) * 2u; voffB[i] = (unsigned)(Rb * K + C) * 2u; }
    const size_t kstep = (size_t)(BK * 2);
    const size_t hstep = (size_t)HALF * K * 2;
    const size_t tstep = 2 * hstep;
    const unsigned ldsw = (unsigned)wid * 1024u;
    const int aoff = lds_byte(wr * 64 + fr, fq * 8), boff = lds_byte(wc * 32 + fr, fq * 8);
#define PG8_SA(b, h) (((b) * 2 + (h)) * HTB)
#define PG8_SB(b, h) ((4 + (b) * 2 + (h)) * HTB)
#define PG8_STAGE(bufoff, gbase, voff) do { _Pragma("unroll") for (int _i = 0; _i < 2; ++_i) \
        __builtin_amdgcn_global_load_lds((const unsigned*)((const char*)(gbase) + (voff)[_i]), (PG8_LAS unsigned*)(lds + (bufoff) + ldsw + _i * 8192), 16, 0, 0); } while (0)
#define PG8_LDA(dst, b, h) do { _Pragma("unroll") for (int m = 0; m < 4; ++m) _Pragma("unroll") for (int k = 0; k < 2; ++k) dst[m][k] = *(const PG8_LAS bf16x8*)(lds + PG8_SA(b, h) + aoff + m * 2048 + k * 1024); } while (0)
#define PG8_LDB(dst, b, h) do { _Pragma("unroll") for (int n = 0; n < 2; ++n) _Pragma("unroll") for (int k = 0; k < 2; ++k) dst[n][k] = *(const PG8_LAS bf16x8*)(lds + PG8_SB(b, h) + boff + n * 2048 + k * 1024); } while (0)
#define PG8_MMA(ai, bj, At, Bt) do { __builtin_amdgcn_s_setprio(1); _Pragma("unroll") for (int m = 0; m < 4; ++m) _Pragma("unroll") for (int n = 0; n < 2; ++n) _Pragma("unroll") for (int k = 0; k < 2; ++k) \
        acc[ai][bj][m][n] = __builtin_amdgcn_mfma_f32_16x16x32_bf16(Bt[n][k], At[m][k], acc[ai][bj][m][n], 0, 0, 0); __builtin_amdgcn_s_setprio(0); } while (0)
#define PG8_WAIT_V(n) asm volatile("s_waitcnt vmcnt(" #n ")" ::: "memory")
#define PG8_WAIT_L(n) asm volatile("s_waitcnt lgkmcnt(" #n ")" ::: "memory")
#define PG8_BAR __builtin_amdgcn_s_barrier()
#define PG8_SCHED __builtin_amdgcn_sched_barrier(0)
    Unit cur, nxt; int ui = 0;
    if (!S.next(0, cur)) return;
    f32x4 acc[2][2][4][2];
#pragma unroll
    for (int a = 0; a < 2; ++a)
#pragma unroll
        for (int b = 0; b < 2; ++b)
#pragma unroll
            for (int m = 0; m < 4; ++m)
#pragma unroll
                for (int n = 0; n < 2; ++n) acc[a][b][m][n] = (f32x4){0.f, 0.f, 0.f, 0.f};
    bf16x8 At[4][2], B0[2][2], B1[2][2];
    const char* cA = (const char*)g.A + (size_t)cur.pm * tstep + (size_t)(cur.pm >> 4) * g.abx; const char* cB = (const char*)g.Bt + (size_t)cur.pn * tstep;
    S.a_ready(cur);
    if constexpr (SP2) {
        PG8_STAGE(PG8_SB(0, 0), cB, voffB); PG8_STAGE(PG8_SB(0, 1), cB + hstep, voffB); PG8_STAGE(PG8_SA(0, 0), cA, voffA); PG8_STAGE(PG8_SA(0, 1), cA + hstep, voffA);
        if (wr == 1) PG8_BAR;
        PG8_WAIT_V(2); PG8_BAR;
        PG8_STAGE(PG8_SB(1, 0), cB + kstep, voffB); PG8_STAGE(PG8_SA(1, 0), cA + kstep, voffA); PG8_STAGE(PG8_SB(1, 1), cB + hstep + kstep, voffB);
        PG8_WAIT_V(6); PG8_BAR;
    } else {
        PG8_STAGE(PG8_SB(0, 0), cB, voffB); PG8_STAGE(PG8_SA(0, 0), cA, voffA); PG8_STAGE(PG8_SB(0, 1), cB + hstep, voffB); PG8_STAGE(PG8_SA(0, 1), cA + hstep, voffA);
        if (wr == 1) PG8_BAR;
        PG8_WAIT_V(4); PG8_BAR;
        PG8_STAGE(PG8_SB(1, 0), cB + kstep, voffB); PG8_STAGE(PG8_SA(1, 0), cA + kstep, voffA); PG8_STAGE(PG8_SB(1, 1), cB + hstep + kstep, voffB);
        PG8_WAIT_V(6); PG8_BAR;
    }
    for (;;) {
        const bool has_next = S.next(ui + 1, nxt);
        const char* nA = has_next ? (const char*)g.A + (size_t)nxt.pm * tstep + (size_t)(nxt.pm >> 4) * g.abx : cA; const char* nB = has_next ? (const char*)g.Bt + (size_t)nxt.pn * tstep : cB;
        for (int t = 0; t < nt; t += 2) {
            const bool last = (t == nt - 2);
            const char* a1 = cA + (size_t)(t + 1) * kstep;
            const char* a2 = last ? nA : cA + (size_t)(t + 2) * kstep; const char* b2 = last ? nB : cB + (size_t)(t + 2) * kstep;
            const char* a3 = a2 + kstep; const char* b3 = b2 + kstep;
            if (last && has_next) S.a_ready(nxt);
            if constexpr (SP2) {
            PG8_LDB(B0, 0, 0); PG8_LDB(B1, 0, 1); PG8_SCHED; PG8_LDA(At, 0, 0); PG8_STAGE(PG8_SA(1, 1), a1 + hstep, voffA);
            PG8_WAIT_V(8); PG8_WAIT_L(0); PG8_BAR; PG8_MMA(0, 0, At, B0); PG8_MMA(0, 1, At, B1); PG8_BAR; PG8_SCHED;
            PG8_LDA(At, 0, 1); PG8_STAGE(PG8_SB(0, 0), b2, voffB); PG8_STAGE(PG8_SB(0, 1), b2 + hstep, voffB); PG8_STAGE(PG8_SA(0, 0), a2, voffA);
            PG8_WAIT_V(8); PG8_WAIT_L(0); PG8_BAR; PG8_MMA(1, 0, At, B0); PG8_MMA(1, 1, At, B1); PG8_BAR; PG8_SCHED;
            PG8_LDB(B0, 1, 0); PG8_LDB(B1, 1, 1); PG8_SCHED; PG8_LDA(At, 1, 0); PG8_STAGE(PG8_SA(0, 1), a2 + hstep, voffA);
            PG8_WAIT_V(8); PG8_WAIT_L(0); PG8_BAR; PG8_MMA(0, 0, At, B0); PG8_MMA(0, 1, At, B1); PG8_BAR; PG8_SCHED;
            PG8_LDA(At, 1, 1); PG8_STAGE(PG8_SB(1, 0), b3, voffB); PG8_STAGE(PG8_SB(1, 1), b3 + hstep, voffB); PG8_STAGE(PG8_SA(1, 0), a3, voffA);
            PG8_WAIT_V(8); PG8_WAIT_L(0); PG8_BAR; PG8_MMA(1, 0, At, B0); PG8_MMA(1, 1, At, B1); PG8_BAR; PG8_SCHED;
            } else {
            PG8_LDB(B0, 0, 0); PG8_SCHED; PG8_LDA(At, 0, 0); PG8_STAGE(PG8_SA(1, 1), a1 + hstep, voffA);
            PG8_WAIT_L(8); PG8_BAR; PG8_WAIT_L(0); PG8_MMA(0, 0, At, B0); PG8_BAR; PG8_SCHED;
            PG8_LDB(B1, 0, 1); PG8_STAGE(PG8_SB(0, 0), b2, voffB);
            PG8_BAR; PG8_WAIT_L(0); PG8_MMA(0, 1, At, B1); PG8_BAR;
            PG8_LDA(At, 0, 1); PG8_STAGE(PG8_SA(0, 0), a2, voffA);
            PG8_BAR; PG8_WAIT_L(0); PG8_MMA(1, 0, At, B0); PG8_BAR; PG8_SCHED;
            PG8_STAGE(PG8_SB(0, 1), b2 + hstep, voffB);
            PG8_WAIT_V(6); PG8_BAR; PG8_MMA(1, 1, At, B1); PG8_BAR;
            PG8_LDB(B0, 1, 0); PG8_SCHED; PG8_LDA(At, 1, 0); PG8_STAGE(PG8_SA(0, 1), a2 + hstep, voffA);
            PG8_WAIT_L(8); PG8_BAR; PG8_WAIT_L(0); PG8_MMA(0, 0, At, B0); PG8_BAR; PG8_SCHED;
            PG8_LDB(B1, 1, 1); PG8_STAGE(PG8_SB(1, 0), b3, voffB);
            PG8_BAR; PG8_WAIT_L(0); PG8_MMA(0, 1, At, B1); PG8_BAR;
            PG8_LDA(At, 1, 1); PG8_STAGE(PG8_SA(1, 0), a3, voffA);
            PG8_BAR; PG8_WAIT_L(0); PG8_MMA(1, 0, At, B0); PG8_BAR; PG8_SCHED;
            PG8_STAGE(PG8_SB(1, 1), b3 + hstep, voffB);
            PG8_WAIT_V(6); PG8_BAR; PG8_MMA(1, 1, At, B1); PG8_BAR;
            }
        }
        if constexpr (ALIGN_EPI) { if (wr == 0) PG8_BAR; }
        if constexpr (!Epi::AFTER_DRAIN) { E(acc, cur, wr, wc, fr, fq); S.done(cur); }
        if (!has_next) break;
#pragma unroll
        for (int a = 0; a < 2; ++a)
#pragma unroll
            for (int b = 0; b < 2; ++b)
#pragma unroll
                for (int m = 0; m < 4; ++m)
#pragma unroll
                    for (int n = 0; n < 2; ++n) acc[a][b][m][n] = (f32x4){0.f, 0.f, 0.f, 0.f};
        cur = nxt; cA = nA; cB = nB; ++ui;
        if constexpr (ALIGN_EPI) { if (wr == 1) PG8_BAR; }
    }
    PG8_WAIT_V(0);
    if constexpr (!ALIGN_EPI) { if (wr == 0) PG8_BAR; }
    PG8_BAR;
    if constexpr (Epi::AFTER_DRAIN) { E.fused(acc, cur, wr, wc, fr, fq, lds, wid, lane); S.done(cur); }
#undef PG8_SA
#undef PG8_SB
#undef PG8_STAGE
#undef PG8_LDA
#undef PG8_LDB
#undef PG8_MMA
#undef PG8_WAIT_V
#undef PG8_WAIT_L
#undef PG8_BAR
#undef PG8_SCHED
}
}
#define GAS __attribute__((address_space(1)))
#define LAS __attribute__((address_space(3)))
typedef unsigned short bf16;
typedef unsigned v4u __attribute__((ext_vector_type(4)));
typedef float f32x4 __attribute__((ext_vector_type(4)));
typedef short bf16x8 __attribute__((ext_vector_type(8)));
typedef GAS unsigned gu32;
typedef GAS unsigned long long gu64;
#define RLX_AGENT __ATOMIC_RELAXED, __HIP_MEMORY_SCOPE_AGENT
#define LDS_WAIT() asm volatile("s_waitcnt lgkmcnt(0)" ::: "memory")
#define VM_WAIT() asm volatile("s_waitcnt vmcnt(0)" ::: "memory")
__device__ __forceinline__ unsigned long long rt() { return __builtin_amdgcn_s_memrealtime(); }
__device__ __forceinline__ unsigned f2bf(float f) { unsigned u = __builtin_bit_cast(unsigned, f); return (u + 0x7fffu + ((u >> 16) & 1u)) >> 16; }
__device__ __forceinline__ unsigned pk2(float lo, float hi) { return f2bf(lo) | (f2bf(hi) << 16); }
#define XB_TMO      128
#define XB_XCNT(j)  (256  + 64 * (j))
#define XB_XSUB(j)  (1280 + 64 * (j))
#define XB_XGEN(j)  (2304 + 64 * (j))
#define XB_TOP      3328
#define XB_TOPGEN   3392
#define XCD_BAR_WORDS 3456
#define XB_SPIN_CAP (1u << 18)

__device__ __forceinline__ unsigned xb_ld(unsigned* p)              { return __hip_atomic_load(p, __ATOMIC_RELAXED, __HIP_MEMORY_SCOPE_AGENT); }
__device__ __forceinline__ unsigned xb_add(unsigned* p, unsigned v) { return __hip_atomic_fetch_add(p, v, __ATOMIC_RELAXED, __HIP_MEMORY_SCOPE_AGENT); }
__device__ __forceinline__ unsigned xb_xcc_id() { return (unsigned)__builtin_amdgcn_s_getreg((3 << 11) | 20) & 0xFu; }
#define XB_SPIN(cond, bar) do { unsigned _sp = 0; while (cond) { __builtin_amdgcn_s_sleep(1); \
    if ((++_sp & 255u) == 0u) { if (xb_ld(&(bar)[XB_TMO])) break; if (_sp > XB_SPIN_CAP) { atomicAdd(&(bar)[XB_TMO], 1u); break; } } } } while (0)

struct XcdBarrier {
    unsigned* bar; unsigned x; int tid;
    volatile LAS unsigned* st;
};

__device__ __forceinline__ XcdBarrier xcd_barrier_post(unsigned* bar, volatile LAS unsigned* st) {
    XcdBarrier b; b.bar = bar; b.x = xb_xcc_id(); b.st = st; b.tid = (int)threadIdx.x;
    if (threadIdx.x == 0) st[2] = xb_add(&bar[XB_XCNT(b.x)], 1u);
    return b;
}
__device__ __forceinline__ void xcd_barrier_complete(unsigned* bar, unsigned x, unsigned& nloc, unsigned& nx, unsigned& uni) {
    const unsigned G = gridDim.x * gridDim.y * gridDim.z;
    unsigned sum, cnt, mine, n32, sp = 0u;
    for (;;) {
        sum = 0u; cnt = 0u; mine = 0u; n32 = 0u;
#pragma unroll
        for (unsigned j = 0; j < 16; ++j) { const unsigned c = xb_ld(&bar[XB_XCNT(j)]); sum += c; cnt += (c > 0u) ? 1u : 0u; mine = (j == x) ? c : mine; n32 += (j < 8u && c == 32u) ? 1u : 0u; }
        if (sum == G) break;
        __builtin_amdgcn_s_sleep(1);
        if ((++sp & 255u) == 0u) { if (xb_ld(&bar[XB_TMO])) break; if (sp > XB_SPIN_CAP) { atomicAdd(&bar[XB_TMO], 1u); break; } }
    }
    nloc = mine > 0u ? mine : 1u; nx = cnt > 0u ? cnt : 1u;
    uni = (sum == G && G == 256u && n32 == 8u) ? 1u : 2u;
}

__device__ __forceinline__ void xcd_barrier(const XcdBarrier& b, int local_only = 0) {
    asm volatile("s_waitcnt vmcnt(0)" ::: "memory");
    __syncthreads();
    if (b.tid == 0) {
        unsigned* bar = b.bar;
        __builtin_amdgcn_s_waitcnt(0);
        unsigned nloc = b.st[0], nx = b.st[1];
        if (nloc == 0u) { unsigned uni; xcd_barrier_complete(bar, b.x, nloc, nx, uni); b.st[0] = nloc; b.st[1] = nx; b.st[3] = uni; }
        const unsigned old = xb_add(&bar[XB_XSUB(b.x)], 1u);
        const unsigned gen = old / nloc;
        if (old + 1u == (gen + 1u) * nloc) {
            if (!local_only) {
            __builtin_amdgcn_fence(__ATOMIC_RELEASE, "agent");
            asm volatile("s_waitcnt vmcnt(0)" ::: "memory");
            const unsigned og = xb_add(&bar[XB_TOP], 1u);
            const unsigned tg = og / nx;
            if (og + 1u == (tg + 1u) * nx) xb_add(&bar[XB_TOPGEN], 1u);
            else XB_SPIN(xb_ld(&bar[XB_TOPGEN]) == tg, bar);
            }
            if (local_only) xb_add(&bar[XB_XGEN(b.x)], 1u);
            __builtin_amdgcn_fence(__ATOMIC_ACQUIRE, "agent");
            if (!local_only) xb_add(&bar[XB_XGEN(b.x)], 1u);
            asm volatile("s_waitcnt vmcnt(0)" ::: "memory");
        } else {
            XB_SPIN(xb_ld(&bar[XB_XGEN(b.x)]) == gen, bar);
            __builtin_amdgcn_fence(__ATOMIC_ACQUIRE, "agent");
            asm volatile("s_waitcnt vmcnt(0)" ::: "memory");
        }
    }
    __syncthreads();
}
__device__ __forceinline__ float bf2f(unsigned short h) { return __uint_as_float((unsigned)h << 16); }
__device__ __forceinline__ float wave_sum(float v) {
    return add_x32(sum32(v));
}
__device__ __forceinline__ float rdl(float v, int l) { return __int_as_float(__builtin_amdgcn_readlane(__float_as_int(v), l)); }

struct TrDesc { const float* W; bf16* WT; int ldw, k0, src, nv, K, dst; };
__device__ __forceinline__ void tr_load(const TrDesc& d, f32x4 (&v)[8], int lane) {
    const int c4 = (lane & 7) * 4, kr = lane >> 3;
#pragma unroll
    for (int i = 0; i < 8; ++i) v[i] = (c4 < d.nv) ? *(const f32x4*)(d.W + (size_t)(d.k0 + kr + 8 * i) * d.ldw + d.src + c4) : (f32x4){0.f, 0.f, 0.f, 0.f};
}
__device__ __forceinline__ void tr_store(const TrDesc& d, const f32x4 (&v)[8], LAS float* scr, int lane) {
    const int c4 = (lane & 7) * 4, kr = lane >> 3;
#pragma unroll
    for (int i = 0; i < 8; ++i) *(LAS f32x4*)(scr + (kr + 8 * i) * 36 + c4) = v[i];
    LDS_WAIT(); asm volatile("" ::: "memory");
    const int c = lane & 7;
#pragma unroll
    for (int j = 0; j < 4; ++j) { const int n = (lane >> 3) + 8 * j; const LAS float* p = scr + (8 * c) * 36 + n;
        v4u o; o.x = pk2(p[0 * 36], p[1 * 36]); o.y = pk2(p[2 * 36], p[3 * 36]); o.z = pk2(p[4 * 36], p[5 * 36]); o.w = pk2(p[6 * 36], p[7 * 36]);
        *(GAS v4u*)(d.WT + (size_t)(d.dst + n) * d.K + d.k0 + 8 * c) = o; }
    LDS_WAIT(); asm volatile("" ::: "memory");
}

struct Ptrs {
    const float *x, *c, *ada_w, *ada_b, *norm1_g, *norm2_g, *w_in, *gla_wa2, *gla_ba, *gla_norm_g, *ret_norm_g, *w_out, *ffn_wg, *ffn_wu, *ffn_wd, *final_g;
    float* out; unsigned char* ws;
};

__device__ __forceinline__ void sincos_acc(float angf, float& s, float& c) {
    const double x = (double)angf;
    const double kq = __builtin_rint(x * 0.63661977236758134308);
    const double r = (x - kq * 1.57079632679489655800e+00) - kq * 6.12323399573676603587e-17;
    const double r2 = r * r;
    double sp = -1.0 / 1307674368000.0; sp = sp * r2 + 1.0 / 6227020800.0; sp = sp * r2 - 1.0 / 39916800.0; sp = sp * r2 + 1.0 / 362880.0; sp = sp * r2 - 1.0 / 5040.0; sp = sp * r2 + 1.0 / 120.0; sp = sp * r2 - 1.0 / 6.0; sp = sp * r2 + 1.0; sp *= r;
    double cp = 1.0 / 20922789888000.0; cp = cp * r2 - 1.0 / 87178291200.0; cp = cp * r2 + 1.0 / 479001600.0; cp = cp * r2 - 1.0 / 3628800.0; cp = cp * r2 + 1.0 / 40320.0; cp = cp * r2 - 1.0 / 720.0; cp = cp * r2 + 1.0 / 24.0; cp = cp * r2 - 0.5; cp = cp * r2 + 1.0;
    const int q = (int)kq & 3;
    const double sv = (q == 0) ? sp : (q == 1) ? cp : (q == 2) ? -sp : -cp;
    const double cv = (q == 0) ? cp : (q == 1) ? -sp : (q == 2) ? -cp : sp;
    s = (float)sv; c = (float)cv;
}

template <int DK, bool GLA>
__device__ __forceinline__ void seq_recurrent_v0(const bf16* Qp, const bf16* Kp, const bf16* Vp, const bf16* Gp, const float* GAp, const float* ng, bf16* OMp, int b, int h, int lane, int om_off) {
    float S[DK];
#pragma unroll
    for (int d = 0; d < DK; ++d) S[d] = 0.f;
    const float gam = GLA ? 0.f : (1.0f - exp2f(-5.0f - (float)h));
    const float ngv = ng[lane];
    const int dl = lane & (DK - 1);
    constexpr int LQK = DK * 4;
    size_t row = (size_t)b * SEQ;
    float qv = bf2f(Qp[row * LQK + h * DK + dl]), kv = bf2f(Kp[row * LQK + h * DK + dl]), av = GLA ? GAp[row * 128 + h * 32 + dl] : 0.f;
    float vv = bf2f(Vp[row * 256 + h * 64 + lane]), gv = bf2f(Gp[row * 256 + h * 64 + lane]);
    for (int t = 0; t < SEQ; ++t) {
        const size_t rn = (size_t)b * SEQ + (t + 1 < SEQ ? t + 1 : t);
        const float qn = bf2f(Qp[rn * LQK + h * DK + dl]), kn = bf2f(Kp[rn * LQK + h * DK + dl]), an = GLA ? GAp[rn * 128 + h * 32 + dl] : 0.f;
        const float vn = bf2f(Vp[rn * 256 + h * 64 + lane]), gn = bf2f(Gp[rn * 256 + h * 64 + lane]);
        float o = 0.f;
#pragma unroll
        for (int d = 0; d < DK; ++d) { const float kd = rdl(kv, d), qd = rdl(qv, d);
            if (GLA) { const float ad = rdl(av, d); S[d] = fmaf(kd, vv, ad * S[d]); } else { S[d] = fmaf(kd, vv, gam * S[d]); }
            o = fmaf(qd, S[d], o); }
        const float ms = wave_sum(o * o) * (1.0f / 64.0f);
        const float y = o * __builtin_amdgcn_rsqf(ms + 1e-6f) * ngv * (gv / (1.0f + __expf(-gv)));
        OMp[((size_t)b * SEQ + t) * DM + om_off + h * 64 + lane] = (bf16)f2bf(y);
        qv = qn; kv = kn; av = an; vv = vn; gv = gn;
    }
}

__device__ __forceinline__ void sb_unit_v0(const bf16* SQ, const bf16* SK, const bf16* SV, bf16* OM, int unit, int lane) {
    const int bh = unit >> 6, qb = unit & 63, b = bh >> 3, h = bh & 7;
    const int t = qb * 64 + lane; const size_t row = (size_t)b * SEQ + t;
    float q[64], o[64];
    { const v4u* qp = (const v4u*)(SQ + row * 512 + h * 64);
#pragma unroll
      for (int i = 0; i < 8; ++i) { const v4u w = qp[i];
          q[8 * i + 0] = __uint_as_float(w.x << 16); q[8 * i + 1] = __uint_as_float(w.x & 0xffff0000u); q[8 * i + 2] = __uint_as_float(w.y << 16); q[8 * i + 3] = __uint_as_float(w.y & 0xffff0000u);
          q[8 * i + 4] = __uint_as_float(w.z << 16); q[8 * i + 5] = __uint_as_float(w.z & 0xffff0000u); q[8 * i + 6] = __uint_as_float(w.w << 16); q[8 * i + 7] = __uint_as_float(w.w & 0xffff0000u); } }
#pragma unroll
    for (int i = 0; i < 64; ++i) o[i] = 0.f;
    float R = 0.f;
    for (int j = 1; j <= SEQ; ++j) {
        const bool act = (t - j >= 0) && (R > SB_THR);
        if (!__any(act)) break;
        if (act) {
            const v4u* kp = (const v4u*)(SK + (row - j) * 512 + h * 64);
            float z = 0.f;
#pragma unroll
            for (int i = 0; i < 8; ++i) { const v4u w = kp[i];
                z = fmaf(q[8 * i + 0], __uint_as_float(w.x << 16), z); z = fmaf(q[8 * i + 1], __uint_as_float(w.x & 0xffff0000u), z); z = fmaf(q[8 * i + 2], __uint_as_float(w.y << 16), z); z = fmaf(q[8 * i + 3], __uint_as_float(w.y & 0xffff0000u), z);
                z = fmaf(q[8 * i + 4], __uint_as_float(w.z << 16), z); z = fmaf(q[8 * i + 5], __uint_as_float(w.z & 0xffff0000u), z); z = fmaf(q[8 * i + 6], __uint_as_float(w.w << 16), z); z = fmaf(q[8 * i + 7], __uint_as_float(w.w & 0xffff0000u), z); }
            const float e = __expf(-fabsf(z)), l1p = __logf(1.0f + e);
            const float lsz = fminf(z, 0.f) - l1p, l1m = fminf(-z, 0.f) - l1p;
            const float w = __expf(lsz + R);
            const v4u* vp = (const v4u*)(SV + (row - j) * 512 + h * 64);
#pragma unroll
            for (int i = 0; i < 8; ++i) { const v4u x = vp[i];
                o[8 * i + 0] = fmaf(w, __uint_as_float(x.x << 16), o[8 * i + 0]); o[8 * i + 1] = fmaf(w, __uint_as_float(x.x & 0xffff0000u), o[8 * i + 1]); o[8 * i + 2] = fmaf(w, __uint_as_float(x.y << 16), o[8 * i + 2]); o[8 * i + 3] = fmaf(w, __uint_as_float(x.y & 0xffff0000u), o[8 * i + 3]);
                o[8 * i + 4] = fmaf(w, __uint_as_float(x.z << 16), o[8 * i + 4]); o[8 * i + 5] = fmaf(w, __uint_as_float(x.z & 0xffff0000u), o[8 * i + 5]); o[8 * i + 6] = fmaf(w, __uint_as_float(x.w << 16), o[8 * i + 6]); o[8 * i + 7] = fmaf(w, __uint_as_float(x.w & 0xffff0000u), o[8 * i + 7]); }
            R += l1m;
        }
    }
    v4u* op = (v4u*)(OM + row * DM + 512 + h * 64);
#pragma unroll
    for (int i = 0; i < 8; ++i) { v4u w; w.x = pk2(o[8 * i + 0], o[8 * i + 1]); w.y = pk2(o[8 * i + 2], o[8 * i + 3]); w.z = pk2(o[8 * i + 4], o[8 * i + 5]); w.w = pk2(o[8 * i + 6], o[8 * i + 7]); op[i] = w; }
}

typedef short v4i16_t __attribute__((ext_vector_type(4)));
typedef float f32x16 __attribute__((ext_vector_type(16)));
typedef float f32x2_t __attribute__((ext_vector_type(2)));
#define MFMA32(a, b, c) __builtin_amdgcn_mfma_f32_32x32x16_bf16((a), (b), (c), 0, 0, 0)
__device__ __forceinline__ int crow(int r, int hi) { return (r & 3) + 8 * (r >> 2) + 4 * hi; }
__device__ __forceinline__ int tr_lane_off(int lane) { return ((lane >> 4) & 1) * 32 + (lane & 3) * 8 + (4 * (lane >> 5) + ((lane & 15) >> 2)) * 64; }
__device__ __forceinline__ bf16x8 frag_tr(LAS unsigned char* p) {
    const v4i16_t lo = __builtin_amdgcn_ds_read_tr16_b64_v4i16((LAS v4i16_t*)p);
    const v4i16_t hi = __builtin_amdgcn_ds_read_tr16_b64_v4i16((LAS v4i16_t*)(p + 512));
    return (bf16x8){lo[0], lo[1], lo[2], lo[3], hi[0], hi[1], hi[2], hi[3]};
}
__device__ __forceinline__ void stage_row64(LAS unsigned char* slot, const bf16* src, int lane) {
    const v4u* sp = (const v4u*)src; v4u w[8];
#pragma unroll
    for (int j = 0; j < 8; ++j) w[j] = sp[j];
    LAS unsigned char* base = slot + (lane >> 4) * 1024 + (lane & 15) * 64;
#pragma unroll
    for (int j = 0; j < 8; ++j) *(LAS v4u*)(base + (j >> 2) * 4096 + (j & 3) * 16) = w[j];
}
__device__ __forceinline__ void unpack8(const v4u w, float* f) {
    f[0] = __uint_as_float(w.x << 16); f[1] = __uint_as_float(w.x & 0xffff0000u); f[2] = __uint_as_float(w.y << 16); f[3] = __uint_as_float(w.y & 0xffff0000u);
    f[4] = __uint_as_float(w.z << 16); f[5] = __uint_as_float(w.z & 0xffff0000u); f[6] = __uint_as_float(w.w << 16); f[7] = __uint_as_float(w.w & 0xffff0000u);
}
__device__ __forceinline__ v4u pack8f(const float* f) { v4u w; w.x = pg8::cvt_pk_bf16(f[0], f[1]); w.y = pg8::cvt_pk_bf16(f[2], f[3]); w.z = pg8::cvt_pk_bf16(f[4], f[5]); w.w = pg8::cvt_pk_bf16(f[6], f[7]); return w; }
__device__ __forceinline__ bf16x8 packP(const f32x16& P, int b0) {
    v4u w; w.x = pg8::cvt_pk_bf16(P[b0 + 0], P[b0 + 1]); w.y = pg8::cvt_pk_bf16(P[b0 + 2], P[b0 + 3]); w.z = pg8::cvt_pk_bf16(P[b0 + 4], P[b0 + 5]); w.w = pg8::cvt_pk_bf16(P[b0 + 6], P[b0 + 7]);
    return __builtin_bit_cast(bf16x8, w);
}
__device__ __forceinline__ float ret_log2_gamma(int h) { return log2f(1.0f - exp2f(-5.0f - (float)h)); }

struct SumPre { v4u v[8], k[8]; };
template <int DK, bool GLA, bool PREF = false, bool HAVE = false>
__device__ __forceinline__ void chunk_sum_unit(int ch, bf16* Qp, bf16* Kp, const bf16* Vp, const float* GRp, const float* wa2, const float* ba, float* KVT, float* DEC, LAS unsigned char* wlds, int lane,
                                               SumPre* pre = nullptr, const bf16* Kn = nullptr, const bf16* Vn = nullptr) {
    asm volatile("" : "+v"(lane));
    const int b = ch >> 8, h = (ch >> 6) & 3, n = ch & 63; const size_t row = (size_t)b * SEQ + n * 64 + lane;
    constexpr int LQK = DK * 4;
    LAS unsigned char* vslot = wlds; LAS unsigned char* kslot = wlds + 8192;
    constexpr int PQ = DK / 8;
    constexpr int RQ_ = 64 / PQ;
    const size_t R0 = (size_t)b * SEQ + n * 64;
    const int pv = lane & 7, rv = lane >> 3;
    const int pq = lane & (PQ - 1), rq = lane / PQ;
    v4u vraw[8], kraw[PQ], qraw[PQ];
    float w[16], bias = 0.f;
    f32x4 grv[4];
    if (GLA) {
#pragma unroll
        for (int r = 0; r < 16; ++r) w[r] = wa2[r * 128 + h * 32 + (lane & 31)];
        bias = ba[h * 32 + (lane & 31)];
#pragma unroll
        for (int j = 0; j < 4; ++j) grv[j] = *(const f32x4*)(GRp + R0 * 16 + (size_t)(j * 64 + lane) * 4); }
    if (HAVE) {
#pragma unroll
        for (int i = 0; i < 8; ++i) vraw[i] = pre->v[i];
#pragma unroll
        for (int i = 0; i < PQ; ++i) kraw[i] = pre->k[i & 7];
    } else {
#pragma unroll
    for (int i = 0; i < 8; ++i) vraw[i] = *(const v4u*)(Vp + (R0 + 8 * i + rv) * 256 + h * 64 + 8 * pv);
#pragma unroll
    for (int i = 0; i < PQ; ++i) { const size_t o = (R0 + RQ_ * i + rq) * LQK + h * DK + 8 * pq;
        kraw[i] = *(const v4u*)(Kp + o); if (GLA) qraw[i] = *(const v4u*)(Qp + o); }
    }
    if (PREF) {
#pragma unroll
        for (int i = 0; i < 8; ++i) { pre->v[i] = *(const v4u*)(Vn + (R0 + 8 * i + rv) * 256 + h * 64 + 8 * pv); pre->k[i] = *(const v4u*)(Kn + (R0 + 8 * i + rv) * 256 + h * 64 + 8 * pv); }
    }
    float ebls = 1.f, l2g = 0.f;
    LAS float* BT = (LAS float*)wlds; LAS float* grl = (LAS float*)(wlds + 12288); LAS float* T0 = (LAS float*)(wlds + 12288);
    if (GLA) {
#pragma unroll
        for (int j = 0; j < 4; ++j) *(LAS f32x4*)(grl + (j * 64 + lane) * 4) = grv[j];
        const int c = lane & 31, half = lane >> 5;
        asm volatile("s_waitcnt lgkmcnt(0)" ::: "memory");
        float run = 0.f;
#pragma unroll 4
        for (int tt = 0; tt < 32; ++tt) {
            const int t = half * 32 + tt;
            const f32x4 g0 = *(const LAS f32x4*)(grl + t * 16), g1 = *(const LAS f32x4*)(grl + t * 16 + 4), g2 = *(const LAS f32x4*)(grl + t * 16 + 8), g3 = *(const LAS f32x4*)(grl + t * 16 + 12);
            float u = bias;
            u = fmaf(g0[0], w[0], u); u = fmaf(g0[1], w[1], u); u = fmaf(g0[2], w[2], u); u = fmaf(g0[3], w[3], u);
            u = fmaf(g1[0], w[4], u); u = fmaf(g1[1], w[5], u); u = fmaf(g1[2], w[6], u); u = fmaf(g1[3], w[7], u);
            u = fmaf(g2[0], w[8], u); u = fmaf(g2[1], w[9], u); u = fmaf(g2[2], w[10], u); u = fmaf(g2[3], w[11], u);
            u = fmaf(g3[0], w[12], u); u = fmaf(g3[1], w[13], u); u = fmaf(g3[2], w[14], u); u = fmaf(g3[3], w[15], u);
            run += (fminf(u, 0.f) - __logf(1.0f + __expf(-fabsf(u)))) * (1.0f / 16.0f);
            BT[t * 32 + c] = run;
        }
        asm volatile("s_waitcnt lgkmcnt(0)" ::: "memory");
        if (half == 0) T0[c] = run;
        asm volatile("s_waitcnt lgkmcnt(0)" ::: "memory");
    } else {
        l2g = ret_log2_gamma(h); ebls = exp2f(64.0f * l2g);
    }
#pragma unroll
    for (int i = 0; i < PQ; ++i) {
        const int r = RQ_ * i + rq;
        float kk[8], qq[8], kh[8], e8[8], el8[8];
        if (GLA) {
            const f32x4 b0 = *(const LAS f32x4*)(BT + r * 32 + 8 * pq), b1 = *(const LAS f32x4*)(BT + r * 32 + 8 * pq + 4);
            const f32x4 t0 = *(const LAS f32x4*)(T0 + 8 * pq), t1 = *(const LAS f32x4*)(T0 + 8 * pq + 4);
            const f32x4 l0 = *(const LAS f32x4*)(BT + 63 * 32 + 8 * pq) + t0, l1 = *(const LAS f32x4*)(BT + 63 * 32 + 8 * pq + 4) + t1;
            const float addt = (r >= 32) ? 1.0f : 0.0f;
#pragma unroll
            for (int e = 0; e < 4; ++e) { e8[e] = __expf(b0[e] + addt * t0[e]); e8[4 + e] = __expf(b1[e] + addt * t1[e]); el8[e] = __expf(l0[e]); el8[4 + e] = __expf(l1[e]); }
            if (i == 0 && rq == 0) { *(f32x4*)(DEC + (size_t)(b * 64 + n) * 128 + h * 32 + 8 * pq) = (f32x4){el8[0], el8[1], el8[2], el8[3]}; *(f32x4*)(DEC + (size_t)(b * 64 + n) * 128 + h * 32 + 8 * pq + 4) = (f32x4){el8[4], el8[5], el8[6], el8[7]}; }
        }
        unpack8(kraw[i], kk); if (GLA) unpack8(qraw[i], qq);
        const float iebs = GLA ? 1.f : exp2f(-(float)(r + 1) * l2g);
#pragma unroll
        for (int e = 0; e < 8; ++e) {
            if (GLA) { qq[e] *= e8[e]; kk[e] *= __builtin_amdgcn_rcpf(e8[e]); kh[e] = kk[e] * el8[e]; }
            else { kk[e] *= iebs; kh[e] = kk[e] * ebls; }
        }
        if (GLA) { const size_t o = (R0 + r) * LQK + h * DK + 8 * pq; *(v4u*)(Qp + o) = pack8f(qq); *(v4u*)(Kp + o) = pack8f(kk); }
        *(LAS v4u*)(kslot + (pq >> 2) * 4096 + (r >> 4) * 1024 + (r & 15) * 64 + (pq & 3) * 16) = pack8f(kh);
    }
    asm volatile("s_waitcnt lgkmcnt(0)" ::: "memory");
#pragma unroll
    for (int i = 0; i < 8; ++i) { const int r = 8 * i + rv; *(LAS v4u*)(vslot + (pv >> 2) * 4096 + (r >> 4) * 1024 + (r & 15) * 64 + (pv & 3) * 16) = vraw[i]; }
    asm volatile("s_waitcnt lgkmcnt(0)" ::: "memory");
    const int hi = lane >> 5, tro = tr_lane_off(lane);
    f32x16 acc[2][DK / 32];
#pragma unroll
    for (int eh = 0; eh < 2; ++eh)
#pragma unroll
        for (int dh = 0; dh < DK / 32; ++dh) acc[eh][dh] = (f32x16){0.f, 0.f, 0.f, 0.f, 0.f, 0.f, 0.f, 0.f, 0.f, 0.f, 0.f, 0.f, 0.f, 0.f, 0.f, 0.f};
#pragma unroll
    for (int rg = 0; rg < 4; ++rg) {
        bf16x8 vf[2], kf[DK / 32];
#pragma unroll
        for (int eh = 0; eh < 2; ++eh) vf[eh] = frag_tr(vslot + eh * 4096 + rg * 1024 + tro);
#pragma unroll
        for (int dh = 0; dh < DK / 32; ++dh) kf[dh] = frag_tr(kslot + dh * 4096 + rg * 1024 + tro);
#pragma unroll
        for (int eh = 0; eh < 2; ++eh)
#pragma unroll
            for (int dh = 0; dh < DK / 32; ++dh) acc[eh][dh] = MFMA32(vf[eh], kf[dh], acc[eh][dh]);
    }
    unsigned short* kvp = (unsigned short*)KVT + (size_t)ch * (64 * DK);
#pragma unroll
    for (int eh = 0; eh < 2; ++eh)
#pragma unroll
        for (int dh = 0; dh < DK / 32; ++dh)
#pragma unroll
            for (int r = 0; r < 16; ++r) kvp[(32 * eh + crow(r, hi)) * DK + 32 * dh + (lane & 31)] = (unsigned short)f2bf(acc[eh][dh][r]);
    asm volatile("s_waitcnt lgkmcnt(0)" ::: "memory");
}

template <int DK, bool GLA>
__device__ __forceinline__ void scan_unit(int seq, int part, const float* KVT, const float* DEC, bf16* ST, int lane) {
    const int idx = part * 128 + lane * 2; const int d = idx & (DK - 1);
    const int b = seq >> 2, h = seq & 3;
    float s0 = 0.f, s1 = 0.f;
    const float gdec = GLA ? 0.f : exp2f(64.0f * ret_log2_gamma(h));
    for (int n0 = 0; n0 < 64; n0 += 32) {
        float kv0[32], kv1[32], d0[32], d1[32];
#pragma unroll
        for (int i = 0; i < 32; ++i) { const size_t chn = (size_t)seq * 64 + n0 + i;
            const unsigned kvw = *(const unsigned*)((const unsigned short*)KVT + chn * (64 * DK) + idx); kv0[i] = __uint_as_float(kvw << 16); kv1[i] = __uint_as_float(kvw & 0xffff0000u);
            if (GLA) { const f32x2_t dd = *(const f32x2_t*)(DEC + (size_t)(b * 64 + n0 + i) * 128 + h * 32 + d); d0[i] = dd.x; d1[i] = dd.y; } else { d0[i] = gdec; d1[i] = gdec; } }
#pragma unroll
        for (int i = 0; i < 32; ++i) { const size_t chn = (size_t)seq * 64 + n0 + i;
            *(unsigned*)(ST + chn * (64 * DK) + idx) = pg8::cvt_pk_bf16(s0, s1);
            s0 = fmaf(d0[i], s0, kv0[i]); s1 = fmaf(d1[i], s1, kv1[i]); }
    }
}

template <int DK>
__device__ __forceinline__ void chunk_out_unit(int ch, const bf16* Qp, const bf16* Kp, const bf16* Vp, const bf16* Gp, const bf16* ST, const float* ng, bf16* OMp, int om_off, LAS unsigned char* wlds, LAS float* ngl, int lane) {
    asm volatile("" : "+v"(lane));
    const float ngv = ng[lane];
    const int b = ch >> 8, h = (ch >> 6) & 3, n = ch & 63; const size_t R0 = (size_t)b * SEQ + n * 64;
    constexpr int LQK = DK * 4, NKS = DK / 16;
    const int hi = lane >> 5, l31 = lane & 31, tro = tr_lane_off(lane);
    LAS unsigned char* vslot = wlds;
    bf16x8 qf[2][NKS], kf[2][NKS], sf[NKS][2];
    v4u graw[2][4];
#pragma unroll
    for (int tb = 0; tb < 2; ++tb)
#pragma unroll
        for (int i = 0; i < 4; ++i) graw[tb][i] = *(const v4u*)(Gp + (R0 + 32 * tb + 8 * i + (lane >> 3)) * 256 + h * 64 + 8 * (lane & 7));
    constexpr int PQ = DK / 8, RQ_ = 64 / PQ;
    const int pq = lane & (PQ - 1), rq = lane / PQ, pv = lane & 7, rv = lane >> 3;
    v4u qraw[PQ], kraw[PQ], sraw[PQ], vrow[8];
#pragma unroll
    for (int i = 0; i < PQ; ++i) { const size_t o = (R0 + RQ_ * i + rq) * LQK + h * DK + 8 * pq;
        qraw[i] = *(const v4u*)(Qp + o); kraw[i] = *(const v4u*)(Kp + o);
        sraw[i] = *(const v4u*)(ST + (size_t)ch * (64 * DK) + (RQ_ * i + rq) * DK + 8 * pq); }
#pragma unroll
    for (int i = 0; i < 8; ++i) vrow[i] = *(const v4u*)(Vp + (R0 + 8 * i + rv) * 256 + h * 64 + 8 * pv);
    asm volatile("" ::: "memory");
    {
        LAS unsigned char* img = wlds + 8192;
#define CO_PUT(raw) { _Pragma("unroll") for (int i = 0; i < PQ; ++i) { const int r = RQ_ * i + rq; *(LAS v4u*)(img + (pq >> 2) * 4096 + (r >> 4) * 1024 + (r & 15) * 64 + (pq & 3) * 16) = raw[i]; } }
#define CO_FRAG(row, piece) (*(const LAS bf16x8*)(img + ((piece) >> 2) * 4096 + ((row) >> 4) * 1024 + ((row) & 15) * 64 + ((piece) & 3) * 16))
        CO_PUT(qraw) asm volatile("s_waitcnt lgkmcnt(0)" ::: "memory");
#pragma unroll
        for (int half = 0; half < 2; ++half)
#pragma unroll
            for (int ks = 0; ks < NKS; ++ks) qf[half][ks] = CO_FRAG(32 * half + l31, 2 * ks + hi);
        asm volatile("s_waitcnt lgkmcnt(0)" ::: "memory");
        CO_PUT(kraw) asm volatile("s_waitcnt lgkmcnt(0)" ::: "memory");
#pragma unroll
        for (int half = 0; half < 2; ++half)
#pragma unroll
            for (int ks = 0; ks < NKS; ++ks) kf[half][ks] = CO_FRAG(32 * half + l31, 2 * ks + hi);
        asm volatile("s_waitcnt lgkmcnt(0)" ::: "memory");
        CO_PUT(sraw) asm volatile("s_waitcnt lgkmcnt(0)" ::: "memory");
#pragma unroll
        for (int ks = 0; ks < NKS; ++ks)
#pragma unroll
            for (int dh = 0; dh < 2; ++dh) sf[ks][dh] = CO_FRAG(32 * dh + l31, 2 * ks + hi);
        asm volatile("s_waitcnt lgkmcnt(0)" ::: "memory");
#undef CO_PUT
#undef CO_FRAG
#pragma unroll
        for (int i = 0; i < 8; ++i) { const int r = 8 * i + rv; *(LAS v4u*)(vslot + (pv >> 2) * 4096 + (r >> 4) * 1024 + (r & 15) * 64 + (pv & 3) * 16) = vrow[i]; }
    }
    ngl[lane] = ngv;
    asm volatile("s_waitcnt lgkmcnt(0)" ::: "memory");
    if (DK == 64) {
        const float l2g = ret_log2_gamma(h);
#pragma unroll
        for (int half = 0; half < 2; ++half) { const float tq = (float)(32 * half + l31 + 1); const float sq_ = exp2f(tq * l2g), sk_ = exp2f(-tq * l2g);
#pragma unroll
            for (int ks = 0; ks < NKS; ++ks) { float f[8];
                unpack8(__builtin_bit_cast(v4u, qf[half][ks]), f);
#pragma unroll
                for (int e = 0; e < 8; ++e) f[e] *= sq_;
                qf[half][ks] = __builtin_bit_cast(bf16x8, pack8f(f));
                unpack8(__builtin_bit_cast(v4u, kf[half][ks]), f);
#pragma unroll
                for (int e = 0; e < 8; ++e) f[e] *= sk_;
                kf[half][ks] = __builtin_bit_cast(bf16x8, pack8f(f)); } }
    }
#pragma unroll
    for (int tb = 0; tb < 2; ++tb) {
        f32x16 o0 = (f32x16){0.f, 0.f, 0.f, 0.f, 0.f, 0.f, 0.f, 0.f, 0.f, 0.f, 0.f, 0.f, 0.f, 0.f, 0.f, 0.f}, o1 = o0;
#pragma unroll
        for (int ks = 0; ks < NKS; ++ks) { o0 = MFMA32(qf[tb][ks], sf[ks][0], o0); o1 = MFMA32(qf[tb][ks], sf[ks][1], o1); }
#pragma unroll
        for (int kh = 0; kh <= tb; ++kh) {
            f32x16 P = (f32x16){0.f, 0.f, 0.f, 0.f, 0.f, 0.f, 0.f, 0.f, 0.f, 0.f, 0.f, 0.f, 0.f, 0.f, 0.f, 0.f};
#pragma unroll
            for (int ks = 0; ks < NKS; ++ks) P = MFMA32(kf[kh][ks], qf[tb][ks], P);
            if (kh == tb) {
#pragma unroll
                for (int r = 0; r < 16; ++r) if (crow(r, hi) > l31) P[r] = 0.f;
            }
            const bf16x8 pa0 = packP(P, 0), pa1 = packP(P, 8);
            const bf16x8 v00 = frag_tr(vslot + 0 * 4096 + (2 * kh) * 1024 + tro), v01 = frag_tr(vslot + 0 * 4096 + (2 * kh + 1) * 1024 + tro);
            const bf16x8 v10 = frag_tr(vslot + 1 * 4096 + (2 * kh) * 1024 + tro), v11 = frag_tr(vslot + 1 * 4096 + (2 * kh + 1) * 1024 + tro);
            o0 = MFMA32(pa0, v00, o0); o0 = MFMA32(pa1, v01, o0);
            o1 = MFMA32(pa0, v10, o1); o1 = MFMA32(pa1, v11, o1);
        }
        {
            LAS float* OT = (LAS float*)(wlds + 8192);
#pragma unroll
            for (int r = 0; r < 16; ++r) { const int tt = crow(r, hi); OT[tt * 64 + (l31 ^ ((tt & 7) << 2))] = o0[r]; OT[tt * 64 + ((32 + l31) ^ ((tt & 7) << 2))] = o1[r]; }
            asm volatile("s_waitcnt lgkmcnt(0)" ::: "memory");
            const int pp = lane & 7;
            const f32x4 n0 = *(const LAS f32x4*)(ngl + 8 * pp), n1 = *(const LAS f32x4*)(ngl + 8 * pp + 4);
#pragma unroll
            for (int i = 0; i < 4; ++i) { const int rr = 8 * i + (lane >> 3); const int sw = (rr & 7) << 2;
                const f32x4 x0 = *(const LAS f32x4*)(OT + rr * 64 + ((8 * pp) ^ sw)), x1 = *(const LAS f32x4*)(OT + rr * 64 + ((8 * pp + 4) ^ sw));
                float sq = (x0[0] * x0[0] + x0[1] * x0[1]) + (x0[2] * x0[2] + x0[3] * x0[3]) + (x1[0] * x1[0] + x1[1] * x1[1]) + (x1[2] * x1[2] + x1[3] * x1[3]);
                sq += shx<1>(sq); sq += shx<2>(sq); sq += shx<4>(sq);
                const float rs = __builtin_amdgcn_rsqf(sq * (1.0f / 64.0f) + 1e-6f);
                float g[8], y[8]; unpack8(graw[tb][i], g);
#pragma unroll
                for (int e = 0; e < 8; ++e) { const float nn = (e < 4) ? n0[e & 3] : n1[e & 3]; const float xv = (e < 4) ? x0[e & 3] : x1[e & 3]; y[e] = xv * rs * nn * (g[e] * __builtin_amdgcn_rcpf(1.0f + __expf(-g[e]))); }
                *(v4u*)(OMp + (R0 + 32 * tb + rr) * DM + om_off + h * 64 + 8 * pp) = pack8f(y); }
            asm volatile("s_waitcnt lgkmcnt(0)" ::: "memory");
        }
    }
    asm volatile("s_waitcnt lgkmcnt(0)" ::: "memory");
}

struct SbK { bf16x8 a0[4], a1[4]; };
__device__ __forceinline__ void sb_dma_k(const bf16* SK, size_t rowbase, int s0, int h, int lane, LAS unsigned char* kslot) {
    const char* kb = (const char*)(SK + (rowbase + s0) * 512 + h * 64); const unsigned voff = (unsigned)(lane >> 3) * 1024u + (unsigned)((lane & 7) ^ (lane >> 3)) * 16u;
#pragma unroll
    for (int c = 0; c < 8; ++c) __builtin_amdgcn_global_load_lds((const unsigned*)(kb + c * 8192 + voff), (LAS unsigned*)(kslot + c * 1024), 16, 0, 0);
}
__device__ __forceinline__ void sb_dma_v(const bf16* SV, size_t rowbase, int s0, int h, int lane, LAS unsigned char* vslot) {
    const char* vb = (const char*)(SV + (rowbase + s0) * 512 + h * 64); const unsigned voff = (unsigned)(lane >> 2) * 1024u + (unsigned)(lane & 3) * 16u;
#pragma unroll
    for (int p = 0; p < 8; ++p)
        __builtin_amdgcn_global_load_lds((const unsigned*)(vb + (16 * (p & 3)) * 1024 + (p >> 2) * 64 + voff), (LAS unsigned*)(vslot + p * 1024), 16, 0, 0);
}
__device__ __forceinline__ void sb_read_k(SbK& k, LAS unsigned char* kslot, int lane) {
    const int l31 = lane & 31, hi = lane >> 5;
#pragma unroll
    for (int ks = 0; ks < 4; ++ks) { const int slot = (2 * ks + hi) ^ (l31 & 7);
        k.a0[ks] = *(const LAS bf16x8*)(kslot + l31 * 128 + slot * 16); k.a1[ks] = *(const LAS bf16x8*)(kslot + 4096 + l31 * 128 + slot * 16); }
}
template <bool DIAG>
__device__ __forceinline__ void sb_half(const bf16x8 (&ka)[4], const bf16x8 (&qr)[4], float& suf, int sbase, int t, int hi, bf16x8& paLo, bf16x8& paHi) {
    f32x16 p = (f32x16){0.f, 0.f, 0.f, 0.f, 0.f, 0.f, 0.f, 0.f, 0.f, 0.f, 0.f, 0.f, 0.f, 0.f, 0.f, 0.f};
#pragma unroll
    for (int ks = 0; ks < 4; ++ks) p = MFMA32(ka[ks], qr[ks], p);
    float om[16];
#pragma unroll
    for (int r = 0; r < 16; ++r) {
        const float e = __builtin_amdgcn_exp2f(-fmaxf(p[r], -100.0f)); float sg = __builtin_amdgcn_rcpf(1.0f + e), o1 = e * sg;
        if (DIAG) { const bool ok = (sbase + crow(r, hi) < t); sg = ok ? sg : 0.f; o1 = ok ? o1 : 1.0f; }
        p[r] = sg; om[r] = o1;
    }
    float G[4], H[4], sg4[4];
#pragma unroll
    for (int q = 0; q < 4; ++q) G[q] = (om[4 * q] * om[4 * q + 1]) * (om[4 * q + 2] * om[4 * q + 3]);
#pragma unroll
    for (int q = 0; q < 4; ++q) H[q] = get_x32(G[q], hi);
#pragma unroll
    for (int q = 3; q >= 0; --q) { if (hi == 1) { sg4[q] = suf; suf *= G[q]; suf *= H[q]; } else { suf *= H[q]; sg4[q] = suf; suf *= G[q]; } }
#pragma unroll
    for (int q = 0; q < 4; ++q) { float s = sg4[q];
        p[4 * q + 3] *= s; s *= om[4 * q + 3]; p[4 * q + 2] *= s; s *= om[4 * q + 2]; p[4 * q + 1] *= s; s *= om[4 * q + 1]; p[4 * q] *= s; }
    paLo = packP(p, 0); paHi = packP(p, 8);
}
template <bool DIAG, int BLK>
__device__ __forceinline__ void sb_tile(const SbK& k, const bf16x8 (&qr)[4], LAS unsigned char* slot, f32x16& o0, f32x16& o1, float& R, int s0, int t, int hi, int tro) {
    float suf = R; bf16x8 paLo, paHi;
    if (!(DIAG && BLK == 0)) {
    sb_half<DIAG>(k.a1, qr, suf, s0 + 32, t, hi, paLo, paHi);
    o0 = MFMA32(paLo, frag_tr(slot + 2 * 1024 + tro), o0); o1 = MFMA32(paLo, frag_tr(slot + 4096 + 2 * 1024 + tro), o1);
    o0 = MFMA32(paHi, frag_tr(slot + 3 * 1024 + tro), o0); o1 = MFMA32(paHi, frag_tr(slot + 4096 + 3 * 1024 + tro), o1);
    }
    sb_half<(DIAG && BLK == 0)>(k.a0, qr, suf, s0, t, hi, paLo, paHi);
    o0 = MFMA32(paLo, frag_tr(slot + 0 * 1024 + tro), o0); o1 = MFMA32(paLo, frag_tr(slot + 4096 + 0 * 1024 + tro), o1);
    o0 = MFMA32(paHi, frag_tr(slot + 1 * 1024 + tro), o0); o1 = MFMA32(paHi, frag_tr(slot + 4096 + 1 * 1024 + tro), o1);
    R = suf;
}
template <bool DIAG>
__device__ __forceinline__ void sb_iter(const bf16* SK, const bf16* SV, size_t rowbase, int j, int h, int lane, LAS unsigned char* kslot, LAS unsigned char* vslot,
                                        const bf16x8 (&qrA)[4], const bf16x8 (&qrB)[4], f32x16& oA0, f32x16& oA1, f32x16& oB0, f32x16& oB1, float& RA, float& RB, bool& doneA, bool& doneB, int tA, int hi, int tro) {
    asm volatile("s_waitcnt vmcnt(8)" ::: "memory");
    SbK k; sb_read_k(k, kslot, lane);
    asm volatile("s_waitcnt lgkmcnt(0)" ::: "memory");
    if (j > 0) { sb_dma_k(SK, rowbase, (j - 1) * 64, h, lane, kslot); asm volatile("s_waitcnt vmcnt(8)" ::: "memory"); }
    else asm volatile("s_waitcnt vmcnt(0)" ::: "memory");
    if (!doneA) { sb_tile<DIAG, 0>(k, qrA, vslot, oA0, oA1, RA, j * 64, tA, hi, tro); doneA = __all(RA < SB_PMIN); }
    if (!doneB) { sb_tile<DIAG, 1>(k, qrB, vslot, oB0, oB1, RB, j * 64, tA + 32, hi, tro); doneB = __all(RB < SB_PMIN); }
    asm volatile("s_waitcnt lgkmcnt(0)" ::: "memory");
    if (j > 0) sb_dma_v(SV, rowbase, (j - 1) * 64, h, lane, vslot);
}
__device__ __forceinline__ void sb_unit_v1(int unit, const bf16* SQ, const bf16* SK, const bf16* SV, bf16* OM, LAS unsigned char* wlds, int lane) {
    asm volatile("" : "+v"(lane));
    const int bh = unit >> 6, qb = unit & 63, b = bh >> 3, h = bh & 7;
    const int hi = lane >> 5, l31 = lane & 31, tro = tr_lane_off(lane);
    const size_t rowbase = (size_t)b * SEQ; const int t0 = qb * 64; const int tA = t0 + l31;
    LAS unsigned char* kslot = wlds; LAS unsigned char* vslot = wlds + 8192;
    asm volatile("s_waitcnt lgkmcnt(0)" ::: "memory");
    int j = qb;
    sb_dma_k(SK, rowbase, j * 64, h, lane, kslot); sb_dma_v(SV, rowbase, j * 64, h, lane, vslot);
    bf16x8 qrA[4], qrB[4];
#pragma unroll
    for (int ks = 0; ks < 4; ++ks) { qrA[ks] = *(const bf16x8*)(SQ + (rowbase + tA) * 512 + h * 64 + 16 * ks + 8 * hi); qrB[ks] = *(const bf16x8*)(SQ + (rowbase + tA + 32) * 512 + h * 64 + 16 * ks + 8 * hi); }
    const f32x16 zero16 = (f32x16){0.f, 0.f, 0.f, 0.f, 0.f, 0.f, 0.f, 0.f, 0.f, 0.f, 0.f, 0.f, 0.f, 0.f, 0.f, 0.f};
    f32x16 oA0 = zero16, oA1 = zero16, oB0 = zero16, oB1 = zero16;
    float RA = 1.0f, RB = 1.0f; bool doneA = false, doneB = false;
    sb_iter<true>(SK, SV, rowbase, j, h, lane, kslot, vslot, qrA, qrB, oA0, oA1, oB0, oB1, RA, RB, doneA, doneB, tA, hi, tro);
    while (j > 0 && !(doneA && doneB)) {
        --j;
        sb_iter<false>(SK, SV, rowbase, j, h, lane, kslot, vslot, qrA, qrB, oA0, oA1, oB0, oB1, RA, RB, doneA, doneB, tA, hi, tro);
    }
    asm volatile("s_waitcnt vmcnt(0) lgkmcnt(0)" ::: "memory");
    { LAS float* OT = (LAS float*)wlds;
#pragma unroll
      for (int r = 0; r < 16; ++r) { const int tt = crow(r, hi); const int sw = (tt & 7) << 2;
          OT[tt * 64 + (l31 ^ sw)] = oA0[r]; OT[tt * 64 + ((32 + l31) ^ sw)] = oA1[r]; OT[2048 + tt * 64 + (l31 ^ sw)] = oB0[r]; OT[2048 + tt * 64 + ((32 + l31) ^ sw)] = oB1[r]; }
      asm volatile("s_waitcnt lgkmcnt(0)" ::: "memory");
      const int pp = lane & 7;
#pragma unroll
      for (int i = 0; i < 8; ++i) { const int rr = 8 * i + (lane >> 3);
          const int sw = (rr & 7) << 2; const LAS float* src = OT + (rr >> 5) * 2048 + (rr & 31) * 64;
          const f32x4 x0 = *(const LAS f32x4*)(src + ((8 * pp) ^ sw)), x1 = *(const LAS f32x4*)(src + ((8 * pp + 4) ^ sw));
          float y[8] = {x0[0], x0[1], x0[2], x0[3], x1[0], x1[1], x1[2], x1[3]};
          *(v4u*)(OM + (rowbase + t0 + rr) * DM + 512 + h * 64 + 8 * pp) = pack8f(y); }
      asm volatile("s_waitcnt lgkmcnt(0)" ::: "memory"); }
}

__device__ __forceinline__ int lane_now() { int l; asm volatile("v_mbcnt_lo_u32_b32 %0, -1, 0\n\tv_mbcnt_hi_u32_b32 %0, -1, %0" : "=v"(l)); return l; }
struct Args { const float* in[16]; float* out; unsigned char* ws; int ph_lo, ph_hi; };
__global__ void __launch_bounds__(NWAVES * 64, 2) mk_fwd(Args args) {
    extern __shared__ __attribute__((aligned(16))) unsigned char lds_raw[];
    LAS unsigned char* lds = (LAS unsigned char*)lds_raw;
    volatile LAS unsigned* MISC = (volatile LAS unsigned*)(lds + MISC_OFF);
    const int wave_k = __builtin_amdgcn_readfirstlane((int)threadIdx.x >> 6);
#define TID_NOW() (wave_k * 64 + lane_now())
    const int G = gridDim.x; const int bx = blockIdx.x; const int NGW = G * NWAVES;
    int bxe = bx, lmode = 0;
    typedef __attribute__((address_space(4))) const unsigned long long kargw_t;
    const kargw_t* kargs = (const kargw_t*)__builtin_amdgcn_kernarg_segment_ptr();
#define PH_BEGIN() const kargw_t* kq_ = kargs; asm volatile("" : "+s"(kq_)); int tid = TID_NOW(); asm volatile("" : "+v"(tid)); const int lane = tid & 63, wave = __builtin_amdgcn_readfirstlane(tid >> 6); \
    const int vcu = (G % 8 == 0) ? (bxe % 8) * (G / 8) + bxe / 8 : bxe; const int gw = vcu * NWAVES + wave; (void)lane; (void)wave; (void)vcu; (void)gw; \
    unsigned char* ws = (unsigned char*)(GAS unsigned char*)kq_[17]; float* out = (float*)(GAS float*)kq_[16]; (void)out; \
    gu32* ctl = (gu32*)(ws + WS_CTL); (void)ctl; unsigned long long* SS = (unsigned long long*)(ws + WS_SS); float* MOD = (float*)(ws + WS_MOD); float* CBIN = (float*)(ws + WS_CBIN); float* CBUP = (float*)(ws + WS_CBUP); float* ROT = (float*)(ws + WS_ROT); \
    bf16 *WIN = (bf16*)(ws + WS_WIN), *WOUT = (bf16*)(ws + WS_WOUT), *WUP = (bf16*)(ws + WS_WUP), *WDN = (bf16*)(ws + WS_WDN); \
    bf16 *XA = (bf16*)(ws + WS_XA), *OM = (bf16*)(ws + WS_OM), *HB = (bf16*)(ws + WS_HB); \
    const size_t bq_ = (size_t)(gw >> 8);        \
    bf16 *GQ = (bf16*)(ws + WS_GQ + bq_ * (PBS - 1 * MiB)), *GK = (bf16*)(ws + WS_GK + bq_ * (PBS - 1 * MiB)), *GV = (bf16*)(ws + WS_GV + bq_ * (PBS - 2 * MiB)), *GG = (bf16*)(ws + WS_GG + bq_ * (PBS - 2 * MiB)), \
         *RQ = (bf16*)(ws + WS_RQ + bq_ * (PBS - 2 * MiB)), *RK = (bf16*)(ws + WS_RK + bq_ * (PBS - 2 * MiB)), *RV = (bf16*)(ws + WS_RV + bq_ * (PBS - 2 * MiB)), *RG = (bf16*)(ws + WS_RG + bq_ * (PBS - 2 * MiB)), \
         *SQ = (bf16*)(ws + WS_SQ + bq_ * (PBS - 4 * MiB)), *SK = (bf16*)(ws + WS_SK + bq_ * (PBS - 4 * MiB)), *SV = (bf16*)(ws + WS_SV + bq_ * (PBS - 4 * MiB)); \
    float *GR = (float*)(ws + WS_GR), *GA = (float*)(ws + WS_GA); \
    (void)SS; (void)MOD; (void)CBIN; (void)CBUP; (void)ROT; (void)WIN; (void)WOUT; (void)WUP; (void)WDN; (void)XA; (void)OM; (void)HB; (void)GQ; (void)GK; (void)GV; (void)GG; (void)RQ; (void)RK; (void)RV; (void)RG; (void)SQ; (void)SK; (void)SV; (void)GR; (void)GA;
#define IN_PTR(i) ((const float*)(const GAS float*)kq_[i])
    for (int u = (int)threadIdx.x; u < (LDS_BYTES - LDSCTL_OFF) / 4; u += NWAVES * 64) ((LAS unsigned*)(lds + LDSCTL_OFF))[u] = 0u;
    __syncthreads();
    { PH_BEGIN(); (void)xcd_barrier_post((unsigned*)(ctl + CW_BAR), MISC + 8); }
#if PROBE_ON
#define STAMP() do { if (blockIdx.x == 0 && TID_NOW() == 0) { ((volatile LAS unsigned long long*)(lds + LDSCTL_OFF + 1024))[nstamp_] = __builtin_amdgcn_s_memrealtime(); } ++nstamp_; } while (0)
    int nstamp_ = 0;
#else
#define STAMP() do {} while (0)
#endif
#define GRID_BAR() do { GRID_BAR_(0); STAMP(); } while (0)
#define XCC_BAR() do { GRID_BAR_(lmode); STAMP(); } while (0)
#define GRID_BAR_(loc) do { const kargw_t* kb_ = kargs; asm volatile("" : "+s"(kb_)); XcdBarrier bb_; bb_.bar = (unsigned*)((gu32*)(GAS unsigned char*)kb_[17] + CW_BAR); bb_.x = xb_xcc_id(); bb_.st = MISC + 8; bb_.tid = TID_NOW(); xcd_barrier(bb_, (loc)); } while (0)

    STAMP();
    {
        PH_BEGIN(); const float *cvec = IN_PTR(1), *ada_w = IN_PTR(2), *ada_b = IN_PTR(3), *w_in = IN_PTR(6), *w_out = IN_PTR(11), *ffn_wg = IN_PTR(12), *ffn_wu = IN_PTR(13), *ffn_wd = IN_PTR(14);
        LAS float* tbl = (LAS float*)(lds + RING_OFF); LAS float* red = (LAS float*)(lds + RING_OFF + 32768);
        if (bx < 192) {
            const int l = bx / 96, jblk = bx % 96, jq = tid & 15, kg = tid >> 4, j0 = jblk * 64 + 4 * jq;
            f32x4 w4[32]; float cv[16];
#pragma unroll
            for (int i = 0; i < 32; ++i) w4[i] = *(const f32x4*)(ada_w + ((size_t)l * DM + kg * 32 + i) * MODLD + j0);
#pragma unroll
            for (int q = 0; q < 16; ++q) cv[q] = cvec[tid + q * (NWAVES * 64)];
            asm volatile("" : "+v"(w4[0]), "+v"(w4[1]), "+v"(w4[2]), "+v"(w4[3]), "+v"(w4[4]), "+v"(w4[5]), "+v"(w4[6]), "+v"(w4[7]), "+v"(w4[8]), "+v"(w4[9]), "+v"(w4[10]), "+v"(w4[11]), "+v"(w4[12]), "+v"(w4[13]), "+v"(w4[14]), "+v"(w4[15]) :: "memory");
            asm volatile("" : "+v"(w4[16]), "+v"(w4[17]), "+v"(w4[18]), "+v"(w4[19]), "+v"(w4[20]), "+v"(w4[21]), "+v"(w4[22]), "+v"(w4[23]), "+v"(w4[24]), "+v"(w4[25]), "+v"(w4[26]), "+v"(w4[27]), "+v"(w4[28]), "+v"(w4[29]), "+v"(w4[30]), "+v"(w4[31]) :: "memory");
#pragma unroll
            for (int q = 0; q < 16; ++q) tbl[tid + q * (NWAVES * 64)] = cv[q] / (1.0f + __expf(-cv[q]));
            __syncthreads();
            f32x4 acc[8];
#pragma unroll
            for (int b = 0; b < 8; ++b) acc[b] = (f32x4){0.f, 0.f, 0.f, 0.f};
#pragma unroll
            for (int b = 0; b < 8; ++b)
#pragma unroll
                for (int i = 0; i < 32; ++i) acc[b] += w4[i] * tbl[b * DM + kg * 32 + i];
#pragma unroll
            for (int b = 0; b < 8; ++b) *(LAS f32x4*)(red + (kg * 8 + b) * 64 + 4 * jq) = acc[b];
            __syncthreads();
            { const int b = tid >> 6, j = tid & 63; float sum = ada_b[l * MODLD + jblk * 64 + j];
#pragma unroll 8
              for (int g8 = 0; g8 < 32; ++g8) sum += red[(g8 * 8 + b) * 64 + j];
              MOD[((size_t)l * 8 + b) * MODLD + jblk * 64 + j] = sum; }
        }
        __syncthreads();
        LAS float* scr = (LAS float*)(lds + RING_OFF + wave * 16384);
        constexpr int I_IN = 16 * (NIN / 32), I_OUT = 16 * 32, I_UP = 16 * (NUP / 32), I_DN = (DFF / 64) * 32, I_L = I_IN + I_OUT + I_UP + I_DN;
        auto mk = [&](int it) {
            TrDesc d; const int l = it / I_L; int r = it % I_L;
            if (r < I_IN) { const int nblk = NIN / 32, kb = r / nblk, nb = r % nblk, n0 = nb * 32;
                int src, nv; if (n0 < 768) { src = n0; nv = 32; } else if (n0 < 3328) { src = n0 + 16; nv = 32; } else if (n0 == 3328) { src = 768; nv = 16; } else { src = 0; nv = 0; }
                d.W = w_in + (size_t)l * DM * NIN_SRC; d.ldw = NIN_SRC; d.k0 = kb * 64; d.src = src; d.nv = nv; d.WT = WIN + (size_t)l * NIN * DM; d.K = DM; d.dst = n0; return d; }
            r -= I_IN;
            if (r < I_OUT) { const int kb = r / 32, nb = r % 32; d.W = w_out + (size_t)l * DM * DM; d.ldw = DM; d.k0 = kb * 64; d.src = nb * 32; d.nv = 32; d.WT = WOUT + (size_t)l * DM * DM; d.K = DM; d.dst = nb * 32; return d; }
            r -= I_OUT;
            if (r < I_UP) { const int nblk = NUP / 32, kb = r / nblk, nb = r % nblk, n0 = nb * 32, tile = n0 >> 8, jj = n0 & 255;
                d.W = ((jj < 128) ? ffn_wg : ffn_wu) + (size_t)l * DM * DFF; d.ldw = DFF; d.k0 = kb * 64; d.src = tile * 128 + (jj & 127); d.nv = 32; d.WT = WUP + (size_t)l * NUP * DM; d.K = DM; d.dst = n0; return d; }
            r -= I_UP;
            { const int kb = r / 32, nb = r % 32; d.W = ffn_wd + (size_t)l * DFF * DM; d.ldw = DM; d.k0 = kb * 64; d.src = nb * 32; d.nv = 32; d.WT = WDN + (size_t)l * DM * DFF; d.K = DFF; d.dst = nb * 32; return d; }
        };
        if (gw < 2 * I_L) {
            TrDesc dc = mk(gw); f32x4 vc[8]; tr_load(dc, vc, lane);
            for (int it = gw; it < 2 * I_L; it += NGW) {
                const bool more = it + NGW < 2 * I_L;
                TrDesc dn = dc; f32x4 vn[8];
                if (more) { dn = mk(it + NGW); tr_load(dn, vn, lane); }
                tr_store(dc, vc, scr, lane);
                if (more) { dc = dn;
#pragma unroll
                    for (int i = 0; i < 8; ++i) vc[i] = vn[i]; }
            }
        }
        for (int e = gw * 64 + lane; e < SEQ * 32; e += NGW * 64) { const int pos = e >> 5, i = e & 31;
            const float inv = powf(10000.0f, -(float)(2 * i) / 64.0f); const float ang = (float)pos * inv; float s, c; sincos_acc(ang, s, c);
            ROT[2 * e] = c; ROT[2 * e + 1] = s; }
    }
    GRID_BAR();
    { const unsigned m_ = MISC[11], r_ = MISC[10]; lmode = __builtin_amdgcn_readfirstlane((int)(m_ == 1u)); if (lmode) bxe = __builtin_amdgcn_readfirstlane((int)(r_ * 8u + xb_xcc_id())); }
    {
        PH_BEGIN(); const float *x = IN_PTR(0), *norm1_g = IN_PTR(4);
        {
            LAS float* shl = (LAS float*)(lds + RING_OFF);
#pragma unroll 4
            for (int q = 0; q < 16; ++q) { const int idx = tid + q * (NWAVES * 64); const int grp = idx >> 11, b = (idx >> 8) & 7, c4 = idx & 255;
                *(LAS f32x4*)(shl + (size_t)idx * 4) = *(const f32x4*)(MOD + ((size_t)(grp >> 1) * 8 + b) * MODLD + ((grp & 1) ? 3 : 0) * DM + c4 * 4); }
            unsigned long long wraw[9][4];
#pragma unroll
            for (int k = 0; k < 9; ++k) { const int r = gw + k * 2048;
                const int l = r >= (NIN + NUP) ? 1 : 0, rr = r - l * (NIN + NUP); const int kind = rr >= NIN ? 1 : 0, n = rr - kind * NIN;
                const bf16* W = kind ? (WUP + ((size_t)l * NUP + n) * DM) : (WIN + ((size_t)l * NIN + n) * DM);
#pragma unroll
                for (int j = 0; j < 4; ++j) wraw[k][j] = *(const unsigned long long*)(W + j * 256 + lane * 4); }
            asm volatile("" ::: "memory");
            __syncthreads();
            const int hi = lane >> 5, b4 = (lane >> 4) & 1, b3 = (lane >> 3) & 1;
#pragma unroll 1
            for (int k = 0; k < 9; ++k) { const int r = gw + k * 2048;
                const int l = r >= (NIN + NUP) ? 1 : 0, rr = r - l * (NIN + NUP); const int kind = rr >= NIN ? 1 : 0, n = rr - kind * NIN; const int grp = l * 2 + kind;
                float wv[16];
#pragma unroll
                for (int j = 0; j < 4; ++j) { unsigned long long w8 = 0;
#pragma unroll
                    for (int kk = 0; kk < 9; ++kk) w8 = (kk == k) ? wraw[kk][j] : w8;
                    const unsigned lo = (unsigned)w8, hi2 = (unsigned)(w8 >> 32);
                    wv[4 * j + 0] = __uint_as_float(lo << 16); wv[4 * j + 1] = __uint_as_float(lo & 0xffff0000u); wv[4 * j + 2] = __uint_as_float(hi2 << 16); wv[4 * j + 3] = __uint_as_float(hi2 & 0xffff0000u); }
                float sm[8];
#pragma unroll
                for (int b = 0; b < 8; ++b) { float a = 0.f;
#pragma unroll
                    for (int j = 0; j < 4; ++j) { const f32x4 s4 = *(const LAS f32x4*)(shl + ((size_t)(grp * 8 + b)) * 1024 + j * 256 + lane * 4);
                        a = fmaf(s4[0], wv[4 * j + 0], a); a = fmaf(s4[1], wv[4 * j + 1], a); a = fmaf(s4[2], wv[4 * j + 2], a); a = fmaf(s4[3], wv[4 * j + 3], a); }
                    sm[b] = a; }
                float u4[4], u2[2], u1;
#pragma unroll
                for (int i = 0; i < 4; ++i) { const float mine = hi ? sm[i + 4] : sm[i], send = hi ? sm[i] : sm[i + 4]; u4[i] = mine + get_x32(send, hi); }
#pragma unroll
                for (int i = 0; i < 2; ++i) { const float mine = b4 ? u4[i + 2] : u4[i], send = b4 ? u4[i] : u4[i + 2]; u2[i] = mine + shx<16>(send); }
                { const float mine = b3 ? u2[1] : u2[0], send = b3 ? u2[0] : u2[1]; u1 = mine + shx<8>(send); }
                u1 += shx<4>(u1); u1 += shx<2>(u1); u1 += shx<1>(u1);
                const int bb = hi * 4 + b4 * 2 + b3;
                float* CB = kind ? (CBUP + (size_t)l * 8 * NUP) : (CBIN + (size_t)l * 8 * NIN); const int NR = kind ? NUP : NIN;
                if ((lane & 7) == 0) CB[(size_t)bb * NR + n] = u1;
            }
            __syncthreads();
        }
        {
            f32x4 vcur[4], an[4];
            const int mb = (gw >> 8) * SEQ + (gw & 255);
            { const float* sp = MOD + (size_t)(gw >> 8) * MODLD + DM + lane * 4;
#pragma unroll
              for (int j = 0; j < 4; ++j) an[j] = *(const f32x4*)(norm1_g + j * 256 + lane * 4) * (*(const f32x4*)(sp + j * 256) + 1.0f); }
            { const GAS f32x4* xr = (const GAS f32x4*)(x + (size_t)mb * DM) + lane;
#pragma unroll
              for (int j = 0; j < 4; ++j) vcur[j] = xr[64 * j]; }
            asm volatile("" : "+v"(vcur[0]), "+v"(vcur[1]), "+v"(vcur[2]), "+v"(vcur[3]), "+v"(an[0]), "+v"(an[1]), "+v"(an[2]), "+v"(an[3]));
            for (int k = 0; k < SEQ / 256; ++k) { const int m = mb + 256 * k;
                f32x4 vnx[4]; const bool more = k + 1 < SEQ / 256;
                if (more) { const GAS f32x4* xn = (const GAS f32x4*)(x + (size_t)(m + 256) * DM) + lane;
#pragma unroll
                    for (int j = 0; j < 4; ++j) vnx[j] = xn[64 * j]; }
                asm volatile("" ::: "memory");
                float s = 0.f;
                GAS unsigned long long* o8 = (GAS unsigned long long*)(XA + (size_t)m * DM) + lane;
                GAS unsigned long long* r8 = (GAS unsigned long long*)((bf16*)out + (size_t)m * DM) + lane;
#pragma unroll
                for (int j = 0; j < 4; ++j) { const f32x4 v = vcur[j]; s += (v.x * v.x + v.y * v.y) + (v.z * v.z + v.w * v.w);
                    const f32x4 y = v * an[j]; o8[64 * j] = (unsigned long long)pk2(y.x, y.y) | ((unsigned long long)pk2(y.z, y.w) << 32);
                    r8[64 * j] = (unsigned long long)pk2(v.x, v.y) | ((unsigned long long)pk2(v.z, v.w) << 32); }
                s = wave_sum(s); if (lane == 0) SS[m] = ss_fix(s);
                if (more) {
#pragma unroll
                    for (int j = 0; j < 4; ++j) vcur[j] = vnx[j]; }
            }
        }
    }
    GRID_BAR();

    for (int l = 0; l < DEPTH; ++l) {
        {
            PH_BEGIN();
            LAS float* cbl = (LAS float*)(lds + CBL_OFF); LAS float* rsl = (LAS float*)(lds + RSL_OFF);
            const int pm0_ = 16 * (bxe & 7) + ((bxe >> 3) & 7);
            const float* cbg = CBIN + ((size_t)l * 8 + (bxe & 7)) * NIN;
            for (int i = tid; i < NIN / 4; i += NWAVES * 64) *(LAS f32x4*)(cbl + 4 * i) = *(const f32x4*)(cbg + 4 * i);
            const int pm_ = pm0_ + 8 * __builtin_amdgcn_readfirstlane(tid >> 8); rsl[tid] = row_rstd(SS + (size_t)(2 * l) * M, (size_t)pm_ * 256 + (tid & 255));
            __syncthreads();
        }
        {
            PH_BEGIN();
            pg8::Gemm g{XA, WIN + (size_t)l * NIN * DM, M, NIN, DM}; pg8::StaticOrder S; S.init(M, NIN, G, bxe);
            pg8::EpiInProj E{(LAS float*)(lds + CBL_OFF), (LAS float*)(lds + RSL_OFF), 16 * (bxe & 7) + ((bxe >> 3) & 7), ROT, ws};
            pg8::gemm_phase<pg8::EpiInProj, pg8::StaticOrder, true, true>(lds + RING_OFF, g, S, E, tid);
        }
        XCC_BAR();
#if !(MIX_GLA_V1)
        {
            PH_BEGIN(); const float *gla_wa2 = IN_PTR(7), *gla_ba = IN_PTR(8);
            float w0[16], w1[16];
#pragma unroll
            for (int r = 0; r < 16; ++r) { w0[r] = gla_wa2[((size_t)l * 16 + r) * 128 + lane]; w1[r] = gla_wa2[((size_t)l * 16 + r) * 128 + 64 + lane]; }
            const float b0 = gla_ba[l * 128 + lane], b1 = gla_ba[l * 128 + 64 + lane];
            for (int m = gw; m < M; m += NGW) {
                const float grv = GR[(size_t)m * 16 + (lane & 15)];
                float u0 = b0, u1 = b1;
#pragma unroll
                for (int r = 0; r < 16; ++r) { const float gr = rdl(grv, r); u0 = fmaf(gr, w0[r], u0); u1 = fmaf(gr, w1[r], u1); }
                const float l0 = fminf(u0, 0.f) - __logf(1.0f + __expf(-fabsf(u0))), l1 = fminf(u1, 0.f) - __logf(1.0f + __expf(-fabsf(u1)));
                GA[(size_t)m * 128 + lane] = __expf(l0 * (1.0f / 16.0f)); GA[(size_t)m * 128 + 64 + lane] = __expf(l1 * (1.0f / 16.0f));
            }
        }
        GRID_BAR();
#endif
#if MIX_GLA_V1 || MIX_RET_V1 || MIX_SB_V1
        {
            const int ord = wave_k >> 2;
#pragma unroll 1
            for (int step = 0; step < 2; ++step) {
                if ((ord ? 1 - step : step) == 0) { PH_BEGIN(); const float *gla_wa2 = IN_PTR(7), *gla_ba = IN_PTR(8); LAS unsigned char* wlds = lds + RING_OFF + wave * 16384;
                    SumPre pre;
                    chunk_sum_unit<32, true, true, false>(gw, GQ, GK, GV, GR, gla_wa2 + (size_t)l * 16 * 128, gla_ba + l * 128, (float*)(ws + WS_KVTG), (float*)(ws + WS_DEC), wlds, lane_now(), &pre, RK, RV);
                    chunk_sum_unit<64, false, false, true>(gw, RQ, RK, RV, nullptr, nullptr, nullptr, (float*)(ws + WS_KVTR), nullptr, wlds, lane_now(), &pre); }
                else { PH_BEGIN(); LAS unsigned char* wlds = lds + RING_OFF + wave * 16384;
                    { const int g_ = gw >> 8, u_ = gw & 255; sb_unit_v1(((g_ * 8 + (u_ >> 6)) << 6) | (u_ & 63), SQ, SK, SV, OM, wlds, lane_now()); } }
            }
        }
        XCC_BAR();
        {
            const int ord = wave_k >> 2;
#pragma unroll 1
            for (int step = 0; step < 2; ++step) {
                if ((ord ? 1 - step : step) == 0) { PH_BEGIN();
                    const int g_ = gw >> 8, u_ = gw & 255;
                    if (u_ < 64) scan_unit<32, true>(g_ * 4 + (u_ >> 4), u_ & 15, (const float*)(ws + WS_KVTG), (const float*)(ws + WS_DEC), (bf16*)(ws + WS_STG), lane);
                    else if (u_ < 192) scan_unit<64, false>(g_ * 4 + ((u_ - 64) >> 5), (u_ - 64) & 31, (const float*)(ws + WS_KVTR), nullptr, (bf16*)(ws + WS_STR), lane);
                } else { PH_BEGIN(); LAS unsigned char* wlds = lds + RING_OFF + wave * 16384;
                    { const int g_ = gw >> 8, u_ = gw & 255; sb_unit_v1(((g_ * 8 + 4 + (u_ >> 6)) << 6) | (u_ & 63), SQ, SK, SV, OM, wlds, lane_now()); } }
            }
        }
        XCC_BAR();
#endif
        {
            PH_BEGIN(); const float *gla_norm_g = IN_PTR(9), *ret_norm_g = IN_PTR(10);
            LAS unsigned char* wlds = lds + RING_OFF + wave * 16384; (void)wlds;
#if MIX_GLA_V1
            for (int ch = gw; ch < 2048; ch += NGW) chunk_out_unit<32>(ch, GQ, GK, GV, GG, (const bf16*)(ws + WS_STG), gla_norm_g + l * 64, OM, 0, wlds, (LAS float*)(lds + LDSCTL_OFF + 4096 + wave * 256), lane_now());
#else
            if (wave == 0 && vcu < 32) seq_recurrent_v0<32, true>(GQ, GK, GV, GG, GA, gla_norm_g + l * 64, OM, vcu >> 2, vcu & 3, lane, 0);
#endif
#if MIX_RET_V1
            for (int ch = gw; ch < 2048; ch += NGW) chunk_out_unit<64>(ch, RQ, RK, RV, RG, (const bf16*)(ws + WS_STR), ret_norm_g + l * 64, OM, 256, wlds, (LAS float*)(lds + LDSCTL_OFF + 4096 + wave * 256), lane_now());
#else
            if (wave == 0 && vcu >= 32 && vcu < 64) seq_recurrent_v0<64, false>(RQ, RK, RV, RG, nullptr, ret_norm_g + l * 64, OM, (vcu - 32) >> 2, (vcu - 32) & 3, lane, 256);
#endif
#if !(MIX_SB_V1)
            for (int unit = gw; unit < 4096; unit += NGW) sb_unit_v0(SQ, SK, SV, OM, unit, lane);
#endif
        }
        XCC_BAR();
#if PROBE_ON && PROBE_DUP3C
        {
            PH_BEGIN(); const float *gla_norm_g = IN_PTR(9), *ret_norm_g = IN_PTR(10);
            LAS unsigned char* wlds = lds + RING_OFF + wave * 16384; (void)wlds;
#if MIX_GLA_V1
            for (int ch = gw; ch < 2048; ch += NGW) chunk_out_unit<32>(ch, GQ, GK, GV, GG, (const bf16*)(ws + WS_STG), gla_norm_g + l * 64, OM, 0, wlds, (LAS float*)(lds + LDSCTL_OFF + 4096 + wave * 256), lane_now());
#else
            if (wave == 0 && vcu < 32) seq_recurrent_v0<32, true>(GQ, GK, GV, GG, GA, gla_norm_g + l * 64, OM, vcu >> 2, vcu & 3, lane, 0);
#endif
#if MIX_RET_V1
            for (int ch = gw; ch < 2048; ch += NGW) chunk_out_unit<64>(ch, RQ, RK, RV, RG, (const bf16*)(ws + WS_STR), ret_norm_g + l * 64, OM, 256, wlds, (LAS float*)(lds + LDSCTL_OFF + 4096 + wave * 256), lane_now());
#else
            if (wave == 0 && vcu >= 32 && vcu < 64) seq_recurrent_v0<64, false>(RQ, RK, RV, RG, nullptr, ret_norm_g + l * 64, OM, (vcu - 32) >> 2, (vcu - 32) & 3, lane, 256);
#endif
#if !(MIX_SB_V1)
            for (int unit = gw; unit < 4096; unit += NGW) sb_unit_v0(SQ, SK, SV, OM, unit, lane);
#endif
        }
        GRID_BAR();
#endif
        {
            PH_BEGIN(); const float *norm2_g = IN_PTR(5); const float* MODB = MOD + ((size_t)l * 8 + (bxe & 7)) * MODLD;
            { LAS float* gl_ = (LAS float*)(lds + CBL_OFF); LAS float* al_ = gl_ + DM;
              for (int i = tid; i < DM / 4; i += NWAVES * 64) { *(LAS f32x4*)(gl_ + 4 * i) = *(const f32x4*)(MODB + 2 * DM + 4 * i);
                  *(LAS f32x4*)(al_ + 4 * i) = *(const f32x4*)(norm2_g + l * DM + 4 * i) * (*(const f32x4*)(MODB + 4 * DM + 4 * i) + 1.0f); }
              __syncthreads(); }
            pg8::Gemm g{OM, WOUT + (size_t)l * DM * DM, M, DM, DM}; pg8::StaticOrder S; S.init(M, DM, G, bxe);
            bf16* XR = (bf16*)out;
            pg8::EpiResid E{XR, XR, (LAS float*)(lds + CBL_OFF), (LAS float*)(lds + CBL_OFF) + DM, XA, SS + (size_t)(2 * l + 1) * M, 1};
            pg8::gemm_phase<pg8::EpiResid, pg8::StaticOrder, true, true>(lds + RING_OFF, g, S, E, tid);
        }
        XCC_BAR();
#if PROBE_ON && PROBE_NULLEPI
        if (l == 0) {
            PH_BEGIN();
            pg8::Gemm g{XA, WUP + (size_t)l * NUP * DM, M, NUP, DM}; pg8::StaticOrder S; S.init(M, NUP, G, bxe);
            pg8::EpiNull E{(float*)(ws + WS_OM)};
            pg8::gemm_phase<pg8::EpiNull, pg8::StaticOrder, true, true>(lds + RING_OFF, g, S, E, tid);
            GRID_BAR();
        }
#endif
        {
            PH_BEGIN();
            LAS float* cbl = (LAS float*)(lds + CBL_OFF); LAS float* rsl = (LAS float*)(lds + RSL_OFF);
            const int pm0_ = 16 * (bxe & 7) + ((bxe >> 3) & 7);
            const float* cbg = CBUP + ((size_t)l * 8 + (bxe & 7)) * NUP;
            for (int i = tid; i < NUP / 4; i += NWAVES * 64) *(LAS f32x4*)(cbl + 4 * i) = *(const f32x4*)(cbg + 4 * i);
            const int pm_ = pm0_ + 8 * __builtin_amdgcn_readfirstlane(tid >> 8); rsl[tid] = row_rstd(SS + (size_t)(2 * l + 1) * M, (size_t)pm_ * 256 + (tid & 255));
            __syncthreads();
        }
        {
            PH_BEGIN();
            pg8::Gemm g{XA, WUP + (size_t)l * NUP * DM, M, NUP, DM}; pg8::StaticOrder S; S.init(M, NUP, G, bxe);
            pg8::EpiFfnUp E{(LAS float*)(lds + CBL_OFF), (LAS float*)(lds + RSL_OFF), 16 * (bxe & 7) + ((bxe >> 3) & 7), HB};
            pg8::gemm_phase<pg8::EpiFfnUp, pg8::StaticOrder, true, true>(lds + RING_OFF, g, S, E, tid);
        }
        XCC_BAR();
        {
            PH_BEGIN(); const float *norm1_g = IN_PTR(4); const float* MODB = MOD + ((size_t)l * 8 + (bxe & 7)) * MODLD;
            const int nl = (l + 1 < DEPTH) ? l + 1 : l;
            { LAS float* gl_ = (LAS float*)(lds + CBL_OFF); LAS float* al_ = gl_ + DM; const float* MODN = MOD + ((size_t)nl * 8 + (bxe & 7)) * MODLD;
              for (int i = tid; i < DM / 4; i += NWAVES * 64) { *(LAS f32x4*)(gl_ + 4 * i) = *(const f32x4*)(MODB + 5 * DM + 4 * i);
                  *(LAS f32x4*)(al_ + 4 * i) = *(const f32x4*)(norm1_g + nl * DM + 4 * i) * (*(const f32x4*)(MODN + 1 * DM + 4 * i) + 1.0f); }
              __syncthreads(); }
            pg8::Gemm g{HB, WDN + (size_t)l * DM * DFF, M, DM, DFF, PBS - (size_t)SEQ * DFF * 2}; pg8::StaticOrder S; S.init(M, DM, G, bxe);
            bf16* XR = (bf16*)out;
            pg8::EpiResid E{XR, (l + 1 < DEPTH) ? XR : XA, (LAS float*)(lds + CBL_OFF), (LAS float*)(lds + CBL_OFF) + DM, XA, SS + (size_t)(2 * l + 2) * M, (l + 1 < DEPTH) ? 1 : 0};
            pg8::gemm_phase<pg8::EpiResid, pg8::StaticOrder, true, true>(lds + RING_OFF, g, S, E, tid);
        }
        if (l + 1 < DEPTH) XCC_BAR(); else GRID_BAR();
    }
    {
        PH_BEGIN(); const float* final_g = IN_PTR(15);
        const unsigned long long* ssf = SS + (size_t)(2 * DEPTH) * M;
        f32x4 fg[4];
#pragma unroll
        for (int j = 0; j < 4; ++j) fg[j] = *(const f32x4*)(final_g + j * 256 + lane * 4);
        unsigned long long wcur[4], qcur;
        const int mb = (gw >> 8) * SEQ + (gw & 255);
        { const GAS unsigned long long* xr = (const GAS unsigned long long*)(XA + (size_t)mb * DM) + lane; qcur = ssf[mb];
#pragma unroll
          for (int j = 0; j < 4; ++j) wcur[j] = xr[64 * j]; }
        asm volatile("" : "+v"(wcur[0]), "+v"(wcur[1]), "+v"(wcur[2]), "+v"(wcur[3]), "+v"(qcur), "+v"(fg[0]), "+v"(fg[1]), "+v"(fg[2]), "+v"(fg[3]));
        for (int k = 0; k < SEQ / 256; ++k) { const int m = mb + 256 * k;
            unsigned long long wnx[4], qnx = 0; const bool more = k + 1 < SEQ / 256;
            if (more) { const GAS unsigned long long* xn = (const GAS unsigned long long*)(XA + (size_t)(m + 256) * DM) + lane; qnx = ssf[m + 256];
#pragma unroll
                for (int j = 0; j < 4; ++j) wnx[j] = xn[64 * j]; }
            asm volatile("" ::: "memory");
            const float r = rstd_of(qcur);
            GAS f32x4* orow = (GAS f32x4*)(out + (size_t)m * DM) + lane;
#pragma unroll
            for (int j = 0; j < 4; ++j) { const unsigned long long w = wcur[j]; const unsigned lo = (unsigned)w, hi2 = (unsigned)(w >> 32);
                const f32x4 v = {__uint_as_float(lo << 16), __uint_as_float(lo & 0xffff0000u), __uint_as_float(hi2 << 16), __uint_as_float(hi2 & 0xffff0000u)};
                orow[64 * j] = v * r * fg[j]; }
            if (more) { qcur = qnx;
#pragma unroll
                for (int j = 0; j < 4; ++j) wcur[j] = wnx[j]; }
        }
    }

#if PROBE_ON
    STAMP();
    if (blockIdx.x == 0 && TID_NOW() == 0) {
        volatile LAS unsigned long long* st_ = (volatile LAS unsigned long long*)(lds + LDSCTL_OFF + 1024);
        const unsigned long long d1 = st_[PROBE_I1B] - st_[PROBE_I1A], d2 = st_[PROBE_I2B] - st_[PROBE_I2A];
        unsigned long long q1 = (d1 + 400) / 800, q2 = (d2 + 400) / 800; if (q1 > 63) q1 = 63; if (q2 > 63) q2 = 63;
        const unsigned long long spin = (q1 + 64 * q2) * 1200ull, t0_ = __builtin_amdgcn_s_memrealtime();
        while (__builtin_amdgcn_s_memrealtime() - t0_ < spin) __builtin_amdgcn_s_sleep(8);
    }
#endif
}

extern "C" void kernel_launch(void* const* d_in, const int* in_sizes, int n_in, void* d_out, int out_size, void* d_ws, size_t ws_size, hipStream_t stream) {
    static int grid = 0;
    if (grid == 0) {
        if (n_in != 16 || in_sizes[0] != M * DM || out_size != M * DM || ws_size < WS_END) { fprintf(stderr, "kernel_launch: unexpected shapes (n_in %d, in0 %d, out %d, ws %zu); nothing launched\n", n_in, n_in > 0 ? in_sizes[0] : -1, out_size, ws_size); grid = -1; return; }
        int dev = 0, cus = 0, per_cu = 0;
        if (hipGetDevice(&dev) != hipSuccess || hipDeviceGetAttribute(&cus, hipDeviceAttributeMultiprocessorCount, dev) != hipSuccess) { grid = -1; return; }
        if (hipFuncSetAttribute((const void*)mk_fwd, hipFuncAttributeMaxDynamicSharedMemorySize, LDS_BYTES) != hipSuccess) { fprintf(stderr, "kernel_launch: hipFuncSetAttribute failed\n"); grid = -1; return; }
        if (hipOccupancyMaxActiveBlocksPerMultiprocessor(&per_cu, (const void*)mk_fwd, NWAVES * 64, LDS_BYTES) != hipSuccess || per_cu < 1) fprintf(stderr, "kernel_launch: note: occupancy query reports %d\n", per_cu);
        (void)hipGetLastError();
        if (cus != 256) { fprintf(stderr, "kernel_launch: built for a 256-CU device, found %d CUs; nothing launched\n", cus); grid = -1; return; }
        grid = cus;
    }
    if (grid < 0) return;
    if (hipMemsetAsync((char*)d_ws + WS_CTL, 0, CTL_ZERO_BYTES, stream) != hipSuccess) { fprintf(stderr, "kernel_launch: memset failed\n"); return; }
    Args a{};
    for (int i = 0; i < 16; ++i) a.in[i] = (const float*)d_in[i];
    a.out = (float*)d_out; a.ws = (unsigned char*)d_ws; a.ph_lo = 0; a.ph_hi = 99;
    hipLaunchKernelGGL(mk_fwd, dim3(grid), dim3(NWAVES * 64), LDS_BYTES, stream, a);
}
```

```cpp
#include <hip/hip_runtime.h>
#include <cstdio>
#include <cstdint>
#define MIX_GLA_V1 1
#define MIX_RET_V1 1
#define MIX_SB_V1 1
#define PROBE_ON 0
constexpr int NWAVES = 8;
constexpr int BATCH = 8, SEQ = 4096, DM = 1024, M = BATCH * SEQ, DEPTH = 2;
constexpr int NIN = 3584, NIN_SRC = 3344, DFF = 2816, NUP = 5632, MODLD = 6144;
constexpr float SB_THR = -110.0f, SB_PMIN = 1.1754944e-38f;

constexpr size_t MiB = 1u << 20;
constexpr size_t WS_CTL = 0;
constexpr size_t WS_SS = 1 * MiB;
constexpr size_t WS_MOD = 2 * MiB + 512 * 1024;
constexpr size_t CTL_ZERO_BYTES = 2 * MiB + 512 * 1024;
constexpr size_t WS_CBIN = 3 * MiB;
constexpr size_t WS_CBUP = 3 * MiB + 512 * 1024;
constexpr size_t WS_ROT = 4 * MiB;
constexpr size_t WS_WIN = 8 * MiB;
constexpr size_t WS_WOUT = 22 * MiB;
constexpr size_t WS_WUP = 26 * MiB;
constexpr size_t WS_WDN = 48 * MiB;
constexpr size_t WS_XA = 64 * MiB;
constexpr size_t WS_OM = 128 * MiB;
constexpr size_t PBS = 26 * MiB;
constexpr size_t WS_GQ = 192 * MiB, WS_GK = 193 * MiB, WS_GV = 194 * MiB, WS_GG = 196 * MiB;
constexpr size_t WS_RQ = 198 * MiB, WS_RK = 200 * MiB, WS_RV = 202 * MiB, WS_RG = 204 * MiB;
constexpr size_t WS_SQ = 206 * MiB, WS_SK = 210 * MiB, WS_SV = 214 * MiB;
constexpr size_t WS_GR = 400 * MiB;
constexpr size_t WS_GA = 402 * MiB;
constexpr size_t WS_HB = 192 * MiB;
constexpr size_t WS_KVTG = 418 * MiB, WS_KVTR = 434 * MiB, WS_STG = 466 * MiB, WS_STR = 474 * MiB, WS_DEC = 490 * MiB;
constexpr size_t WS_END = 501 * MiB;
constexpr int CW_BAR = 4096;

constexpr int RING_OFF = 0, RING_BYTES = 131072;
constexpr int LDSCTL_OFF = RING_BYTES, MISC_OFF = LDSCTL_OFF + 320;
constexpr int LDS_BYTES = 163840;
constexpr int CBL_OFF = LDSCTL_OFF + 6144, RSL_OFF = CBL_OFF + 22528;

#if MIX_SB_V1
constexpr float SB_QSCALE = 0.125f * 1.4426950408889634f;
#else
constexpr float SB_QSCALE = 0.125f;
#endif
template <int OFF> __device__ __forceinline__ float shx(float v) {
    static_assert(OFF >= 1 && OFF < 32, "shx: OFF");
    return __builtin_bit_cast(float, __builtin_amdgcn_ds_swizzle(__builtin_bit_cast(int, v), (OFF << 10) | 0x1f));
}
__device__ __forceinline__ void swap32(float& a, float& b) { asm volatile("s_nop 1\n\tv_permlane32_swap_b32 %0, %1\n\ts_nop 1" : "+v"(a), "+v"(b)); }
__device__ __forceinline__ float add_x32(float v) {
    float a = v, b = v; swap32(a, b); return a + b;
}
__device__ __forceinline__ float get_x32(float v, int hi) {
    float a = v, b = v; swap32(a, b); return hi ? a : b;
}
__device__ __forceinline__ float sum32(float v) { v += shx<1>(v); v += shx<2>(v); v += shx<4>(v); v += shx<8>(v); v += shx<16>(v); return v; }
__device__ __forceinline__ unsigned long long ss_fix(float sq) { return (unsigned long long)(unsigned)(sq * 4096.0f) << 20; }
__device__ __forceinline__ float rstd_of(unsigned long long q) { const float s = (float)(unsigned)(q >> 20) * (1.0f / 4096.0f); return __builtin_amdgcn_rsqf(s * (1.0f / 1024.0f) + 1e-6f); }
__device__ __forceinline__ float row_rstd(const unsigned long long* ssq, size_t row) { const float s = (float)(unsigned)(ssq[row] >> 20) * (1.0f / 4096.0f); return __builtin_amdgcn_rsqf(s * (1.0f / 1024.0f) + 1e-6f); }
namespace pg8 {
#define PG8_LAS __attribute__((address_space(3)))
typedef unsigned short bf16_t;
typedef short bf16x8 __attribute__((ext_vector_type(8)));
typedef float f32x4 __attribute__((ext_vector_type(4)));
typedef unsigned u32x4 __attribute__((ext_vector_type(4)));
constexpr int BM = 256, BK = 64, HALF = 128, HTB = HALF * BK * 2  , STAGE_BYTES = 8 * HTB, NXCD = 8, WGM = 8;

__host__ __device__ __forceinline__ int lds_byte(int r, int c) { const int st = (r >> 4) * 2 + (c >> 5), rr = r & 15, cc = c & 31, ob = rr * 64 + cc * 2; return st * 1024 + (ob ^ (((ob >> 9) & 1) << 5)); }
__host__ __device__ __forceinline__ void stage_rc(int b, int& R, int& C) { const int st = b / 1024, sb = b % 1024, swz = sb ^ (((sb >> 9) & 1) << 5); R = (st >> 1) * 16 + swz / 64; C = (st & 1) * 32 + (swz % 64) / 2; }
__host__ __device__ __forceinline__ int perm32(int rho) { const int n = rho >> 4, i = rho & 15; return 8 * (i >> 2) + 4 * n + (i & 3); }

struct Unit { int pm, pn; };
struct Gemm { const bf16_t* A; const bf16_t* Bt; int M, N, K; size_t abx = 0; };

struct StaticOrder {
    int nM, nN, nwg, G, c;
    __host__ __device__ void init(int M, int N, int G_, int c_) { nM = M / BM; nN = N / BM; nwg = nM * nN; G = G_; c = c_; }
    __host__ __device__ bool next(int i, Unit& u) const {
        const long L = (long)i * G + c; if (L >= nwg) return false;
        int wgid = (int)L; { const int q = nwg / NXCD, r = nwg % NXCD, xcd = wgid % NXCD, off = wgid / NXCD; wgid = (xcd < r ? xcd * (q + 1) : r * (q + 1) + (xcd - r) * q) + off; }
        const int nig = WGM * nN, gid = wgid / nig, fm = gid * WGM, gsz = (nM - fm) < WGM ? (nM - fm) : WGM;
        u.pm = fm + ((wgid % nig) % gsz); u.pn = (wgid % nig) / gsz; return true;
    }
    __device__ __forceinline__ void a_ready(const Unit&) const {}
    __device__ __forceinline__ void done(const Unit&) const {}
};

typedef float cvt_f32x2_t __attribute__((ext_vector_type(2))); typedef __bf16 cvt_bf16x2_t __attribute__((ext_vector_type(2)));
__device__ __forceinline__ unsigned cvt_pk_bf16(float lo, float hi) { const cvt_f32x2_t v = {lo, hi}; const cvt_bf16x2_t b = __builtin_convertvector(v, cvt_bf16x2_t); return __builtin_bit_cast(unsigned, b); }
constexpr int NIN = ::NIN, NUP = ::NUP, DFFC = ::DFF, DMC = ::DM, MODLD = ::MODLD;
__device__ __forceinline__ float silu_f(float a) { return a * __builtin_amdgcn_rcpf(1.0f + __expf(-a)); }
__device__ __forceinline__ u32x4 pack8(const f32x4 v0, const f32x4 v1) { u32x4 w; w.x = cvt_pk_bf16(v0[0], v0[1]); w.y = cvt_pk_bf16(v0[2], v0[3]); w.z = cvt_pk_bf16(v1[0], v1[1]); w.w = cvt_pk_bf16(v1[2], v1[3]); return w; }

__device__ __forceinline__ void load_rstd8(const unsigned long long* sp, float (&rs)[2][4]) {
    unsigned long long raw[8];
    asm volatile("global_load_dwordx2 %0, %1, off" : "=v"(raw[0]) : "v"(sp));
    asm volatile("global_load_dwordx2 %0, %1, off offset:128" : "=v"(raw[1]) : "v"(sp));
    asm volatile("global_load_dwordx2 %0, %1, off offset:256" : "=v"(raw[2]) : "v"(sp));
    asm volatile("global_load_dwordx2 %0, %1, off offset:384" : "=v"(raw[3]) : "v"(sp));
    asm volatile("global_load_dwordx2 %0, %1, off offset:1024" : "=v"(raw[4]) : "v"(sp));
    asm volatile("global_load_dwordx2 %0, %1, off offset:1152" : "=v"(raw[5]) : "v"(sp));
    asm volatile("global_load_dwordx2 %0, %1, off offset:1280" : "=v"(raw[6]) : "v"(sp));
    asm volatile("global_load_dwordx2 %0, %1, off offset:1408" : "=v"(raw[7]) : "v"(sp));
    asm volatile("s_waitcnt vmcnt(0)" : "+v"(raw[0]), "+v"(raw[1]), "+v"(raw[2]), "+v"(raw[3]), "+v"(raw[4]), "+v"(raw[5]), "+v"(raw[6]), "+v"(raw[7]) :: "memory");
#pragma unroll
    for (int i = 0; i < 8; ++i) rs[i >> 2][i & 3] = rstd_of(raw[i]);
}

struct EpiInProj {
    static constexpr bool PERM = true, AFTER_DRAIN = false;
    const PG8_LAS float* cbl; const PG8_LAS float* rsl; int pm0; const float* rot; unsigned char* ws;
    template <bool ROT>
    __device__ __forceinline__ void tile(const f32x4 (&acc)[2][2][4][2], const float (&rs)[2][4], const f32x4 (&c0)[2], const f32x4 (&c1)[2], int pn, int row0, int cl, int bq) const {
        int clq = cl; asm volatile("" : "+v"(clq));
        const int i0 = (clq & 63) >> 1;
#pragma unroll
        for (int ai = 0; ai < 2; ++ai) {
            f32x4 t0[4], t1[4];
            if constexpr (ROT) {
#pragma unroll
                for (int m = 0; m < 4; ++m) { const int pos = (row0 + ai * HALF + m * 16) & 4095; t0[m] = *(const f32x4*)(rot + ((size_t)pos * 32 + i0) * 2); t1[m] = *(const f32x4*)(rot + ((size_t)pos * 32 + i0 + 2) * 2); }
                asm volatile("" ::: "memory");
            }
#pragma unroll
            for (int bj = 0; bj < 2; ++bj) {
                unsigned long long off; int ldl, colb = bj * HALF; float sc = 1.0f;
                if (ROT) { ldl = 8; if (pn == 3) { off = WS_RQ; } else { off = WS_RK; sc = 0.125f; } }
                else if (pn == 0) { ldl = 7; colb = 0; if (bj == 0) { off = WS_GQ; sc = 0.17677669529663687f; } else { off = WS_GK; } }
                else if (pn == 1) { off = WS_GV; ldl = 8; }
                else if (pn == 2) { off = WS_GG; ldl = 8; }
                else if (pn == 5) { off = WS_RV; ldl = 8; }
                else if (pn == 6) { off = WS_RG; ldl = 8; }
                else if (pn <= 8) { off = WS_SQ; ldl = 9; colb += (pn - 7) * BM; sc = SB_QSCALE; }
                else if (pn <= 10) { off = WS_SK; ldl = 9; colb += (pn - 9) * BM; }
                else { off = WS_SV; ldl = 9; colb += (pn - 11) * BM; }
                off = ((unsigned long long)__builtin_amdgcn_readfirstlane((unsigned)(off >> 20))) << 20; ldl = __builtin_amdgcn_readfirstlane(ldl); colb = __builtin_amdgcn_readfirstlane(colb);
                asm volatile("" : "+s"(off), "+s"(ldl), "+s"(colb));
                unsigned char* dstb = ws + off + (size_t)bq * (::PBS - ((size_t)4096 << (ldl + 1)));
#pragma unroll
                for (int m = 0; m < 4; ++m) { const int row = row0 + ai * HALF + m * 16; const float r = rs[ai][m];
                    f32x4 v0 = acc[ai][bj][m][0] * r + c0[bj], v1 = acc[ai][bj][m][1] * r + c1[bj];
                    if constexpr (ROT) {
                        const f32x4 w0 = {v0[0] * t0[m][0] - v0[1] * t0[m][1], v0[0] * t0[m][1] + v0[1] * t0[m][0], v0[2] * t0[m][2] - v0[3] * t0[m][3], v0[2] * t0[m][3] + v0[3] * t0[m][2]};
                        const f32x4 w1 = {v1[0] * t1[m][0] - v1[1] * t1[m][1], v1[0] * t1[m][1] + v1[1] * t1[m][0], v1[2] * t1[m][2] - v1[3] * t1[m][3], v1[2] * t1[m][3] + v1[3] * t1[m][2]};
                        v0 = w0; v1 = w1; }
                    v0 = v0 * sc; v1 = v1 * sc;
                    *(u32x4*)(dstb + ((((size_t)row << ldl) + (size_t)(colb + cl)) << 1)) = pack8(v0, v1); } }
        }
    }
    __device__ __forceinline__ void operator()(const f32x4 (&acc)[2][2][4][2], const Unit& u, int wr, int wc, int fr, int fq) const {
        const int pn = u.pn, b = u.pm >> 4;
        const int row0 = u.pm * BM + wr * 64 + fr; const int cl = wc * 32 + 8 * fq;
        f32x4 c0[2], c1[2];
#pragma unroll
        for (int bj = 0; bj < 2; ++bj) { const PG8_LAS float* cbp = cbl + pn * BM + bj * HALF + cl; c0[bj] = *(const PG8_LAS f32x4*)(cbp); c1[bj] = *(const PG8_LAS f32x4*)(cbp + 4); }
        float rs[2][4];
        { const PG8_LAS float* rp = rsl + (u.pm == pm0 ? 0 : 256) + wr * 64 + fr;
#pragma unroll
          for (int ai = 0; ai < 2; ++ai)
#pragma unroll
              for (int m = 0; m < 4; ++m) rs[ai][m] = rp[ai * HALF + m * 16]; }
        int kind = (pn == 3 || pn == 4) ? 1 : (pn == 13 ? 2 : 0);
        kind = __builtin_amdgcn_readfirstlane(kind); asm volatile("" : "+s"(kind));
        if (kind == 2) {
            int clg = cl; unsigned long long goff = WS_GR; asm volatile("" : "+v"(clg), "+s"(goff));
            if (clg < 16) { float* gbase = (float*)(ws + goff);
#pragma unroll
                for (int ai = 0; ai < 2; ++ai)
#pragma unroll
                    for (int m = 0; m < 4; ++m) { const int row = row0 + ai * HALF + m * 16; const float r = rs[ai][m]; float* gp = gbase + (size_t)row * 16 + clg;
                        *(f32x4*)(gp) = acc[ai][0][m][0] * r + c0[0]; *(f32x4*)(gp + 4) = acc[ai][0][m][1] * r + c1[0]; } }
        } else if (kind == 1) { tile<true>(acc, rs, c0, c1, pn, row0, cl, b); }
        else { tile<false>(acc, rs, c0, c1, pn, row0, cl, b); }
    }
};

struct EpiResid {
    static constexpr bool PERM = true, AFTER_DRAIN = false;
    const bf16_t* xin; bf16_t* xout;
    const PG8_LAS float* gl; const PG8_LAS float* al;
    bf16_t* xa; unsigned long long* ssn; int write_xa;
    __device__ __forceinline__ void operator()(const f32x4 (&acc)[2][2][4][2], const Unit& u, int wr, int wc, int fr, int fq) const {
        const int row0 = u.pm * BM + wr * 64 + fr;
        const int colb = u.pn * BM + wc * 32 + 8 * fq;
        unsigned voff = (unsigned)(((size_t)row0 * DMC + colb) * 2); asm volatile("" : "+v"(voff));
#define RES_CO(ai, bj, m) ((size_t)(((ai) * HALF + (m) * 16) * DMC + (bj) * HALF) * 2)
#define RES_LD(ai, bj, buf) { _Pragma("unroll") for (int m = 0; m < 4; ++m) xr[buf][m] = *(const u32x4*)((const char*)xin + RES_CO(ai, bj, m) + voff); }
        u32x4 xr[2][4]; f32x4 g0, g1, a0, a1;
        RES_LD(0, 0, 0) RES_LD(1, 0, 1)
        asm volatile("" ::: "memory");
        float sq[2][4] = {{0.f, 0.f, 0.f, 0.f}, {0.f, 0.f, 0.f, 0.f}};
#pragma unroll
        for (int q = 0; q < 4; ++q) {
            const int bj = q >> 1, ai = q & 1, buf = q & 1;
            if (ai == 0) { const int col = colb + bj * HALF;
                g0 = *(const PG8_LAS f32x4*)(gl + col); g1 = *(const PG8_LAS f32x4*)(gl + col + 4); a0 = *(const PG8_LAS f32x4*)(al + col); a1 = *(const PG8_LAS f32x4*)(al + col + 4); }
#pragma unroll
            for (int m = 0; m < 4; ++m) { const u32x4 w = xr[buf][m];
                const f32x4 x0 = {__uint_as_float(w.x << 16), __uint_as_float(w.x & 0xffff0000u), __uint_as_float(w.y << 16), __uint_as_float(w.y & 0xffff0000u)};
                const f32x4 x1 = {__uint_as_float(w.z << 16), __uint_as_float(w.z & 0xffff0000u), __uint_as_float(w.w << 16), __uint_as_float(w.w & 0xffff0000u)};
                const f32x4 y0 = x0 + g0 * acc[ai][bj][m][0], y1 = x1 + g1 * acc[ai][bj][m][1];
                *(u32x4*)((char*)xout + RES_CO(ai, bj, m) + voff) = pack8(y0, y1);
                sq[ai][m] += (y0[0] * y0[0] + y0[1] * y0[1]) + (y0[2] * y0[2] + y0[3] * y0[3]) + (y1[0] * y1[0] + y1[1] * y1[1]) + (y1[2] * y1[2] + y1[3] * y1[3]);
                if (write_xa) *(u32x4*)((char*)xa + RES_CO(ai, bj, m) + voff) = pack8(y0 * a0, y1 * a1); }
            asm volatile("" ::: "memory");
            if (q == 0) RES_LD(0, 1, 0)
            if (q == 1) RES_LD(1, 1, 1)
            asm volatile("" ::: "memory");
            if (bj == 1) {
#pragma unroll
                for (int m = 0; m < 4; ++m) { float s2 = sq[ai][m]; s2 += shx<16>(s2); s2 = add_x32(s2);
                    if (fq == 0) __hip_atomic_fetch_add(ssn + (row0 + ai * HALF + m * 16), ss_fix(s2), __ATOMIC_RELAXED, __HIP_MEMORY_SCOPE_AGENT); }
            }
        }
#undef RES_LD
#undef RES_CO
    }
};

struct EpiFfnUp {
    static constexpr bool PERM = true, AFTER_DRAIN = false;
    const PG8_LAS float* cbl; const PG8_LAS float* rsl; int pm0; bf16_t* hb;
    __device__ __forceinline__ void operator()(const f32x4 (&acc)[2][2][4][2], const Unit& u, int wr, int wc, int fr, int fq) const {
        const int b = u.pm >> 4; const int row0 = u.pm * BM + wr * 64 + fr; const int cw = wc * 32 + 8 * fq;
        const PG8_LAS float* cbp = cbl + u.pn * BM + cw;
        const f32x4 cg0 = *(const PG8_LAS f32x4*)(cbp), cg1 = *(const PG8_LAS f32x4*)(cbp + 4), cu0 = *(const PG8_LAS f32x4*)(cbp + HALF), cu1 = *(const PG8_LAS f32x4*)(cbp + HALF + 4);
        float rs[2][4];
        { const PG8_LAS float* rp = rsl + (u.pm == pm0 ? 0 : 256) + wr * 64 + fr;
#pragma unroll
          for (int ai = 0; ai < 2; ++ai)
#pragma unroll
              for (int m = 0; m < 4; ++m) rs[ai][m] = rp[ai * HALF + m * 16]; }
#pragma unroll
        for (int ai = 0; ai < 2; ++ai)
#pragma unroll
            for (int m = 0; m < 4; ++m) { const int row = row0 + ai * HALF + m * 16;
                const float r = rs[ai][m];
                const f32x4 g0 = acc[ai][0][m][0] * r + cg0, g1 = acc[ai][0][m][1] * r + cg1, u0 = acc[ai][1][m][0] * r + cu0, u1 = acc[ai][1][m][1] * r + cu1;
                f32x4 h0, h1;
#pragma unroll
                for (int e = 0; e < 4; ++e) { h0[e] = silu_f(g0[e]) * u0[e]; h1[e] = silu_f(g1[e]) * u1[e]; }
                *(u32x4*)(hb + (size_t)b * ((::PBS - (size_t)4096 * DFFC * 2) / 2) + (size_t)row * DFFC + u.pn * HALF + cw) = pack8(h0, h1); }
    }
};

struct EpiNull {
    static constexpr bool PERM = true, AFTER_DRAIN = false;
    float* sink;
    __device__ __forceinline__ void operator()(const f32x4 (&acc)[2][2][4][2], const Unit& u, int wr, int wc, int fr, int fq) const {
        f32x4 s = (f32x4){0.f, 0.f, 0.f, 0.f};
#pragma unroll
        for (int ai = 0; ai < 2; ++ai)
#pragma unroll
            for (int bj = 0; bj < 2; ++bj)
#pragma unroll
                for (int m = 0; m < 4; ++m)
#pragma unroll
                    for (int n = 0; n < 2; ++n) s += acc[ai][bj][m][n];
        sink[(size_t)(u.pm * 32 + u.pn) * 512 + (wr * 4 + wc) * 64 + fq * 16 + fr] = (s[0] + s[1]) + (s[2] + s[3]);
    }
};
template <class Epi, class Sched, bool ALIGN_EPI = false, bool SP2 = false>
__device__ __forceinline__ void gemm_phase(PG8_LAS unsigned char* lds, const Gemm g, const Sched& S, const Epi& E, int tid) {
    asm volatile("" : "+v"(tid));
    const int wid = __builtin_amdgcn_readfirstlane(tid >> 6), lane = tid & 63, wr = wid >> 2, wc = wid & 3, fr = lane & 15, fq = lane >> 4;
    const int K = g.K, nt = K / BK;
    unsigned voffA[2], voffB[2];
#pragma unroll
    for (int i = 0; i < 2; ++i) { int R, C; stage_rc(tid * 16 + i * 8192, R, C); const int Rb = Epi::PERM ? ((R & ~31) + perm32(R & 31)) : R;
        voffA[i] = (unsigned)(R * K + C) * 2u; voffB[i] = (unsigned)(Rb * K + C) * 2u; }
    const size_t kstep = (size_t)(BK * 2);
    const size_t hstep = (size_t)HALF * K * 2;
    const size_t tstep = 2 * hstep;
    const unsigned ldsw = (unsigned)wid * 1024u;
    const int aoff = lds_byte(wr * 64 + fr, fq * 8), boff = lds_byte(wc * 32 + fr, fq * 8);
#define PG8_SA(b, h) (((b) * 2 + (h)) * HTB)
#define PG8_SB(b, h) ((4 + (b) * 2 + (h)) * HTB)
#define PG8_STAGE(bufoff, gbase, voff) do { _Pragma("unroll") for (int _i = 0; _i < 2; ++_i) \
        __builtin_amdgcn_global_load_lds((const unsigned*)((const char*)(gbase) + (voff)[_i]), (PG8_LAS unsigned*)(lds + (bufoff) + ldsw + _i * 8192), 16, 0, 0); } while (0)
#define PG8_LDA(dst, b, h) do { _Pragma("unroll") for (int m = 0; m < 4; ++m) _Pragma("unroll") for (int k = 0; k < 2; ++k) dst[m][k] = *(const PG8_LAS bf16x8*)(lds + PG8_SA(b, h) + aoff + m * 2048 + k * 1024); } while (0)
#define PG8_LDB(dst, b, h) do { _Pragma("unroll") for (int n = 0; n < 2; ++n) _Pragma("unroll") for (int k = 0; k < 2; ++k) dst[n][k] = *(const PG8_LAS bf16x8*)(lds + PG8_SB(b, h) + boff + n * 2048 + k * 1024); } while (0)
#define PG8_MMA(ai, bj, At, Bt) do { __builtin_amdgcn_s_setprio(1); _Pragma("unroll") for (int m = 0; m < 4; ++m) _Pragma("unroll") for (int n = 0; n < 2; ++n) _Pragma("unroll") for (int k = 0; k < 2; ++k) \
        acc[ai][bj][m][n] = __builtin_amdgcn_mfma_f32_16x16x32_bf16(Bt[n][k], At[m][k], acc[ai][bj][m][n], 0, 0, 0); __builtin_amdgcn_s_setprio(0); } while (0)
#define PG8_WAIT_V(n) asm volatile("s_waitcnt vmcnt(" #n ")" ::: "memory")
#define PG8_WAIT_L(n) asm volatile("s_waitcnt lgkmcnt(" #n ")" ::: "memory")
#define PG8_BAR __builtin_amdgcn_s_barrier()
#define PG8_SCHED __builtin_amdgcn_sched_barrier(0)
    Unit cur, nxt; int ui = 0;
    if (!S.next(0, cur)) return;
    f32x4 acc[2][2][4][2];
#pragma unroll
    for (int a = 0; a < 2; ++a)
#pragma unroll
        for (int b = 0; b < 2; ++b)
#pragma unroll
            for (int m = 0; m < 4; ++m)
#pragma unroll
                for (int n = 0; n < 2; ++n) acc[a][b][m][n] = (f32x4){0.f, 0.f, 0.f, 0.f};
    bf16x8 At[4][2], B0[2][2], B1[2][2];
    const char* cA = (const char*)g.A + (size_t)cur.pm * tstep + (size_t)(cur.pm >> 4) * g.abx; const char* cB = (const char*)g.Bt + (size_t)cur.pn * tstep;
    S.a_ready(cur);
    if constexpr (SP2) {
        PG8_STAGE(PG8_SB(0, 0), cB, voffB); PG8_STAGE(PG8_SB(0, 1), cB + hstep, voffB); PG8_STAGE(PG8_SA(0, 0), cA, voffA); PG8_STAGE(PG8_SA(0, 1), cA + hstep, voffA);
        if (wr == 1) PG8_BAR;
        PG8_WAIT_V(2); PG8_BAR;
        PG8_STAGE(PG8_SB(1, 0), cB + kstep, voffB); PG8_STAGE(PG8_SA(1, 0), cA + kstep, voffA); PG8_STAGE(PG8_SB(1, 1), cB + hstep + kstep, voffB);
        PG8_WAIT_V(6); PG8_BAR;
    } else {
        PG8_STAGE(PG8_SB(0, 0), cB, voffB); PG8_STAGE(PG8_SA(0, 0), cA, voffA); PG8_STAGE(PG8_SB(0, 1), cB + hstep, voffB); PG8_STAGE(PG8_SA(0, 1), cA + hstep, voffA);
        if (wr == 1) PG8_BAR;
        PG8_WAIT_V(4); PG8_BAR;
        PG8_STAGE(PG8_SB(1, 0), cB + kstep, voffB); PG8_STAGE(PG8_SA(1, 0), cA + kstep, voffA); PG8_STAGE(PG8_SB(1, 1), cB + hstep + kstep, voffB);
        PG8_WAIT_V(6); PG8_BAR;
    }
    for (;;) {
        const bool has_next = S.next(ui + 1, nxt);
        const char* nA = has_next ? (const char*)g.A + (size_t)nxt.pm * tstep + (size_t)(nxt.pm >> 4) * g.abx : cA; const char* nB = has_next ? (const char*)g.Bt + (size_t)nxt.pn * tstep : cB;
        for (int t = 0; t < nt; t += 2) {
            const bool last = (t == nt - 2);
            const char* a1 = cA + (size_t)(t + 1) * kstep;
            const char* a2 = last ? nA : cA + (size_t)(t + 2) * kstep; const char* b2 = last ? nB : cB + (size_t)(t + 2) * kstep;
            const char* a3 = a2 + kstep; const char* b3 = b2 + kstep;
            if (last && has_next) S.a_ready(nxt);
            if constexpr (SP2) {
            PG8_LDB(B0, 0, 0); PG8_LDB(B1, 0, 1); PG8_SCHED; PG8_LDA(At, 0, 0); PG8_STAGE(PG8_SA(1, 1), a1 + hstep, voffA);
            PG8_WAIT_V(8); PG8_WAIT_L(0); PG8_BAR; PG8_MMA(0, 0, At, B0); PG8_MMA(0, 1, At, B1); PG8_BAR; PG8_SCHED;
            PG8_LDA(At, 0, 1); PG8_STAGE(PG8_SB(0, 0), b2, voffB); PG8_STAGE(PG8_SB(0, 1), b2 + hstep, voffB); PG8_STAGE(PG8_SA(0, 0), a2, voffA);
            PG8_WAIT_V(8); PG8_WAIT_L(0); PG8_BAR; PG8_MMA(1, 0, At, B0); PG8_MMA(1, 1, At, B1); PG8_BAR; PG8_SCHED;
            PG8_LDB(B0, 1, 0); PG8_LDB(B1, 1, 1); PG8_SCHED; PG8_LDA(At, 1, 0); PG8_STAGE(PG8_SA(0, 1), a2 + hstep, voffA);
            PG8_WAIT_V(8); PG8_WAIT_L(0); PG8_BAR; PG8_MMA(0, 0, At, B0); PG8_MMA(0, 1, At, B1); PG8_BAR; PG8_SCHED;
            PG8_LDA(At, 1, 1); PG8_STAGE(PG8_SB(1, 0), b3, voffB); PG8_STAGE(PG8_SB(1, 1), b3 + hstep, voffB); PG8_STAGE(PG8_SA(1, 0), a3, voffA);
            PG8_WAIT_V(8); PG8_WAIT_L(0); PG8_BAR; PG8_MMA(1, 0, At, B0); PG8_MMA(1, 1, At, B1); PG8_BAR; PG8_SCHED;
            } else {
            PG8_LDB(B0, 0, 0); PG8_SCHED; PG8_LDA(At, 0, 0); PG8_STAGE(PG8_SA(1, 1), a1 + hstep, voffA);
            PG8_WAIT_L(8); PG8_BAR; PG8_WAIT_L(0); PG8_MMA(0, 0, At, B0); PG8_BAR; PG8_SCHED;
            PG8_LDB(B1, 0, 1); PG8_STAGE(PG8_SB(0, 0), b2, voffB);
            PG8_BAR; PG8_WAIT_L(0); PG8_MMA(0, 1, At, B1); PG8_BAR;
            PG8_LDA(At, 0, 1); PG8_STAGE(PG8_SA(0, 0), a2, voffA);
            PG8_BAR; PG8_WAIT_L(0); PG8_MMA(1, 0, At, B0); PG8_BAR; PG8_SCHED;
            PG8_STAGE(PG8_SB(0, 1), b2 + hstep, voffB);
            PG8_WAIT_V(6); PG8_BAR; PG8_MMA(1, 1, At, B1); PG8_BAR;
            PG8_LDB(B0, 1, 0); PG8_SCHED; PG8_LDA(At, 1, 0); PG8_STAGE(PG8_SA(0, 1), a2 + hstep, voffA);
            PG8_WAIT_L(8); PG8_BAR; PG8_WAIT_L(0); PG8_MMA(0, 0, At, B0); PG8_BAR; PG8_SCHED;
            PG8_LDB(B1, 1, 1); PG8_STAGE(PG8_SB(1, 0), b3, voffB);
            PG8_BAR; PG8_WAIT_L(0); PG8_MMA(0, 1, At, B1); PG8_BAR;
            PG8_LDA(At, 1, 1); PG8_STAGE(PG8_SA(1, 0), a3, voffA);
            PG8_BAR; PG8_WAIT_L(0); PG8_MMA(1, 0, At, B0); PG8_BAR; PG8_SCHED;
            PG8_STAGE(PG8_SB(1, 1), b3 + hstep, voffB);
            PG8_WAIT_V(6); PG8_BAR; PG8_MMA(1, 1, At, B1); PG8_BAR;
            }
        }
        if constexpr (ALIGN_EPI) { if (wr == 0) PG8_BAR; }
        if constexpr (!Epi::AFTER_DRAIN) { E(acc, cur, wr, wc, fr, fq); S.done(cur); }
        if (!has_next) break;
#pragma unroll
        for (int a = 0; a < 2; ++a)
#pragma unroll
            for (int b = 0; b < 2; ++b)
#pragma unroll
                for (int m = 0; m < 4; ++m)
#pragma unroll
                    for (int n = 0; n < 2; ++n) acc[a][b][m][n] = (f32x4){0.f, 0.f, 0.f, 0.f};
        cur = nxt; cA = nA; cB = nB; ++ui;
        if constexpr (ALIGN_EPI) { if (wr == 1) PG8_BAR; }
    }
    PG8_WAIT_V(0);
    if constexpr (!ALIGN_EPI) { if (wr == 0) PG8_BAR; }
    PG8_BAR;
    if constexpr (Epi::AFTER_DRAIN) { E.fused(acc, cur, wr, wc, fr, fq, lds, wid, lane); S.done(cur); }
#undef PG8_SA
#undef PG8_SB
#undef PG8_STAGE
#undef PG8_LDA
#undef PG8_LDB
#undef PG8_MMA
#undef PG8_WAIT_V
#undef PG8_WAIT_L
#undef PG8_BAR
#undef PG8_SCHED
}
}
#define GAS __attribute__((address_space(1)))
#define LAS __attribute__((address_space(3)))
typedef unsigned short bf16;
typedef unsigned v4u __attribute__((ext_vector_type(4)));
typedef float f32x4 __attribute__((ext_vector_type(4)));
typedef short bf16x8 __attribute__((ext_vector_type(8)));
typedef GAS unsigned gu32;
typedef GAS unsigned long long gu64;
#define RLX_AGENT __ATOMIC_RELAXED, __HIP_MEMORY_SCOPE_AGENT
#define LDS_WAIT() asm volatile("s_waitcnt lgkmcnt(0)" ::: "memory")
#define VM_WAIT() asm volatile("s_waitcnt vmcnt(0)" ::: "memory")
__device__ __forceinline__ unsigned long long rt() { return __builtin_amdgcn_s_memrealtime(); }
__device__ __forceinline__ unsigned f2bf(float f) { unsigned u = __builtin_bit_cast(unsigned, f); return (u + 0x7fffu + ((u >> 16) & 1u)) >> 16; }
__device__ __forceinline__ unsigned pk2(float lo, float hi) { return f2bf(lo) | (f2bf(hi) << 16); }
#define XB_TMO      128
#define XB_XCNT(j)  (256  + 64 * (j))
#define XB_XSUB(j)  (1280 + 64 * (j))
#define XB_XGEN(j)  (2304 + 64 * (j))
#define XB_TOP      3328
#define XB_TOPGEN   3392
#define XCD_BAR_WORDS 3456
#define XB_SPIN_CAP (1u << 18)

__device__ __forceinline__ unsigned xb_ld(unsigned* p)              { return __hip_atomic_load(p, __ATOMIC_RELAXED, __HIP_MEMORY_SCOPE_AGENT); }
__device__ __forceinline__ unsigned xb_add(unsigned* p, unsigned v) { return __hip_atomic_fetch_add(p, v, __ATOMIC_RELAXED, __HIP_MEMORY_SCOPE_AGENT); }
__device__ __forceinline__ unsigned xb_xcc_id() { return (unsigned)__builtin_amdgcn_s_getreg((3 << 11) | 20) & 0xFu; }
#define XB_SPIN(cond, bar) do { unsigned _sp = 0; while (cond) { __builtin_amdgcn_s_sleep(1); \
    if ((++_sp & 255u) == 0u) { if (xb_ld(&(bar)[XB_TMO])) break; if (_sp > XB_SPIN_CAP) { atomicAdd(&(bar)[XB_TMO], 1u); break; } } } } while (0)

struct XcdBarrier {
    unsigned* bar; unsigned x; int tid;
    volatile LAS unsigned* st;
};

__device__ __forceinline__ XcdBarrier xcd_barrier_post(unsigned* bar, volatile LAS unsigned* st) {
    XcdBarrier b; b.bar = bar; b.x = xb_xcc_id(); b.st = st; b.tid = (int)threadIdx.x;
    if (threadIdx.x == 0) st[2] = xb_add(&bar[XB_XCNT(b.x)], 1u);
    return b;
}
__device__ __forceinline__ void xcd_barrier_complete(unsigned* bar, unsigned x, unsigned& nloc, unsigned& nx, unsigned& uni) {
    const unsigned G = gridDim.x * gridDim.y * gridDim.z;
    unsigned sum, cnt, mine, n32, sp = 0u;
    for (;;) {
        sum = 0u; cnt = 0u; mine = 0u; n32 = 0u;
#pragma unroll
        for (unsigned j = 0; j < 16; ++j) { const unsigned c = xb_ld(&bar[XB_XCNT(j)]); sum += c; cnt += (c > 0u) ? 1u : 0u; mine = (j == x) ? c : mine; n32 += (j < 8u && c == 32u) ? 1u : 0u; }
        if (sum == G) break;
        __builtin_amdgcn_s_sleep(1);
        if ((++sp & 255u) == 0u) { if (xb_ld(&bar[XB_TMO])) break; if (sp > XB_SPIN_CAP) { atomicAdd(&bar[XB_TMO], 1u); break; } }
    }
    nloc = mine > 0u ? mine : 1u; nx = cnt > 0u ? cnt : 1u;
    uni = (sum == G && G == 256u && n32 == 8u) ? 1u : 2u;
}

__device__ __forceinline__ void xcd_barrier(const XcdBarrier& b, int local_only = 0) {
    asm volatile("s_waitcnt vmcnt(0)" ::: "memory");
    __syncthreads();
    if (b.tid == 0) {
        unsigned* bar = b.bar;
        __builtin_amdgcn_s_waitcnt(0);
        unsigned nloc = b.st[0], nx = b.st[1];
        if (nloc == 0u) { unsigned uni; xcd_barrier_complete(bar, b.x, nloc, nx, uni); b.st[0] = nloc; b.st[1] = nx; b.st[3] = uni; }
        const unsigned old = xb_add(&bar[XB_XSUB(b.x)], 1u);
        const unsigned gen = old / nloc;
        if (old + 1u == (gen + 1u) * nloc) {
            if (!local_only) {
            __builtin_amdgcn_fence(__ATOMIC_RELEASE, "agent");
            asm volatile("s_waitcnt vmcnt(0)" ::: "memory");
            const unsigned og = xb_add(&bar[XB_TOP], 1u);
            const unsigned tg = og / nx;
            if (og + 1u == (tg + 1u) * nx) xb_add(&bar[XB_TOPGEN], 1u);
            else XB_SPIN(xb_ld(&bar[XB_TOPGEN]) == tg, bar);
            }
            __builtin_amdgcn_fence(__ATOMIC_ACQUIRE, "agent");
            xb_add(&bar[XB_XGEN(b.x)], 1u);
            asm volatile("s_waitcnt vmcnt(0)" ::: "memory");
        } else {
            XB_SPIN(xb_ld(&bar[XB_XGEN(b.x)]) == gen, bar);
            __builtin_amdgcn_fence(__ATOMIC_ACQUIRE, "agent");
            asm volatile("s_waitcnt vmcnt(0)" ::: "memory");
        }
    }
    __syncthreads();
}
__device__ __forceinline__ float bf2f(unsigned short h) { return __uint_as_float((unsigned)h << 16); }
__device__ __forceinline__ float wave_sum(float v) {
    return add_x32(sum32(v));
}
__device__ __forceinline__ float rdl(float v, int l) { return __int_as_float(__builtin_amdgcn_readlane(__float_as_int(v), l)); }

struct TrDesc { const float* W; bf16* WT; int ldw, k0, src, nv, K, dst; };
__device__ __forceinline__ void tr_load(const TrDesc& d, f32x4 (&v)[8], int lane) {
    const int c4 = (lane & 7) * 4, kr = lane >> 3;
#pragma unroll
    for (int i = 0; i < 8; ++i) v[i] = (c4 < d.nv) ? *(const f32x4*)(d.W + (size_t)(d.k0 + kr + 8 * i) * d.ldw + d.src + c4) : (f32x4){0.f, 0.f, 0.f, 0.f};
}
__device__ __forceinline__ void tr_store(const TrDesc& d, const f32x4 (&v)[8], LAS float* scr, int lane) {
    const int c4 = (lane & 7) * 4, kr = lane >> 3;
#pragma unroll
    for (int i = 0; i < 8; ++i) *(LAS f32x4*)(scr + (kr + 8 * i) * 36 + c4) = v[i];
    LDS_WAIT(); asm volatile("" ::: "memory");
    const int c = lane & 7;
#pragma unroll
    for (int j = 0; j < 4; ++j) { const int n = (lane >> 3) + 8 * j; const LAS float* p = scr + (8 * c) * 36 + n;
        v4u o; o.x = pk2(p[0 * 36], p[1 * 36]); o.y = pk2(p[2 * 36], p[3 * 36]); o.z = pk2(p[4 * 36], p[5 * 36]); o.w = pk2(p[6 * 36], p[7 * 36]);
        *(GAS v4u*)(d.WT + (size_t)(d.dst + n) * d.K + d.k0 + 8 * c) = o; }
    LDS_WAIT(); asm volatile("" ::: "memory");
}

struct Ptrs {
    const float *x, *c, *ada_w, *ada_b, *norm1_g, *norm2_g, *w_in, *gla_wa2, *gla_ba, *gla_norm_g, *ret_norm_g, *w_out, *ffn_wg, *ffn_wu, *ffn_wd, *final_g;
    float* out; unsigned char* ws;
};

__device__ __forceinline__ void sincos_acc(float angf, float& s, float& c) {
    const double x = (double)angf;
    const double kq = __builtin_rint(x * 0.63661977236758134308);
    const double r = (x - kq * 1.57079632679489655800e+00) - kq * 6.12323399573676603587e-17;
    const double r2 = r * r;
    double sp = -1.0 / 1307674368000.0; sp = sp * r2 + 1.0 / 6227020800.0; sp = sp * r2 - 1.0 / 39916800.0; sp = sp * r2 + 1.0 / 362880.0; sp = sp * r2 - 1.0 / 5040.0; sp = sp * r2 + 1.0 / 120.0; sp = sp * r2 - 1.0 / 6.0; sp = sp * r2 + 1.0; sp *= r;
    double cp = 1.0 / 20922789888000.0; cp = cp * r2 - 1.0 / 87178291200.0; cp = cp * r2 + 1.0 / 479001600.0; cp = cp * r2 - 1.0 / 3628800.0; cp = cp * r2 + 1.0 / 40320.0; cp = cp * r2 - 1.0 / 720.0; cp = cp * r2 + 1.0 / 24.0; cp = cp * r2 - 0.5; cp = cp * r2 + 1.0;
    const int q = (int)kq & 3;
    const double sv = (q == 0) ? sp : (q == 1) ? cp : (q == 2) ? -sp : -cp;
    const double cv = (q == 0) ? cp : (q == 1) ? -sp : (q == 2) ? -cp : sp;
    s = (float)sv; c = (float)cv;
}

template <int DK, bool GLA>
__device__ __forceinline__ void seq_recurrent_v0(const bf16* Qp, const bf16* Kp, const bf16* Vp, const bf16* Gp, const float* GAp, const float* ng, bf16* OMp, int b, int h, int lane, int om_off) {
    float S[DK];
#pragma unroll
    for (int d = 0; d < DK; ++d) S[d] = 0.f;
    const float gam = GLA ? 0.f : (1.0f - exp2f(-5.0f - (float)h));
    const float ngv = ng[lane];
    const int dl = lane & (DK - 1);
    constexpr int LQK = DK * 4;
    size_t row = (size_t)b * SEQ;
    float qv = bf2f(Qp[row * LQK + h * DK + dl]), kv = bf2f(Kp[row * LQK + h * DK + dl]), av = GLA ? GAp[row * 128 + h * 32 + dl] : 0.f;
    float vv = bf2f(Vp[row * 256 + h * 64 + lane]), gv = bf2f(Gp[row * 256 + h * 64 + lane]);
    for (int t = 0; t < SEQ; ++t) {
        const size_t rn = (size_t)b * SEQ + (t + 1 < SEQ ? t + 1 : t);
        const float qn = bf2f(Qp[rn * LQK + h * DK + dl]), kn = bf2f(Kp[rn * LQK + h * DK + dl]), an = GLA ? GAp[rn * 128 + h * 32 + dl] : 0.f;
        const float vn = bf2f(Vp[rn * 256 + h * 64 + lane]), gn = bf2f(Gp[rn * 256 + h * 64 + lane]);
        float o = 0.f;
#pragma unroll
        for (int d = 0; d < DK; ++d) { const float kd = rdl(kv, d), qd = rdl(qv, d);
            if (GLA) { const float ad = rdl(av, d); S[d] = fmaf(kd, vv, ad * S[d]); } else { S[d] = fmaf(kd, vv, gam * S[d]); }
            o = fmaf(qd, S[d], o); }
        const float ms = wave_sum(o * o) * (1.0f / 64.0f);
        const float y = o * __builtin_amdgcn_rsqf(ms + 1e-6f) * ngv * (gv / (1.0f + __expf(-gv)));
        OMp[((size_t)b * SEQ + t) * DM + om_off + h * 64 + lane] = (bf16)f2bf(y);
        qv = qn; kv = kn; av = an; vv = vn; gv = gn;
    }
}

__device__ __forceinline__ void sb_unit_v0(const bf16* SQ, const bf16* SK, const bf16* SV, bf16* OM, int unit, int lane) {
    const int bh = unit >> 6, qb = unit & 63, b = bh >> 3, h = bh & 7;
    const int t = qb * 64 + lane; const size_t row = (size_t)b * SEQ + t;
    float q[64], o[64];
    { const v4u* qp = (const v4u*)(SQ + row * 512 + h * 64);
#pragma unroll
      for (int i = 0; i < 8; ++i) { const v4u w = qp[i];
          q[8 * i + 0] = __uint_as_float(w.x << 16); q[8 * i + 1] = __uint_as_float(w.x & 0xffff0000u); q[8 * i + 2] = __uint_as_float(w.y << 16); q[8 * i + 3] = __uint_as_float(w.y & 0xffff0000u);
          q[8 * i + 4] = __uint_as_float(w.z << 16); q[8 * i + 5] = __uint_as_float(w.z & 0xffff0000u); q[8 * i + 6] = __uint_as_float(w.w << 16); q[8 * i + 7] = __uint_as_float(w.w & 0xffff0000u); } }
#pragma unroll
    for (int i = 0; i < 64; ++i) o[i] = 0.f;
    float R = 0.f;
    for (int j = 1; j <= SEQ; ++j) {
        const bool act = (t - j >= 0) && (R > SB_THR);
        if (!__any(act)) break;
        if (act) {
            const v4u* kp = (const v4u*)(SK + (row - j) * 512 + h * 64);
            float z = 0.f;
#pragma unroll
            for (int i = 0; i < 8; ++i) { const v4u w = kp[i];
                z = fmaf(q[8 * i + 0], __uint_as_float(w.x << 16), z); z = fmaf(q[8 * i + 1], __uint_as_float(w.x & 0xffff0000u), z); z = fmaf(q[8 * i + 2], __uint_as_float(w.y << 16), z); z = fmaf(q[8 * i + 3], __uint_as_float(w.y & 0xffff0000u), z);
                z = fmaf(q[8 * i + 4], __uint_as_float(w.z << 16), z); z = fmaf(q[8 * i + 5], __uint_as_float(w.z & 0xffff0000u), z); z = fmaf(q[8 * i + 6], __uint_as_float(w.w << 16), z); z = fmaf(q[8 * i + 7], __uint_as_float(w.w & 0xffff0000u), z); }
            const float e = __expf(-fabsf(z)), l1p = __logf(1.0f + e);
            const float lsz = fminf(z, 0.f) - l1p, l1m = fminf(-z, 0.f) - l1p;
            const float w = __expf(lsz + R);
            const v4u* vp = (const v4u*)(SV + (row - j) * 512 + h * 64);
#pragma unroll
            for (int i = 0; i < 8; ++i) { const v4u x = vp[i];
                o[8 * i + 0] = fmaf(w, __uint_as_float(x.x << 16), o[8 * i + 0]); o[8 * i + 1] = fmaf(w, __uint_as_float(x.x & 0xffff0000u), o[8 * i + 1]); o[8 * i + 2] = fmaf(w, __uint_as_float(x.y << 16), o[8 * i + 2]); o[8 * i + 3] = fmaf(w, __uint_as_float(x.y & 0xffff0000u), o[8 * i + 3]);
                o[8 * i + 4] = fmaf(w, __uint_as_float(x.z << 16), o[8 * i + 4]); o[8 * i + 5] = fmaf(w, __uint_as_float(x.z & 0xffff0000u), o[8 * i + 5]); o[8 * i + 6] = fmaf(w, __uint_as_float(x.w << 16), o[8 * i + 6]); o[8 * i + 7] = fmaf(w, __uint_as_float(x.w & 0xffff0000u), o[8 * i + 7]); }
            R += l1m;
        }
    }
    v4u* op = (v4u*)(OM + row * DM + 512 + h * 64);
#pragma unroll
    for (int i = 0; i < 8; ++i) { v4u w; w.x = pk2(o[8 * i + 0], o[8 * i + 1]); w.y = pk2(o[8 * i + 2], o[8 * i + 3]); w.z = pk2(o[8 * i + 4], o[8 * i + 5]); w.w = pk2(o[8 * i + 6], o[8 * i + 7]); op[i] = w; }
}

typedef short v4i16_t __attribute__((ext_vector_type(4)));
typedef float f32x16 __attribute__((ext_vector_type(16)));
typedef float f32x2_t __attribute__((ext_vector_type(2)));
#define MFMA32(a, b, c) __builtin_amdgcn_mfma_f32_32x32x16_bf16((a), (b), (c), 0, 0, 0)
__device__ __forceinline__ int crow(int r, int hi) { return (r & 3) + 8 * (r >> 2) + 4 * hi; }
__device__ __forceinline__ int tr_lane_off(int lane) { return ((lane >> 4) & 1) * 32 + (lane & 3) * 8 + (4 * (lane >> 5) + ((lane & 15) >> 2)) * 64; }
__device__ __forceinline__ bf16x8 frag_tr(LAS unsigned char* p) {
    const v4i16_t lo = __builtin_amdgcn_ds_read_tr16_b64_v4i16((LAS v4i16_t*)p);
    const v4i16_t hi = __builtin_amdgcn_ds_read_tr16_b64_v4i16((LAS v4i16_t*)(p + 512));
    return (bf16x8){lo[0], lo[1], lo[2], lo[3], hi[0], hi[1], hi[2], hi[3]};
}
__device__ __forceinline__ void stage_row64(LAS unsigned char* slot, const bf16* src, int lane) {
    const v4u* sp = (const v4u*)src; v4u w[8];
#pragma unroll
    for (int j = 0; j < 8; ++j) w[j] = sp[j];
    LAS unsigned char* base = slot + (lane >> 4) * 1024 + (lane & 15) * 64;
#pragma unroll
    for (int j = 0; j < 8; ++j) *(LAS v4u*)(base + (j >> 2) * 4096 + (j & 3) * 16) = w[j];
}
__device__ __forceinline__ void unpack8(const v4u w, float* f) {
    f[0] = __uint_as_float(w.x << 16); f[1] = __uint_as_float(w.x & 0xffff0000u); f[2] = __uint_as_float(w.y << 16); f[3] = __uint_as_float(w.y & 0xffff0000u);
    f[4] = __uint_as_float(w.z << 16); f[5] = __uint_as_float(w.z & 0xffff0000u); f[6] = __uint_as_float(w.w << 16); f[7] = __uint_as_float(w.w & 0xffff0000u);
}
__device__ __forceinline__ v4u pack8f(const float* f) { v4u w; w.x = pg8::cvt_pk_bf16(f[0], f[1]); w.y = pg8::cvt_pk_bf16(f[2], f[3]); w.z = pg8::cvt_pk_bf16(f[4], f[5]); w.w = pg8::cvt_pk_bf16(f[6], f[7]); return w; }
__device__ __forceinline__ bf16x8 packP(const f32x16& P, int b0) {
    v4u w; w.x = pg8::cvt_pk_bf16(P[b0 + 0], P[b0 + 1]); w.y = pg8::cvt_pk_bf16(P[b0 + 2], P[b0 + 3]); w.z = pg8::cvt_pk_bf16(P[b0 + 4], P[b0 + 5]); w.w = pg8::cvt_pk_bf16(P[b0 + 6], P[b0 + 7]);
    return __builtin_bit_cast(bf16x8, w);
}
__device__ __forceinline__ float ret_log2_gamma(int h) { return log2f(1.0f - exp2f(-5.0f - (float)h)); }

template <int DK, bool GLA>
__device__ __forceinline__ void chunk_sum_unit(int ch, bf16* Qp, bf16* Kp, const bf16* Vp, const float* GRp, const float* wa2, const float* ba, float* KVT, float* DEC, LAS unsigned char* wlds, int lane) {
    asm volatile("" : "+v"(lane));
    const int b = ch >> 8, h = (ch >> 6) & 3, n = ch & 63; const size_t row = (size_t)b * SEQ + n * 64 + lane;
    constexpr int LQK = DK * 4;
    LAS unsigned char* vslot = wlds; LAS unsigned char* kslot = wlds + 8192;
    constexpr int PQ = DK / 8;
    constexpr int RQ_ = 64 / PQ;
    const size_t R0 = (size_t)b * SEQ + n * 64;
    const int pv = lane & 7, rv = lane >> 3;
    const int pq = lane & (PQ - 1), rq = lane / PQ;
    v4u vraw[8], kraw[PQ], qraw[PQ];
    float w[16], bias = 0.f;
    f32x4 grv[4];
    if (GLA) {
#pragma unroll
        for (int r = 0; r < 16; ++r) w[r] = wa2[r * 128 + h * 32 + (lane & 31)];
        bias = ba[h * 32 + (lane & 31)];
#pragma unroll
        for (int j = 0; j < 4; ++j) grv[j] = *(const f32x4*)(GRp + R0 * 16 + (size_t)(j * 64 + lane) * 4); }
#pragma unroll
    for (int i = 0; i < 8; ++i) vraw[i] = *(const v4u*)(Vp + (R0 + 8 * i + rv) * 256 + h * 64 + 8 * pv);
#pragma unroll
    for (int i = 0; i < PQ; ++i) { const size_t o = (R0 + RQ_ * i + rq) * LQK + h * DK + 8 * pq;
        kraw[i] = *(const v4u*)(Kp + o); if (GLA) qraw[i] = *(const v4u*)(Qp + o); }
    float ebls = 1.f, l2g = 0.f;
    LAS float* BT = (LAS float*)wlds; LAS float* grl = (LAS float*)(wlds + 12288); LAS float* T0 = (LAS float*)(wlds + 12288);
    if (GLA) {
#pragma unroll
        for (int j = 0; j < 4; ++j) *(LAS f32x4*)(grl + (j * 64 + lane) * 4) = grv[j];
        const int c = lane & 31, half = lane >> 5;
        asm volatile("s_waitcnt lgkmcnt(0)" ::: "memory");
        float run = 0.f;
#pragma unroll 4
        for (int tt = 0; tt < 32; ++tt) {
            const int t = half * 32 + tt;
            const f32x4 g0 = *(const LAS f32x4*)(grl + t * 16), g1 = *(const LAS f32x4*)(grl + t * 16 + 4), g2 = *(const LAS f32x4*)(grl + t * 16 + 8), g3 = *(const LAS f32x4*)(grl + t * 16 + 12);
            float u = bias;
            u = fmaf(g0[0], w[0], u); u = fmaf(g0[1], w[1], u); u = fmaf(g0[2], w[2], u); u = fmaf(g0[3], w[3], u);
            u = fmaf(g1[0], w[4], u); u = fmaf(g1[1], w[5], u); u = fmaf(g1[2], w[6], u); u = fmaf(g1[3], w[7], u);
            u = fmaf(g2[0], w[8], u); u = fmaf(g2[1], w[9], u); u = fmaf(g2[2], w[10], u); u = fmaf(g2[3], w[11], u);
            u = fmaf(g3[0], w[12], u); u = fmaf(g3[1], w[13], u); u = fmaf(g3[2], w[14], u); u = fmaf(g3[3], w[15], u);
            run += (fminf(u, 0.f) - __logf(1.0f + __expf(-fabsf(u)))) * (1.0f / 16.0f);
            BT[t * 32 + c] = run;
        }
        asm volatile("s_waitcnt lgkmcnt(0)" ::: "memory");
        if (half == 0) T0[c] = run;
        asm volatile("s_waitcnt lgkmcnt(0)" ::: "memory");
    } else {
        l2g = ret_log2_gamma(h); ebls = exp2f(64.0f * l2g);
    }
#pragma unroll
    for (int i = 0; i < PQ; ++i) {
        const int r = RQ_ * i + rq;
        float kk[8], qq[8], kh[8], e8[8], el8[8];
        if (GLA) {
            const f32x4 b0 = *(const LAS f32x4*)(BT + r * 32 + 8 * pq), b1 = *(const LAS f32x4*)(BT + r * 32 + 8 * pq + 4);
            const f32x4 t0 = *(const LAS f32x4*)(T0 + 8 * pq), t1 = *(const LAS f32x4*)(T0 + 8 * pq + 4);
            const f32x4 l0 = *(const LAS f32x4*)(BT + 63 * 32 + 8 * pq) + t0, l1 = *(const LAS f32x4*)(BT + 63 * 32 + 8 * pq + 4) + t1;
            const float addt = (r >= 32) ? 1.0f : 0.0f;
#pragma unroll
            for (int e = 0; e < 4; ++e) { e8[e] = __expf(b0[e] + addt * t0[e]); e8[4 + e] = __expf(b1[e] + addt * t1[e]); el8[e] = __expf(l0[e]); el8[4 + e] = __expf(l1[e]); }
            if (i == 0 && rq == 0) { *(f32x4*)(DEC + (size_t)(b * 64 + n) * 128 + h * 32 + 8 * pq) = (f32x4){el8[0], el8[1], el8[2], el8[3]}; *(f32x4*)(DEC + (size_t)(b * 64 + n) * 128 + h * 32 + 8 * pq + 4) = (f32x4){el8[4], el8[5], el8[6], el8[7]}; }
        }
        unpack8(kraw[i], kk); if (GLA) unpack8(qraw[i], qq);
        const float iebs = GLA ? 1.f : exp2f(-(float)(r + 1) * l2g);
#pragma unroll
        for (int e = 0; e < 8; ++e) {
            if (GLA) { qq[e] *= e8[e]; kk[e] *= __builtin_amdgcn_rcpf(e8[e]); kh[e] = kk[e] * el8[e]; }
            else { kk[e] *= iebs; kh[e] = kk[e] * ebls; }
        }
        if (GLA) { const size_t o = (R0 + r) * LQK + h * DK + 8 * pq; *(v4u*)(Qp + o) = pack8f(qq); *(v4u*)(Kp + o) = pack8f(kk); }
        *(LAS v4u*)(kslot + (pq >> 2) * 4096 + (r >> 4) * 1024 + (r & 15) * 64 + (pq & 3) * 16) = pack8f(kh);
    }
    asm volatile("s_waitcnt lgkmcnt(0)" ::: "memory");
#pragma unroll
    for (int i = 0; i < 8; ++i) { const int r = 8 * i + rv; *(LAS v4u*)(vslot + (pv >> 2) * 4096 + (r >> 4) * 1024 + (r & 15) * 64 + (pv & 3) * 16) = vraw[i]; }
    asm volatile("s_waitcnt lgkmcnt(0)" ::: "memory");
    const int hi = lane >> 5, tro = tr_lane_off(lane);
    f32x16 acc[2][DK / 32];
#pragma unroll
    for (int eh = 0; eh < 2; ++eh)
#pragma unroll
        for (int dh = 0; dh < DK / 32; ++dh) acc[eh][dh] = (f32x16){0.f, 0.f, 0.f, 0.f, 0.f, 0.f, 0.f, 0.f, 0.f, 0.f, 0.f, 0.f, 0.f, 0.f, 0.f, 0.f};
#pragma unroll
    for (int rg = 0; rg < 4; ++rg) {
        bf16x8 vf[2], kf[DK / 32];
#pragma unroll
        for (int eh = 0; eh < 2; ++eh) vf[eh] = frag_tr(vslot + eh * 4096 + rg * 1024 + tro);
#pragma unroll
        for (int dh = 0; dh < DK / 32; ++dh) kf[dh] = frag_tr(kslot + dh * 4096 + rg * 1024 + tro);
#pragma unroll
        for (int eh = 0; eh < 2; ++eh)
#pragma unroll
            for (int dh = 0; dh < DK / 32; ++dh) acc[eh][dh] = MFMA32(vf[eh], kf[dh], acc[eh][dh]);
    }
    unsigned short* kvp = (unsigned short*)KVT + (size_t)ch * (64 * DK);
#pragma unroll
    for (int eh = 0; eh < 2; ++eh)
#pragma unroll
        for (int dh = 0; dh < DK / 32; ++dh)
#pragma unroll
            for (int r = 0; r < 16; ++r) kvp[(32 * eh + crow(r, hi)) * DK + 32 * dh + (lane & 31)] = (unsigned short)f2bf(acc[eh][dh][r]);
    asm volatile("s_waitcnt lgkmcnt(0)" ::: "memory");
}

template <int DK, bool GLA>
__device__ __forceinline__ void scan_unit(int seq, int part, const float* KVT, const float* DEC, bf16* ST, int lane) {
    const int idx = part * 128 + lane * 2; const int d = idx & (DK - 1);
    const int b = seq >> 2, h = seq & 3;
    float s0 = 0.f, s1 = 0.f;
    const float gdec = GLA ? 0.f : exp2f(64.0f * ret_log2_gamma(h));
    for (int n0 = 0; n0 < 64; n0 += 32) {
        float kv0[32], kv1[32], d0[32], d1[32];
#pragma unroll
        for (int i = 0; i < 32; ++i) { const size_t chn = (size_t)seq * 64 + n0 + i;
            const unsigned kvw = *(const unsigned*)((const unsigned short*)KVT + chn * (64 * DK) + idx); kv0[i] = __uint_as_float(kvw << 16); kv1[i] = __uint_as_float(kvw & 0xffff0000u);
            if (GLA) { const f32x2_t dd = *(const f32x2_t*)(DEC + (size_t)(b * 64 + n0 + i) * 128 + h * 32 + d); d0[i] = dd.x; d1[i] = dd.y; } else { d0[i] = gdec; d1[i] = gdec; } }
#pragma unroll
        for (int i = 0; i < 32; ++i) { const size_t chn = (size_t)seq * 64 + n0 + i;
            *(unsigned*)(ST + chn * (64 * DK) + idx) = pg8::cvt_pk_bf16(s0, s1);
            s0 = fmaf(d0[i], s0, kv0[i]); s1 = fmaf(d1[i], s1, kv1[i]); }
    }
}

template <int DK>
__device__ __forceinline__ void chunk_out_unit(int ch, const bf16* Qp, const bf16* Kp, const bf16* Vp, const bf16* Gp, const bf16* ST, const float* ng, bf16* OMp, int om_off, LAS unsigned char* wlds, LAS float* ngl, int lane) {
    asm volatile("" : "+v"(lane));
    const float ngv = ng[lane];
    const int b = ch >> 8, h = (ch >> 6) & 3, n = ch & 63; const size_t R0 = (size_t)b * SEQ + n * 64;
    constexpr int LQK = DK * 4, NKS = DK / 16;
    const int hi = lane >> 5, l31 = lane & 31, tro = tr_lane_off(lane);
    LAS unsigned char* vslot = wlds;
    bf16x8 qf[2][NKS], kf[2][NKS], sf[NKS][2];
    v4u graw[2][4];
#pragma unroll
    for (int tb = 0; tb < 2; ++tb)
#pragma unroll
        for (int i = 0; i < 4; ++i) graw[tb][i] = *(const v4u*)(Gp + (R0 + 32 * tb + 8 * i + (lane >> 3)) * 256 + h * 64 + 8 * (lane & 7));
    constexpr int PQ = DK / 8, RQ_ = 64 / PQ;
    const int pq = lane & (PQ - 1), rq = lane / PQ, pv = lane & 7, rv = lane >> 3;
    v4u qraw[PQ], kraw[PQ], sraw[PQ], vrow[8];
#pragma unroll
    for (int i = 0; i < PQ; ++i) { const size_t o = (R0 + RQ_ * i + rq) * LQK + h * DK + 8 * pq;
        qraw[i] = *(const v4u*)(Qp + o); kraw[i] = *(const v4u*)(Kp + o);
        sraw[i] = *(const v4u*)(ST + (size_t)ch * (64 * DK) + (RQ_ * i + rq) * DK + 8 * pq); }
#pragma unroll
    for (int i = 0; i < 8; ++i) vrow[i] = *(const v4u*)(Vp + (R0 + 8 * i + rv) * 256 + h * 64 + 8 * pv);
    asm volatile("" ::: "memory");
    {
        LAS unsigned char* img = wlds + 8192;
#define CO_PUT(raw) { _Pragma("unroll") for (int i = 0; i < PQ; ++i) { const int r = RQ_ * i + rq; *(LAS v4u*)(img + (pq >> 2) * 4096 + (r >> 4) * 1024 + (r & 15) * 64 + (pq & 3) * 16) = raw[i]; } }
#define CO_FRAG(row, piece) (*(const LAS bf16x8*)(img + ((piece) >> 2) * 4096 + ((row) >> 4) * 1024 + ((row) & 15) * 64 + ((piece) & 3) * 16))
        CO_PUT(qraw) asm volatile("s_waitcnt lgkmcnt(0)" ::: "memory");
#pragma unroll
        for (int half = 0; half < 2; ++half)
#pragma unroll
            for (int ks = 0; ks < NKS; ++ks) qf[half][ks] = CO_FRAG(32 * half + l31, 2 * ks + hi);
        asm volatile("s_waitcnt lgkmcnt(0)" ::: "memory");
        CO_PUT(kraw) asm volatile("s_waitcnt lgkmcnt(0)" ::: "memory");
#pragma unroll
        for (int half = 0; half < 2; ++half)
#pragma unroll
            for (int ks = 0; ks < NKS; ++ks) kf[half][ks] = CO_FRAG(32 * half + l31, 2 * ks + hi);
        asm volatile("s_waitcnt lgkmcnt(0)" ::: "memory");
        CO_PUT(sraw) asm volatile("s_waitcnt lgkmcnt(0)" ::: "memory");
#pragma unroll
        for (int ks = 0; ks < NKS; ++ks)
#pragma unroll
            for (int dh = 0; dh < 2; ++dh) sf[ks][dh] = CO_FRAG(32 * dh + l31, 2 * ks + hi);
        asm volatile("s_waitcnt lgkmcnt(0)" ::: "memory");
#undef CO_PUT
#undef CO_FRAG
#pragma unroll
        for (int i = 0; i < 8; ++i) { const int r = 8 * i + rv; *(LAS v4u*)(vslot + (pv >> 2) * 4096 + (r >> 4) * 1024 + (r & 15) * 64 + (pv & 3) * 16) = vrow[i]; }
    }
    ngl[lane] = ngv;
    asm volatile("s_waitcnt lgkmcnt(0)" ::: "memory");
    if (DK == 64) {
        const float l2g = ret_log2_gamma(h);
#pragma unroll
        for (int half = 0; half < 2; ++half) { const float tq = (float)(32 * half + l31 + 1); const float sq_ = exp2f(tq * l2g), sk_ = exp2f(-tq * l2g);
#pragma unroll
            for (int ks = 0; ks < NKS; ++ks) { float f[8];
                unpack8(__builtin_bit_cast(v4u, qf[half][ks]), f);
#pragma unroll
                for (int e = 0; e < 8; ++e) f[e] *= sq_;
                qf[half][ks] = __builtin_bit_cast(bf16x8, pack8f(f));
                unpack8(__builtin_bit_cast(v4u, kf[half][ks]), f);
#pragma unroll
                for (int e = 0; e < 8; ++e) f[e] *= sk_;
                kf[half][ks] = __builtin_bit_cast(bf16x8, pack8f(f)); } }
    }
#pragma unroll
    for (int tb = 0; tb < 2; ++tb) {
        f32x16 o0 = (f32x16){0.f, 0.f, 0.f, 0.f, 0.f, 0.f, 0.f, 0.f, 0.f, 0.f, 0.f, 0.f, 0.f, 0.f, 0.f, 0.f}, o1 = o0;
#pragma unroll
        for (int ks = 0; ks < NKS; ++ks) { o0 = MFMA32(qf[tb][ks], sf[ks][0], o0); o1 = MFMA32(qf[tb][ks], sf[ks][1], o1); }
#pragma unroll
        for (int kh = 0; kh <= tb; ++kh) {
            f32x16 P = (f32x16){0.f, 0.f, 0.f, 0.f, 0.f, 0.f, 0.f, 0.f, 0.f, 0.f, 0.f, 0.f, 0.f, 0.f, 0.f, 0.f};
#pragma unroll
            for (int ks = 0; ks < NKS; ++ks) P = MFMA32(kf[kh][ks], qf[tb][ks], P);
            if (kh == tb) {
#pragma unroll
                for (int r = 0; r < 16; ++r) if (crow(r, hi) > l31) P[r] = 0.f;
            }
            const bf16x8 pa0 = packP(P, 0), pa1 = packP(P, 8);
            const bf16x8 v00 = frag_tr(vslot + 0 * 4096 + (2 * kh) * 1024 + tro), v01 = frag_tr(vslot + 0 * 4096 + (2 * kh + 1) * 1024 + tro);
            const bf16x8 v10 = frag_tr(vslot + 1 * 4096 + (2 * kh) * 1024 + tro), v11 = frag_tr(vslot + 1 * 4096 + (2 * kh + 1) * 1024 + tro);
            o0 = MFMA32(pa0, v00, o0); o0 = MFMA32(pa1, v01, o0);
            o1 = MFMA32(pa0, v10, o1); o1 = MFMA32(pa1, v11, o1);
        }
        {
            LAS float* OT = (LAS float*)(wlds + 8192);
#pragma unroll
            for (int r = 0; r < 16; ++r) { const int tt = crow(r, hi); OT[tt * 64 + (l31 ^ ((tt & 7) << 2))] = o0[r]; OT[tt * 64 + ((32 + l31) ^ ((tt & 7) << 2))] = o1[r]; }
            asm volatile("s_waitcnt lgkmcnt(0)" ::: "memory");
            const int pp = lane & 7;
            const f32x4 n0 = *(const LAS f32x4*)(ngl + 8 * pp), n1 = *(const LAS f32x4*)(ngl + 8 * pp + 4);
#pragma unroll
            for (int i = 0; i < 4; ++i) { const int rr = 8 * i + (lane >> 3); const int sw = (rr & 7) << 2;
                const f32x4 x0 = *(const LAS f32x4*)(OT + rr * 64 + ((8 * pp) ^ sw)), x1 = *(const LAS f32x4*)(OT + rr * 64 + ((8 * pp + 4) ^ sw));
                float sq = (x0[0] * x0[0] + x0[1] * x0[1]) + (x0[2] * x0[2] + x0[3] * x0[3]) + (x1[0] * x1[0] + x1[1] * x1[1]) + (x1[2] * x1[2] + x1[3] * x1[3]);
                sq += shx<1>(sq); sq += shx<2>(sq); sq += shx<4>(sq);
                const float rs = __builtin_amdgcn_rsqf(sq * (1.0f / 64.0f) + 1e-6f);
                float g[8], y[8]; unpack8(graw[tb][i], g);
#pragma unroll
                for (int e = 0; e < 8; ++e) { const float nn = (e < 4) ? n0[e & 3] : n1[e & 3]; const float xv = (e < 4) ? x0[e & 3] : x1[e & 3]; y[e] = xv * rs * nn * (g[e] * __builtin_amdgcn_rcpf(1.0f + __expf(-g[e]))); }
                *(v4u*)(OMp + (R0 + 32 * tb + rr) * DM + om_off + h * 64 + 8 * pp) = pack8f(y); }
            asm volatile("s_waitcnt lgkmcnt(0)" ::: "memory");
        }
    }
    asm volatile("s_waitcnt lgkmcnt(0)" ::: "memory");
}

struct SbK { bf16x8 a0[4], a1[4]; };
__device__ __forceinline__ void sb_dma_k(const bf16* SK, size_t rowbase, int s0, int h, int lane, LAS unsigned char* kslot) {
    const char* kb = (const char*)(SK + (rowbase + s0) * 512 + h * 64); const unsigned voff = (unsigned)(lane >> 3) * 1024u + (unsigned)((lane & 7) ^ (lane >> 3)) * 16u;
#pragma unroll
    for (int c = 0; c < 8; ++c) __builtin_amdgcn_global_load_lds((const unsigned*)(kb + c * 8192 + voff), (LAS unsigned*)(kslot + c * 1024), 16, 0, 0);
}
__device__ __forceinline__ void sb_dma_v(const bf16* SV, size_t rowbase, int s0, int h, int lane, LAS unsigned char* vslot) {
    const char* vb = (const char*)(SV + (rowbase + s0) * 512 + h * 64); const unsigned voff = (unsigned)(lane >> 2) * 1024u + (unsigned)(lane & 3) * 16u;
#pragma unroll
    for (int p = 0; p < 8; ++p)
        __builtin_amdgcn_global_load_lds((const unsigned*)(vb + (16 * (p & 3)) * 1024 + (p >> 2) * 64 + voff), (LAS unsigned*)(vslot + p * 1024), 16, 0, 0);
}
__device__ __forceinline__ void sb_read_k(SbK& k, LAS unsigned char* kslot, int lane) {
    const int l31 = lane & 31, hi = lane >> 5;
#pragma unroll
    for (int ks = 0; ks < 4; ++ks) { const int slot = (2 * ks + hi) ^ (l31 & 7);
        k.a0[ks] = *(const LAS bf16x8*)(kslot + l31 * 128 + slot * 16); k.a1[ks] = *(const LAS bf16x8*)(kslot + 4096 + l31 * 128 + slot * 16); }
}
template <bool DIAG>
__device__ __forceinline__ void sb_half(const bf16x8 (&ka)[4], const bf16x8 (&qr)[4], float& suf, int sbase, int t, int hi, bf16x8& paLo, bf16x8& paHi) {
    f32x16 p = (f32x16){0.f, 0.f, 0.f, 0.f, 0.f, 0.f, 0.f, 0.f, 0.f, 0.f, 0.f, 0.f, 0.f, 0.f, 0.f, 0.f};
#pragma unroll
    for (int ks = 0; ks < 4; ++ks) p = MFMA32(ka[ks], qr[ks], p);
    float om[16];
#pragma unroll
    for (int r = 0; r < 16; ++r) {
        const float e = __builtin_amdgcn_exp2f(-fmaxf(p[r], -100.0f)); float sg = __builtin_amdgcn_rcpf(1.0f + e), o1 = e * sg;
        if (DIAG) { const bool ok = (sbase + crow(r, hi) < t); sg = ok ? sg : 0.f; o1 = ok ? o1 : 1.0f; }
        p[r] = sg; om[r] = o1;
    }
    float G[4], H[4], sg4[4];
#pragma unroll
    for (int q = 0; q < 4; ++q) G[q] = (om[4 * q] * om[4 * q + 1]) * (om[4 * q + 2] * om[4 * q + 3]);
#pragma unroll
    for (int q = 0; q < 4; ++q) H[q] = get_x32(G[q], hi);
#pragma unroll
    for (int q = 3; q >= 0; --q) { sg4[q] = suf * (hi ? 1.0f : H[q]); suf *= G[q] * H[q]; }
#pragma unroll
    for (int q = 0; q < 4; ++q) { float s = sg4[q];
        p[4 * q + 3] *= s; s *= om[4 * q + 3]; p[4 * q + 2] *= s; s *= om[4 * q + 2]; p[4 * q + 1] *= s; s *= om[4 * q + 1]; p[4 * q] *= s; }
    paLo = packP(p, 0); paHi = packP(p, 8);
}
template <bool DIAG, int BLK>
__device__ __forceinline__ void sb_tile(const SbK& k, const bf16x8 (&qr)[4], LAS unsigned char* slot, f32x16& o0, f32x16& o1, float& R, int s0, int t, int hi, int tro) {
    float suf = R; bf16x8 paLo, paHi;
    if (!(DIAG && BLK == 0)) {
    sb_half<DIAG>(k.a1, qr, suf, s0 + 32, t, hi, paLo, paHi);
    o0 = MFMA32(paLo, frag_tr(slot + 2 * 1024 + tro), o0); o1 = MFMA32(paLo, frag_tr(slot + 4096 + 2 * 1024 + tro), o1);
    o0 = MFMA32(paHi, frag_tr(slot + 3 * 1024 + tro), o0); o1 = MFMA32(paHi, frag_tr(slot + 4096 + 3 * 1024 + tro), o1);
    }
    sb_half<(DIAG && BLK == 0)>(k.a0, qr, suf, s0, t, hi, paLo, paHi);
    o0 = MFMA32(paLo, frag_tr(slot + 0 * 1024 + tro), o0); o1 = MFMA32(paLo, frag_tr(slot + 4096 + 0 * 1024 + tro), o1);
    o0 = MFMA32(paHi, frag_tr(slot + 1 * 1024 + tro), o0); o1 = MFMA32(paHi, frag_tr(slot + 4096 + 1 * 1024 + tro), o1);
    R = suf;
}
template <bool DIAG>
__device__ __forceinline__ void sb_iter(const bf16* SK, const bf16* SV, size_t rowbase, int j, int h, int lane, LAS unsigned char* kslot, LAS unsigned char* vslot,
                                        const bf16x8 (&qrA)[4], const bf16x8 (&qrB)[4], f32x16& oA0, f32x16& oA1, f32x16& oB0, f32x16& oB1, float& RA, float& RB, bool& doneA, bool& doneB, int tA, int hi, int tro) {
    asm volatile("s_waitcnt vmcnt(8)" ::: "memory");
    SbK k; sb_read_k(k, kslot, lane);
    asm volatile("s_waitcnt lgkmcnt(0)" ::: "memory");
    if (j > 0) { sb_dma_k(SK, rowbase, (j - 1) * 64, h, lane, kslot); asm volatile("s_waitcnt vmcnt(8)" ::: "memory"); }
    else asm volatile("s_waitcnt vmcnt(0)" ::: "memory");
    if (!doneA) { sb_tile<DIAG, 0>(k, qrA, vslot, oA0, oA1, RA, j * 64, tA, hi, tro); doneA = __all(RA < SB_PMIN); }
    if (!doneB) { sb_tile<DIAG, 1>(k, qrB, vslot, oB0, oB1, RB, j * 64, tA + 32, hi, tro); doneB = __all(RB < SB_PMIN); }
    asm volatile("s_waitcnt lgkmcnt(0)" ::: "memory");
    if (j > 0) sb_dma_v(SV, rowbase, (j - 1) * 64, h, lane, vslot);
}
__device__ __forceinline__ void sb_unit_v1(int unit, const bf16* SQ, const bf16* SK, const bf16* SV, bf16* OM, LAS unsigned char* wlds, int lane) {
    asm volatile("" : "+v"(lane));
    const int bh = unit >> 6, qb = unit & 63, b = bh >> 3, h = bh & 7;
    const int hi = lane >> 5, l31 = lane & 31, tro = tr_lane_off(lane);
    const size_t rowbase = (size_t)b * SEQ; const int t0 = qb * 64; const int tA = t0 + l31;
    LAS unsigned char* kslot = wlds; LAS unsigned char* vslot = wlds + 8192;
    asm volatile("s_waitcnt lgkmcnt(0)" ::: "memory");
    int j = qb;
    sb_dma_k(SK, rowbase, j * 64, h, lane, kslot); sb_dma_v(SV, rowbase, j * 64, h, lane, vslot);
    bf16x8 qrA[4], qrB[4];
#pragma unroll
    for (int ks = 0; ks < 4; ++ks) { qrA[ks] = *(const bf16x8*)(SQ + (rowbase + tA) * 512 + h * 64 + 16 * ks + 8 * hi); qrB[ks] = *(const bf16x8*)(SQ + (rowbase + tA + 32) * 512 + h * 64 + 16 * ks + 8 * hi); }
    const f32x16 zero16 = (f32x16){0.f, 0.f, 0.f, 0.f, 0.f, 0.f, 0.f, 0.f, 0.f, 0.f, 0.f, 0.f, 0.f, 0.f, 0.f, 0.f};
    f32x16 oA0 = zero16, oA1 = zero16, oB0 = zero16, oB1 = zero16;
    float RA = 1.0f, RB = 1.0f; bool doneA = false, doneB = false;
    sb_iter<true>(SK, SV, rowbase, j, h, lane, kslot, vslot, qrA, qrB, oA0, oA1, oB0, oB1, RA, RB, doneA, doneB, tA, hi, tro);
    while (j > 0 && !(doneA && doneB)) {
        --j;
        sb_iter<false>(SK, SV, rowbase, j, h, lane, kslot, vslot, qrA, qrB, oA0, oA1, oB0, oB1, RA, RB, doneA, doneB, tA, hi, tro);
    }
    asm volatile("s_waitcnt vmcnt(0) lgkmcnt(0)" ::: "memory");
    { LAS float* OT = (LAS float*)wlds;
#pragma unroll
      for (int r = 0; r < 16; ++r) { const int tt = crow(r, hi); const int sw = (tt & 7) << 2;
          OT[tt * 64 + (l31 ^ sw)] = oA0[r]; OT[tt * 64 + ((32 + l31) ^ sw)] = oA1[r]; OT[2048 + tt * 64 + (l31 ^ sw)] = oB0[r]; OT[2048 + tt * 64 + ((32 + l31) ^ sw)] = oB1[r]; }
      asm volatile("s_waitcnt lgkmcnt(0)" ::: "memory");
      const int pp = lane & 7;
#pragma unroll
      for (int i = 0; i < 8; ++i) { const int rr = 8 * i + (lane >> 3);
          const int sw = (rr & 7) << 2; const LAS float* src = OT + (rr >> 5) * 2048 + (rr & 31) * 64;
          const f32x4 x0 = *(const LAS f32x4*)(src + ((8 * pp) ^ sw)), x1 = *(const LAS f32x4*)(src + ((8 * pp + 4) ^ sw));
          float y[8] = {x0[0], x0[1], x0[2], x0[3], x1[0], x1[1], x1[2], x1[3]};
          *(v4u*)(OM + (rowbase + t0 + rr) * DM + 512 + h * 64 + 8 * pp) = pack8f(y); }
      asm volatile("s_waitcnt lgkmcnt(0)" ::: "memory"); }
}

__device__ __forceinline__ int lane_now() { int l; asm volatile("v_mbcnt_lo_u32_b32 %0, -1, 0\n\tv_mbcnt_hi_u32_b32 %0, -1, %0" : "=v"(l)); return l; }
struct Args { const float* in[16]; float* out; unsigned char* ws; int ph_lo, ph_hi; };
__global__ void __launch_bounds__(NWAVES * 64, 2) mk_fwd(Args args) {
    extern __shared__ __attribute__((aligned(16))) unsigned char lds_raw[];
    LAS unsigned char* lds = (LAS unsigned char*)lds_raw;
    volatile LAS unsigned* MISC = (volatile LAS unsigned*)(lds + MISC_OFF);
    const int wave_k = __builtin_amdgcn_readfirstlane((int)threadIdx.x >> 6);
#define TID_NOW() (wave_k * 64 + lane_now())
    const int G = gridDim.x; const int bx = blockIdx.x; const int NGW = G * NWAVES;
    int bxe = bx, lmode = 0;
    typedef __attribute__((address_space(4))) const unsigned long long kargw_t;
    const kargw_t* kargs = (const kargw_t*)__builtin_amdgcn_kernarg_segment_ptr();
#define PH_BEGIN() const kargw_t* kq_ = kargs; asm volatile("" : "+s"(kq_)); int tid = TID_NOW(); asm volatile("" : "+v"(tid)); const int lane = tid & 63, wave = __builtin_amdgcn_readfirstlane(tid >> 6); \
    const int vcu = (G % 8 == 0) ? (bxe % 8) * (G / 8) + bxe / 8 : bxe; const int gw = vcu * NWAVES + wave; (void)lane; (void)wave; (void)vcu; (void)gw; \
    unsigned char* ws = (unsigned char*)(GAS unsigned char*)kq_[17]; float* out = (float*)(GAS float*)kq_[16]; (void)out; \
    gu32* ctl = (gu32*)(ws + WS_CTL); (void)ctl; unsigned long long* SS = (unsigned long long*)(ws + WS_SS); float* MOD = (float*)(ws + WS_MOD); float* CBIN = (float*)(ws + WS_CBIN); float* CBUP = (float*)(ws + WS_CBUP); float* ROT = (float*)(ws + WS_ROT); \
    bf16 *WIN = (bf16*)(ws + WS_WIN), *WOUT = (bf16*)(ws + WS_WOUT), *WUP = (bf16*)(ws + WS_WUP), *WDN = (bf16*)(ws + WS_WDN); \
    bf16 *XA = (bf16*)(ws + WS_XA), *OM = (bf16*)(ws + WS_OM), *HB = (bf16*)(ws + WS_HB); \
    const size_t bq_ = (size_t)(gw >> 8);        \
    bf16 *GQ = (bf16*)(ws + WS_GQ + bq_ * (PBS - 1 * MiB)), *GK = (bf16*)(ws + WS_GK + bq_ * (PBS - 1 * MiB)), *GV = (bf16*)(ws + WS_GV + bq_ * (PBS - 2 * MiB)), *GG = (bf16*)(ws + WS_GG + bq_ * (PBS - 2 * MiB)), \
         *RQ = (bf16*)(ws + WS_RQ + bq_ * (PBS - 2 * MiB)), *RK = (bf16*)(ws + WS_RK + bq_ * (PBS - 2 * MiB)), *RV = (bf16*)(ws + WS_RV + bq_ * (PBS - 2 * MiB)), *RG = (bf16*)(ws + WS_RG + bq_ * (PBS - 2 * MiB)), \
         *SQ = (bf16*)(ws + WS_SQ + bq_ * (PBS - 4 * MiB)), *SK = (bf16*)(ws + WS_SK + bq_ * (PBS - 4 * MiB)), *SV = (bf16*)(ws + WS_SV + bq_ * (PBS - 4 * MiB)); \
    float *GR = (float*)(ws + WS_GR), *GA = (float*)(ws + WS_GA); \
    (void)SS; (void)MOD; (void)CBIN; (void)CBUP; (void)ROT; (void)WIN; (void)WOUT; (void)WUP; (void)WDN; (void)XA; (void)OM; (void)HB; (void)GQ; (void)GK; (void)GV; (void)GG; (void)RQ; (void)RK; (void)RV; (void)RG; (void)SQ; (void)SK; (void)SV; (void)GR; (void)GA;
#define IN_PTR(i) ((const float*)(const GAS float*)kq_[i])
    for (int u = (int)threadIdx.x; u < (LDS_BYTES - LDSCTL_OFF) / 4; u += NWAVES * 64) ((LAS unsigned*)(lds + LDSCTL_OFF))[u] = 0u;
    __syncthreads();
    { PH_BEGIN(); (void)xcd_barrier_post((unsigned*)(ctl + CW_BAR), MISC + 8); }
#if PROBE_ON
#define STAMP() do { if (blockIdx.x == 0 && TID_NOW() == 0) { ((volatile LAS unsigned long long*)(lds + LDSCTL_OFF + 1024))[nstamp_] = __builtin_amdgcn_s_memrealtime(); } ++nstamp_; } while (0)
    int nstamp_ = 0;
#else
#define STAMP() do {} while (0)
#endif
#define GRID_BAR() do { GRID_BAR_(0); STAMP(); } while (0)
#define XCC_BAR() do { GRID_BAR_(lmode); STAMP(); } while (0)
#define GRID_BAR_(loc) do { const kargw_t* kb_ = kargs; asm volatile("" : "+s"(kb_)); XcdBarrier bb_; bb_.bar = (unsigned*)((gu32*)(GAS unsigned char*)kb_[17] + CW_BAR); bb_.x = xb_xcc_id(); bb_.st = MISC + 8; bb_.tid = TID_NOW(); xcd_barrier(bb_, (loc)); } while (0)

    STAMP();
    {
        PH_BEGIN(); const float *cvec = IN_PTR(1), *ada_w = IN_PTR(2), *ada_b = IN_PTR(3), *w_in = IN_PTR(6), *w_out = IN_PTR(11), *ffn_wg = IN_PTR(12), *ffn_wu = IN_PTR(13), *ffn_wd = IN_PTR(14);
        LAS float* tbl = (LAS float*)(lds + RING_OFF); LAS float* red = (LAS float*)(lds + RING_OFF + 32768);
        if (bx < 192) {
            const int l = bx / 96, jblk = bx % 96, jq = tid & 15, kg = tid >> 4, j0 = jblk * 64 + 4 * jq;
            f32x4 w4[32]; float cv[16];
#pragma unroll
            for (int i = 0; i < 32; ++i) w4[i] = *(const f32x4*)(ada_w + ((size_t)l * DM + kg * 32 + i) * MODLD + j0);
#pragma unroll
            for (int q = 0; q < 16; ++q) cv[q] = cvec[tid + q * (NWAVES * 64)];
            asm volatile("" : "+v"(w4[0]), "+v"(w4[1]), "+v"(w4[2]), "+v"(w4[3]), "+v"(w4[4]), "+v"(w4[5]), "+v"(w4[6]), "+v"(w4[7]), "+v"(w4[8]), "+v"(w4[9]), "+v"(w4[10]), "+v"(w4[11]), "+v"(w4[12]), "+v"(w4[13]), "+v"(w4[14]), "+v"(w4[15]) :: "memory");
            asm volatile("" : "+v"(w4[16]), "+v"(w4[17]), "+v"(w4[18]), "+v"(w4[19]), "+v"(w4[20]), "+v"(w4[21]), "+v"(w4[22]), "+v"(w4[23]), "+v"(w4[24]), "+v"(w4[25]), "+v"(w4[26]), "+v"(w4[27]), "+v"(w4[28]), "+v"(w4[29]), "+v"(w4[30]), "+v"(w4[31]) :: "memory");
#pragma unroll
            for (int q = 0; q < 16; ++q) tbl[tid + q * (NWAVES * 64)] = cv[q] / (1.0f + __expf(-cv[q]));
            __syncthreads();
            f32x4 acc[8];
#pragma unroll
            for (int b = 0; b < 8; ++b) acc[b] = (f32x4){0.f, 0.f, 0.f, 0.f};
#pragma unroll
            for (int b = 0; b < 8; ++b)
#pragma unroll
                for (int i = 0; i < 32; ++i) acc[b] += w4[i] * tbl[b * DM + kg * 32 + i];
#pragma unroll
            for (int b = 0; b < 8; ++b) *(LAS f32x4*)(red + (kg * 8 + b) * 64 + 4 * jq) = acc[b];
            __syncthreads();
            { const int b = tid >> 6, j = tid & 63; float sum = ada_b[l * MODLD + jblk * 64 + j];
#pragma unroll 8
              for (int g8 = 0; g8 < 32; ++g8) sum += red[(g8 * 8 + b) * 64 + j];
              MOD[((size_t)l * 8 + b) * MODLD + jblk * 64 + j] = sum; }
        }
        __syncthreads();
        LAS float* scr = (LAS float*)(lds + RING_OFF + wave * 16384);
        constexpr int I_IN = 16 * (NIN / 32), I_OUT = 16 * 32, I_UP = 16 * (NUP / 32), I_DN = (DFF / 64) * 32, I_L = I_IN + I_OUT + I_UP + I_DN;
        auto mk = [&](int it) {
            TrDesc d; const int l = it / I_L; int r = it % I_L;
            if (r < I_IN) { const int nblk = NIN / 32, kb = r / nblk, nb = r % nblk, n0 = nb * 32;
                int src, nv; if (n0 < 768) { src = n0; nv = 32; } else if (n0 < 3328) { src = n0 + 16; nv = 32; } else if (n0 == 3328) { src = 768; nv = 16; } else { src = 0; nv = 0; }
                d.W = w_in + (size_t)l * DM * NIN_SRC; d.ldw = NIN_SRC; d.k0 = kb * 64; d.src = src; d.nv = nv; d.WT = WIN + (size_t)l * NIN * DM; d.K = DM; d.dst = n0; return d; }
            r -= I_IN;
            if (r < I_OUT) { const int kb = r / 32, nb = r % 32; d.W = w_out + (size_t)l * DM * DM; d.ldw = DM; d.k0 = kb * 64; d.src = nb * 32; d.nv = 32; d.WT = WOUT + (size_t)l * DM * DM; d.K = DM; d.dst = nb * 32; return d; }
            r -= I_OUT;
            if (r < I_UP) { const int nblk = NUP / 32, kb = r / nblk, nb = r % nblk, n0 = nb * 32, tile = n0 >> 8, jj = n0 & 255;
                d.W = ((jj < 128) ? ffn_wg : ffn_wu) + (size_t)l * DM * DFF; d.ldw = DFF; d.k0 = kb * 64; d.src = tile * 128 + (jj & 127); d.nv = 32; d.WT = WUP + (size_t)l * NUP * DM; d.K = DM; d.dst = n0; return d; }
            r -= I_UP;
            { const int kb = r / 32, nb = r % 32; d.W = ffn_wd + (size_t)l * DFF * DM; d.ldw = DM; d.k0 = kb * 64; d.src = nb * 32; d.nv = 32; d.WT = WDN + (size_t)l * DM * DFF; d.K = DFF; d.dst = nb * 32; return d; }
        };
        if (gw < 2 * I_L) {
            TrDesc dc = mk(gw); f32x4 vc[8]; tr_load(dc, vc, lane);
            for (int it = gw; it < 2 * I_L; it += NGW) {
                const bool more = it + NGW < 2 * I_L;
                TrDesc dn = dc; f32x4 vn[8];
                if (more) { dn = mk(it + NGW); tr_load(dn, vn, lane); }
                tr_store(dc, vc, scr, lane);
                if (more) { dc = dn;
#pragma unroll
                    for (int i = 0; i < 8; ++i) vc[i] = vn[i]; }
            }
        }
        for (int e = gw * 64 + lane; e < SEQ * 32; e += NGW * 64) { const int pos = e >> 5, i = e & 31;
            const float inv = powf(10000.0f, -(float)(2 * i) / 64.0f); const float ang = (float)pos * inv; float s, c; sincos_acc(ang, s, c);
            ROT[2 * e] = c; ROT[2 * e + 1] = s; }
    }
    GRID_BAR();
    { const unsigned m_ = MISC[11], r_ = MISC[10]; lmode = __builtin_amdgcn_readfirstlane((int)(m_ == 1u)); if (lmode) bxe = __builtin_amdgcn_readfirstlane((int)(r_ * 8u + xb_xcc_id())); }
    {
        PH_BEGIN(); const float *x = IN_PTR(0), *norm1_g = IN_PTR(4);
        {
            LAS float* shl = (LAS float*)(lds + RING_OFF);
#pragma unroll 4
            for (int q = 0; q < 16; ++q) { const int idx = tid + q * (NWAVES * 64); const int grp = idx >> 11, b = (idx >> 8) & 7, c4 = idx & 255;
                *(LAS f32x4*)(shl + (size_t)idx * 4) = *(const f32x4*)(MOD + ((size_t)(grp >> 1) * 8 + b) * MODLD + ((grp & 1) ? 3 : 0) * DM + c4 * 4); }
            unsigned long long wraw[9][4];
#pragma unroll
            for (int k = 0; k < 9; ++k) { const int r = gw + k * 2048;
                const int l = r >= (NIN + NUP) ? 1 : 0, rr = r - l * (NIN + NUP); const int kind = rr >= NIN ? 1 : 0, n = rr - kind * NIN;
                const bf16* W = kind ? (WUP + ((size_t)l * NUP + n) * DM) : (WIN + ((size_t)l * NIN + n) * DM);
#pragma unroll
                for (int j = 0; j < 4; ++j) wraw[k][j] = *(const unsigned long long*)(W + j * 256 + lane * 4); }
            asm volatile("" ::: "memory");
            __syncthreads();
            const int hi = lane >> 5, b4 = (lane >> 4) & 1, b3 = (lane >> 3) & 1;
#pragma unroll 1
            for (int k = 0; k < 9; ++k) { const int r = gw + k * 2048;
                const int l = r >= (NIN + NUP) ? 1 : 0, rr = r - l * (NIN + NUP); const int kind = rr >= NIN ? 1 : 0, n = rr - kind * NIN; const int grp = l * 2 + kind;
                float wv[16];
#pragma unroll
                for (int j = 0; j < 4; ++j) { unsigned long long w8 = 0;
#pragma unroll
                    for (int kk = 0; kk < 9; ++kk) w8 = (kk == k) ? wraw[kk][j] : w8;
                    const unsigned lo = (unsigned)w8, hi2 = (unsigned)(w8 >> 32);
                    wv[4 * j + 0] = __uint_as_float(lo << 16); wv[4 * j + 1] = __uint_as_float(lo & 0xffff0000u); wv[4 * j + 2] = __uint_as_float(hi2 << 16); wv[4 * j + 3] = __uint_as_float(hi2 & 0xffff0000u); }
                float sm[8];
#pragma unroll
                for (int b = 0; b < 8; ++b) { float a = 0.f;
#pragma unroll
                    for (int j = 0; j < 4; ++j) { const f32x4 s4 = *(const LAS f32x4*)(shl + ((size_t)(grp * 8 + b)) * 1024 + j * 256 + lane * 4);
                        a = fmaf(s4[0], wv[4 * j + 0], a); a = fmaf(s4[1], wv[4 * j + 1], a); a = fmaf(s4[2], wv[4 * j + 2], a); a = fmaf(s4[3], wv[4 * j + 3], a); }
                    sm[b] = a; }
                float u4[4], u2[2], u1;
#pragma unroll
                for (int i = 0; i < 4; ++i) { const float mine = hi ? sm[i + 4] : sm[i], send = hi ? sm[i] : sm[i + 4]; u4[i] = mine + get_x32(send, hi); }
#pragma unroll
                for (int i = 0; i < 2; ++i) { const float mine = b4 ? u4[i + 2] : u4[i], send = b4 ? u4[i] : u4[i + 2]; u2[i] = mine + shx<16>(send); }
                { const float mine = b3 ? u2[1] : u2[0], send = b3 ? u2[0] : u2[1]; u1 = mine + shx<8>(send); }
                u1 += shx<4>(u1); u1 += shx<2>(u1); u1 += shx<1>(u1);
                const int bb = hi * 4 + b4 * 2 + b3;
                float* CB = kind ? (CBUP + (size_t)l * 8 * NUP) : (CBIN + (size_t)l * 8 * NIN); const int NR = kind ? NUP : NIN;
                if ((lane & 7) == 0) CB[(size_t)bb * NR + n] = u1;
            }
            __syncthreads();
        }
        {
            f32x4 vcur[4], an[4];
            const int mb = (gw >> 8) * SEQ + (gw & 255);
            { const float* sp = MOD + (size_t)(gw >> 8) * MODLD + DM + lane * 4;
#pragma unroll
              for (int j = 0; j < 4; ++j) an[j] = *(const f32x4*)(norm1_g + j * 256 + lane * 4) * (*(const f32x4*)(sp + j * 256) + 1.0f); }
            { const GAS f32x4* xr = (const GAS f32x4*)(x + (size_t)mb * DM) + lane;
#pragma unroll
              for (int j = 0; j < 4; ++j) vcur[j] = xr[64 * j]; }
            asm volatile("" : "+v"(vcur[0]), "+v"(vcur[1]), "+v"(vcur[2]), "+v"(vcur[3]), "+v"(an[0]), "+v"(an[1]), "+v"(an[2]), "+v"(an[3]));
            for (int k = 0; k < SEQ / 256; ++k) { const int m = mb + 256 * k;
                f32x4 vnx[4]; const bool more = k + 1 < SEQ / 256;
                if (more) { const GAS f32x4* xn = (const GAS f32x4*)(x + (size_t)(m + 256) * DM) + lane;
#pragma unroll
                    for (int j = 0; j < 4; ++j) vnx[j] = xn[64 * j]; }
                asm volatile("" ::: "memory");
                float s = 0.f;
                GAS unsigned long long* o8 = (GAS unsigned long long*)(XA + (size_t)m * DM) + lane;
                GAS unsigned long long* r8 = (GAS unsigned long long*)((bf16*)out + (size_t)m * DM) + lane;
#pragma unroll
                for (int j = 0; j < 4; ++j) { const f32x4 v = vcur[j]; s += (v.x * v.x + v.y * v.y) + (v.z * v.z + v.w * v.w);
                    const f32x4 y = v * an[j]; o8[64 * j] = (unsigned long long)pk2(y.x, y.y) | ((unsigned long long)pk2(y.z, y.w) << 32);
                    r8[64 * j] = (unsigned long long)pk2(v.x, v.y) | ((unsigned long long)pk2(v.z, v.w) << 32); }
                s = wave_sum(s); if (lane == 0) SS[m] = ss_fix(s);
                if (more) {
#pragma unroll
                    for (int j = 0; j < 4; ++j) vcur[j] = vnx[j]; }
            }
        }
    }
    GRID_BAR();

    for (int l = 0; l < DEPTH; ++l) {
        {
            PH_BEGIN();
            LAS float* cbl = (LAS float*)(lds + CBL_OFF); LAS float* rsl = (LAS float*)(lds + RSL_OFF);
            const int pm0_ = 16 * (bxe & 7) + ((bxe >> 3) & 7);
            const float* cbg = CBIN + ((size_t)l * 8 + (bxe & 7)) * NIN;
            for (int i = tid; i < NIN / 4; i += NWAVES * 64) *(LAS f32x4*)(cbl + 4 * i) = *(const f32x4*)(cbg + 4 * i);
            const int pm_ = pm0_ + 8 * __builtin_amdgcn_readfirstlane(tid >> 8); rsl[tid] = row_rstd(SS + (size_t)(2 * l) * M, (size_t)pm_ * 256 + (tid & 255));
            __syncthreads();
        }
        {
            PH_BEGIN();
            pg8::Gemm g{XA, WIN + (size_t)l * NIN * DM, M, NIN, DM}; pg8::StaticOrder S; S.init(M, NIN, G, bxe);
            pg8::EpiInProj E{(LAS float*)(lds + CBL_OFF), (LAS float*)(lds + RSL_OFF), 16 * (bxe & 7) + ((bxe >> 3) & 7), ROT, ws};
            pg8::gemm_phase<pg8::EpiInProj, pg8::StaticOrder, true, true>(lds + RING_OFF, g, S, E, tid);
        }
        XCC_BAR();
#if !(MIX_GLA_V1)
        {
            PH_BEGIN(); const float *gla_wa2 = IN_PTR(7), *gla_ba = IN_PTR(8);
            float w0[16], w1[16];
#pragma unroll
            for (int r = 0; r < 16; ++r) { w0[r] = gla_wa2[((size_t)l * 16 + r) * 128 + lane]; w1[r] = gla_wa2[((size_t)l * 16 + r) * 128 + 64 + lane]; }
            const float b0 = gla_ba[l * 128 + lane], b1 = gla_ba[l * 128 + 64 + lane];
            for (int m = gw; m < M; m += NGW) {
                const float grv = GR[(size_t)m * 16 + (lane & 15)];
                float u0 = b0, u1 = b1;
#pragma unroll
                for (int r = 0; r < 16; ++r) { const float gr = rdl(grv, r); u0 = fmaf(gr, w0[r], u0); u1 = fmaf(gr, w1[r], u1); }
                const float l0 = fminf(u0, 0.f) - __logf(1.0f + __expf(-fabsf(u0))), l1 = fminf(u1, 0.f) - __logf(1.0f + __expf(-fabsf(u1)));
                GA[(size_t)m * 128 + lane] = __expf(l0 * (1.0f / 16.0f)); GA[(size_t)m * 128 + 64 + lane] = __expf(l1 * (1.0f / 16.0f));
            }
        }
        GRID_BAR();
#endif
#if MIX_GLA_V1 || MIX_RET_V1 || MIX_SB_V1
        {
            const int ord = wave_k >> 2;
#pragma unroll 1
            for (int step = 0; step < 3; ++step) {
                const int which = ord ? (step == 0 ? 2 : step - 1) : step;
                if (which == 0) { PH_BEGIN(); const float *gla_wa2 = IN_PTR(7), *gla_ba = IN_PTR(8); LAS unsigned char* wlds = lds + RING_OFF + wave * 16384;
                    for (int ch = gw; ch < 2048; ch += NGW) chunk_sum_unit<32, true>(ch, GQ, GK, GV, GR, gla_wa2 + (size_t)l * 16 * 128, gla_ba + l * 128, (float*)(ws + WS_KVTG), (float*)(ws + WS_DEC), wlds, lane_now()); }
                else if (which == 1) { PH_BEGIN(); LAS unsigned char* wlds = lds + RING_OFF + wave * 16384;
                    for (int ch = gw; ch < 2048; ch += NGW) chunk_sum_unit<64, false>(ch, RQ, RK, RV, nullptr, nullptr, nullptr, (float*)(ws + WS_KVTR), nullptr, wlds, lane_now()); }
                else { PH_BEGIN(); LAS unsigned char* wlds = lds + RING_OFF + wave * 16384;
                    { const int g_ = gw >> 8, u_ = gw & 255; sb_unit_v1(((g_ * 8 + (u_ >> 6)) << 6) | (u_ & 63), SQ, SK, SV, OM, wlds, lane_now()); } }
            }
        }
        XCC_BAR();
        {
            const int ord = wave_k >> 2;
#pragma unroll 1
            for (int step = 0; step < 2; ++step) {
                if ((ord ? 1 - step : step) == 0) { PH_BEGIN();
                    const int g_ = gw >> 8, u_ = gw & 255;
                    if (u_ < 64) scan_unit<32, true>(g_ * 4 + (u_ >> 4), u_ & 15, (const float*)(ws + WS_KVTG), (const float*)(ws + WS_DEC), (bf16*)(ws + WS_STG), lane);
                    else if (u_ < 192) scan_unit<64, false>(g_ * 4 + ((u_ - 64) >> 5), (u_ - 64) & 31, (const float*)(ws + WS_KVTR), nullptr, (bf16*)(ws + WS_STR), lane);
                } else { PH_BEGIN(); LAS unsigned char* wlds = lds + RING_OFF + wave * 16384;
                    { const int g_ = gw >> 8, u_ = gw & 255; sb_unit_v1(((g_ * 8 + 4 + (u_ >> 6)) << 6) | (u_ & 63), SQ, SK, SV, OM, wlds, lane_now()); } }
            }
        }
        XCC_BAR();
#endif
        {
            PH_BEGIN(); const float *gla_norm_g = IN_PTR(9), *ret_norm_g = IN_PTR(10);
            LAS unsigned char* wlds = lds + RING_OFF + wave * 16384; (void)wlds;
#if MIX_GLA_V1
            for (int ch = gw; ch < 2048; ch += NGW) chunk_out_unit<32>(ch, GQ, GK, GV, GG, (const bf16*)(ws + WS_STG), gla_norm_g + l * 64, OM, 0, wlds, (LAS float*)(lds + LDSCTL_OFF + 4096 + wave * 256), lane_now());
#else
            if (wave == 0 && vcu < 32) seq_recurrent_v0<32, true>(GQ, GK, GV, GG, GA, gla_norm_g + l * 64, OM, vcu >> 2, vcu & 3, lane, 0);
#endif
#if MIX_RET_V1
            for (int ch = gw; ch < 2048; ch += NGW) chunk_out_unit<64>(ch, RQ, RK, RV, RG, (const bf16*)(ws + WS_STR), ret_norm_g + l * 64, OM, 256, wlds, (LAS float*)(lds + LDSCTL_OFF + 4096 + wave * 256), lane_now());
#else
            if (wave == 0 && vcu >= 32 && vcu < 64) seq_recurrent_v0<64, false>(RQ, RK, RV, RG, nullptr, ret_norm_g + l * 64, OM, (vcu - 32) >> 2, (vcu - 32) & 3, lane, 256);
#endif
#if !(MIX_SB_V1)
            for (int unit = gw; unit < 4096; unit += NGW) sb_unit_v0(SQ, SK, SV, OM, unit, lane);
#endif
        }
        XCC_BAR();
#if PROBE_ON && PROBE_DUP3C
        {
            PH_BEGIN(); const float *gla_norm_g = IN_PTR(9), *ret_norm_g = IN_PTR(10);
            LAS unsigned char* wlds = lds + RING_OFF + wave * 16384; (void)wlds;
#if MIX_GLA_V1
            for (int ch = gw; ch < 2048; ch += NGW) chunk_out_unit<32>(ch, GQ, GK, GV, GG, (const bf16*)(ws + WS_STG), gla_norm_g + l * 64, OM, 0, wlds, (LAS float*)(lds + LDSCTL_OFF + 4096 + wave * 256), lane_now());
#else
            if (wave == 0 && vcu < 32) seq_recurrent_v0<32, true>(GQ, GK, GV, GG, GA, gla_norm_g + l * 64, OM, vcu >> 2, vcu & 3, lane, 0);
#endif
#if MIX_RET_V1
            for (int ch = gw; ch < 2048; ch += NGW) chunk_out_unit<64>(ch, RQ, RK, RV, RG, (const bf16*)(ws + WS_STR), ret_norm_g + l * 64, OM, 256, wlds, (LAS float*)(lds + LDSCTL_OFF + 4096 + wave * 256), lane_now());
#else
            if (wave == 0 && vcu >= 32 && vcu < 64) seq_recurrent_v0<64, false>(RQ, RK, RV, RG, nullptr, ret_norm_g + l * 64, OM, (vcu - 32) >> 2, (vcu - 32) & 3, lane, 256);
#endif
#if !(MIX_SB_V1)
            for (int unit = gw; unit < 4096; unit += NGW) sb_unit_v0(SQ, SK, SV, OM, unit, lane);
#endif
        }
        GRID_BAR();
#endif
        {
            PH_BEGIN(); const float *norm2_g = IN_PTR(5); const float* MODB = MOD + ((size_t)l * 8 + (bxe & 7)) * MODLD;
            { LAS float* gl_ = (LAS float*)(lds + CBL_OFF); LAS float* al_ = gl_ + DM;
              for (int i = tid; i < DM / 4; i += NWAVES * 64) { *(LAS f32x4*)(gl_ + 4 * i) = *(const f32x4*)(MODB + 2 * DM + 4 * i);
                  *(LAS f32x4*)(al_ + 4 * i) = *(const f32x4*)(norm2_g + l * DM + 4 * i) * (*(const f32x4*)(MODB + 4 * DM + 4 * i) + 1.0f); }
              __syncthreads(); }
            pg8::Gemm g{OM, WOUT + (size_t)l * DM * DM, M, DM, DM}; pg8::StaticOrder S; S.init(M, DM, G, bxe);
            bf16* XR = (bf16*)out;
            pg8::EpiResid E{XR, XR, (LAS float*)(lds + CBL_OFF), (LAS float*)(lds + CBL_OFF) + DM, XA, SS + (size_t)(2 * l + 1) * M, 1};
            pg8::gemm_phase<pg8::EpiResid, pg8::StaticOrder, true, true>(lds + RING_OFF, g, S, E, tid);
        }
        XCC_BAR();
#if PROBE_ON && PROBE_NULLEPI
        if (l == 0) {
            PH_BEGIN();
            pg8::Gemm g{XA, WUP + (size_t)l * NUP * DM, M, NUP, DM}; pg8::StaticOrder S; S.init(M, NUP, G, bxe);
            pg8::EpiNull E{(float*)(ws + WS_OM)};
            pg8::gemm_phase<pg8::EpiNull, pg8::StaticOrder, true, true>(lds + RING_OFF, g, S, E, tid);
            GRID_BAR();
        }
#endif
        {
            PH_BEGIN();
            LAS float* cbl = (LAS float*)(lds + CBL_OFF); LAS float* rsl = (LAS float*)(lds + RSL_OFF);
            const int pm0_ = 16 * (bxe & 7) + ((bxe >> 3) & 7);
            const float* cbg = CBUP + ((size_t)l * 8 + (bxe & 7)) * NUP;
            for (int i = tid; i < NUP / 4; i += NWAVES * 64) *(LAS f32x4*)(cbl + 4 * i) = *(const f32x4*)(cbg + 4 * i);
            const int pm_ = pm0_ + 8 * __builtin_amdgcn_readfirstlane(tid >> 8); rsl[tid] = row_rstd(SS + (size_t)(2 * l + 1) * M, (size_t)pm_ * 256 + (tid & 255));
            __syncthreads();
        }
        {
            PH_BEGIN();
            pg8::Gemm g{XA, WUP + (size_t)l * NUP * DM, M, NUP, DM}; pg8::StaticOrder S; S.init(M, NUP, G, bxe);
            pg8::EpiFfnUp E{(LAS float*)(lds + CBL_OFF), (LAS float*)(lds + RSL_OFF), 16 * (bxe & 7) + ((bxe >> 3) & 7), HB};
            pg8::gemm_phase<pg8::EpiFfnUp, pg8::StaticOrder, true, true>(lds + RING_OFF, g, S, E, tid);
        }
        XCC_BAR();
        {
            PH_BEGIN(); const float *norm1_g = IN_PTR(4); const float* MODB = MOD + ((size_t)l * 8 + (bxe & 7)) * MODLD;
            const int nl = (l + 1 < DEPTH) ? l + 1 : l;
            { LAS float* gl_ = (LAS float*)(lds + CBL_OFF); LAS float* al_ = gl_ + DM; const float* MODN = MOD + ((size_t)nl * 8 + (bxe & 7)) * MODLD;
              for (int i = tid; i < DM / 4; i += NWAVES * 64) { *(LAS f32x4*)(gl_ + 4 * i) = *(const f32x4*)(MODB + 5 * DM + 4 * i);
                  *(LAS f32x4*)(al_ + 4 * i) = *(const f32x4*)(norm1_g + nl * DM + 4 * i) * (*(const f32x4*)(MODN + 1 * DM + 4 * i) + 1.0f); }
              __syncthreads(); }
            pg8::Gemm g{HB, WDN + (size_t)l * DM * DFF, M, DM, DFF, PBS - (size_t)SEQ * DFF * 2}; pg8::StaticOrder S; S.init(M, DM, G, bxe);
            bf16* XR = (bf16*)out;
            pg8::EpiResid E{XR, (l + 1 < DEPTH) ? XR : XA, (LAS float*)(lds + CBL_OFF), (LAS float*)(lds + CBL_OFF) + DM, XA, SS + (size_t)(2 * l + 2) * M, (l + 1 < DEPTH) ? 1 : 0};
            pg8::gemm_phase<pg8::EpiResid, pg8::StaticOrder, true, true>(lds + RING_OFF, g, S, E, tid);
        }
        if (l + 1 < DEPTH) XCC_BAR(); else GRID_BAR();
    }
    {
        PH_BEGIN(); const float* final_g = IN_PTR(15);
        const unsigned long long* ssf = SS + (size_t)(2 * DEPTH) * M;
        f32x4 fg[4];
#pragma unroll
        for (int j = 0; j < 4; ++j) fg[j] = *(const f32x4*)(final_g + j * 256 + lane * 4);
        unsigned long long wcur[4], qcur;
        const int mb = (gw >> 8) * SEQ + (gw & 255);
        { const GAS unsigned long long* xr = (const GAS unsigned long long*)(XA + (size_t)mb * DM) + lane; qcur = ssf[mb];
#pragma unroll
          for (int j = 0; j < 4; ++j) wcur[j] = xr[64 * j]; }
        asm volatile("" : "+v"(wcur[0]), "+v"(wcur[1]), "+v"(wcur[2]), "+v"(wcur[3]), "+v"(qcur), "+v"(fg[0]), "+v"(fg[1]), "+v"(fg[2]), "+v"(fg[3]));
        for (int k = 0; k < SEQ / 256; ++k) { const int m = mb + 256 * k;
            unsigned long long wnx[4], qnx = 0; const bool more = k + 1 < SEQ / 256;
            if (more) { const GAS unsigned long long* xn = (const GAS unsigned long long*)(XA + (size_t)(m + 256) * DM) + lane; qnx = ssf[m + 256];
#pragma unroll
                for (int j = 0; j < 4; ++j) wnx[j] = xn[64 * j]; }
            asm volatile("" ::: "memory");
            const float r = rstd_of(qcur);
            GAS f32x4* orow = (GAS f32x4*)(out + (size_t)m * DM) + lane;
#pragma unroll
            for (int j = 0; j < 4; ++j) { const unsigned long long w = wcur[j]; const unsigned lo = (unsigned)w, hi2 = (unsigned)(w >> 32);
                const f32x4 v = {__uint_as_float(lo << 16), __uint_as_float(lo & 0xffff0000u), __uint_as_float(hi2 << 16), __uint_as_float(hi2 & 0xffff0000u)};
                orow[64 * j] = v * r * fg[j]; }
            if (more) { qcur = qnx;
#pragma unroll
                for (int j = 0; j < 4; ++j) wcur[j] = wnx[j]; }
        }
    }

#if PROBE_ON
    STAMP();
    if (blockIdx.x == 0 && TID_NOW() == 0) {
        volatile LAS unsigned long long* st_ = (volatile LAS unsigned long long*)(lds + LDSCTL_OFF + 1024);
        const unsigned long long d1 = st_[PROBE_I1B] - st_[PROBE_I1A], d2 = st_[PROBE_I2B] - st_[PROBE_I2A];
        unsigned long long q1 = (d1 + 400) / 800, q2 = (d2 + 400) / 800; if (q1 > 63) q1 = 63; if (q2 > 63) q2 = 63;
        const unsigned long long spin = (q1 + 64 * q2) * 1200ull, t0_ = __builtin_amdgcn_s_memrealtime();
        while (__builtin_amdgcn_s_memrealtime() - t0_ < spin) __builtin_amdgcn_s_sleep(8);
    }
#endif
}

extern "C" void kernel_launch(void* const* d_in, const int* in_sizes, int n_in, void* d_out, int out_size, void* d_ws, size_t ws_size, hipStream_t stream) {
    static int grid = 0;
    if (grid == 0) {
        if (n_in != 16 || in_sizes[0] != M * DM || out_size != M * DM || ws_size < WS_END) { fprintf(stderr, "kernel_launch: unexpected shapes (n_in %d, in0 %d, out %d, ws %zu); nothing launched\n", n_in, n_in > 0 ? in_sizes[0] : -1, out_size, ws_size); grid = -1; return; }
        int dev = 0, cus = 0, per_cu = 0;
        if (hipGetDevice(&dev) != hipSuccess || hipDeviceGetAttribute(&cus, hipDeviceAttributeMultiprocessorCount, dev) != hipSuccess) { grid = -1; return; }
        if (hipFuncSetAttribute((const void*)mk_fwd, hipFuncAttributeMaxDynamicSharedMemorySize, LDS_BYTES) != hipSuccess) { fprintf(stderr, "kernel_launch: hipFuncSetAttribute failed\n"); grid = -1; return; }
        if (hipOccupancyMaxActiveBlocksPerMultiprocessor(&per_cu, (const void*)mk_fwd, NWAVES * 64, LDS_BYTES) != hipSuccess || per_cu < 1) fprintf(stderr, "kernel_launch: note: occupancy query reports %d\n", per_cu);
        (void)hipGetLastError();
        if (cus != 256) { fprintf(stderr, "kernel_launch: built for a 256-CU device, found %d CUs; nothing launched\n", cus); grid = -1; return; }
        grid = cus;
    }
    if (grid < 0) return;
    if (hipMemsetAsync((char*)d_ws + WS_CTL, 0, CTL_ZERO_BYTES, stream) != hipSuccess) { fprintf(stderr, "kernel_launch: memset failed\n"); return; }
    Args a{};
    for (int i = 0; i < 16; ++i) a.in[i] = (const float*)d_in[i];
    a.out = (float*)d_out; a.ws = (unsigned char*)d_ws; a.ph_lo = 0; a.ph_hi = 99;
    hipLaunchKernelGGL(mk_fwd, dim3(grid), dim3(NWAVES * 64), LDS_BYTES, stream, a);
}
```

```cpp
#include <hip/hip_runtime.h>
#include <cstdio>
#include <cstdint>
#define MIX_GLA_V1 1
#define MIX_RET_V1 1
#define MIX_SB_V1 1
#define PROBE_ON 0
constexpr int NWAVES = 8;
constexpr int BATCH = 8, SEQ = 4096, DM = 1024, M = BATCH * SEQ, DEPTH = 2;
constexpr int NIN = 3584, NIN_SRC = 3344, DFF = 2816, NUP = 5632, MODLD = 6144;
constexpr float SB_THR = -110.0f, SB_PMIN = 1.1754944e-38f;

constexpr size_t MiB = 1u << 20;
constexpr size_t WS_CTL = 0;
constexpr size_t WS_SS = 1 * MiB;
constexpr size_t WS_MOD = 2 * MiB + 512 * 1024;
constexpr size_t CTL_ZERO_BYTES = 2 * MiB + 512 * 1024;
constexpr size_t WS_CBIN = 3 * MiB;
constexpr size_t WS_CBUP = 3 * MiB + 512 * 1024;
constexpr size_t WS_ROT = 4 * MiB;
constexpr size_t WS_WIN = 8 * MiB;
constexpr size_t WS_WOUT = 22 * MiB;
constexpr size_t WS_WUP = 26 * MiB;
constexpr size_t WS_WDN = 48 * MiB;
constexpr size_t WS_XA = 64 * MiB;
constexpr size_t WS_OM = 128 * MiB;
constexpr size_t PBS = 26 * MiB;
constexpr size_t WS_GQ = 192 * MiB, WS_GK = 193 * MiB, WS_GV = 194 * MiB, WS_GG = 196 * MiB;
constexpr size_t WS_RQ = 198 * MiB, WS_RK = 200 * MiB, WS_RV = 202 * MiB, WS_RG = 204 * MiB;
constexpr size_t WS_SQ = 206 * MiB, WS_SK = 210 * MiB, WS_SV = 214 * MiB;
constexpr size_t WS_GR = 400 * MiB;
constexpr size_t WS_GA = 402 * MiB;
constexpr size_t WS_HB = 192 * MiB;
constexpr size_t WS_KVTG = 418 * MiB, WS_KVTR = 434 * MiB, WS_STG = 466 * MiB, WS_STR = 474 * MiB, WS_DEC = 490 * MiB;
constexpr size_t WS_END = 501 * MiB;
constexpr int CW_BAR = 4096;

constexpr int RING_OFF = 0, RING_BYTES = 131072;
constexpr int LDSCTL_OFF = RING_BYTES, MISC_OFF = LDSCTL_OFF + 320;
constexpr int LDS_BYTES = 163840;
constexpr int CBL_OFF = LDSCTL_OFF + 6144, RSL_OFF = CBL_OFF + 22528;

#if MIX_SB_V1
constexpr float SB_QSCALE = 0.125f * 1.4426950408889634f;
#else
constexpr float SB_QSCALE = 0.125f;
#endif
template <int OFF> __device__ __forceinline__ float shx(float v) {
    static_assert(OFF >= 1 && OFF < 32, "shx: OFF");
    return __builtin_bit_cast(float, __builtin_amdgcn_ds_swizzle(__builtin_bit_cast(int, v), (OFF << 10) | 0x1f));
}
__device__ __forceinline__ void swap32(float& a, float& b) { asm volatile("s_nop 1\n\tv_permlane32_swap_b32 %0, %1\n\ts_nop 1" : "+v"(a), "+v"(b)); }
__device__ __forceinline__ float add_x32(float v) {
    float a = v, b = v; swap32(a, b); return a + b;
}
__device__ __forceinline__ float get_x32(float v, int hi) {
    float a = v, b = v; swap32(a, b); return hi ? a : b;
}
__device__ __forceinline__ float sum32(float v) { v += shx<1>(v); v += shx<2>(v); v += shx<4>(v); v += shx<8>(v); v += shx<16>(v); return v; }
__device__ __forceinline__ unsigned long long ss_fix(float sq) { return (unsigned long long)(unsigned)(sq * 4096.0f) << 20; }
__device__ __forceinline__ float rstd_of(unsigned long long q) { const float s = (float)(unsigned)(q >> 20) * (1.0f / 4096.0f); return __builtin_amdgcn_rsqf(s * (1.0f / 1024.0f) + 1e-6f); }
__device__ __forceinline__ float row_rstd(const unsigned long long* ssq, size_t row) { const float s = (float)(unsigned)(ssq[row] >> 20) * (1.0f / 4096.0f); return __builtin_amdgcn_rsqf(s * (1.0f / 1024.0f) + 1e-6f); }
namespace pg8 {
#define PG8_LAS __attribute__((address_space(3)))
typedef unsigned short bf16_t;
typedef short bf16x8 __attribute__((ext_vector_type(8)));
typedef float f32x4 __attribute__((ext_vector_type(4)));
typedef unsigned u32x4 __attribute__((ext_vector_type(4)));
constexpr int BM = 256, BK = 64, HALF = 128, HTB = HALF * BK * 2  , STAGE_BYTES = 8 * HTB, NXCD = 8, WGM = 8;

__host__ __device__ __forceinline__ int lds_byte(int r, int c) { const int st = (r >> 4) * 2 + (c >> 5), rr = r & 15, cc = c & 31, ob = rr * 64 + cc * 2; return st * 1024 + (ob ^ (((ob >> 9) & 1) << 5)); }
__host__ __device__ __forceinline__ void stage_rc(int b, int& R, int& C) { const int st = b / 1024, sb = b % 1024, swz = sb ^ (((sb >> 9) & 1) << 5); R = (st >> 1) * 16 + swz / 64; C = (st & 1) * 32 + (swz % 64) / 2; }
__host__ __device__ __forceinline__ int perm32(int rho) { const int n = rho >> 4, i = rho & 15; return 8 * (i >> 2) + 4 * n + (i & 3); }

struct Unit { int pm, pn; };
struct Gemm { const bf16_t* A; const bf16_t* Bt; int M, N, K; size_t abx = 0; };

struct StaticOrder {
    int nM, nN, nwg, G, c;
    __host__ __device__ void init(int M, int N, int G_, int c_) { nM = M / BM; nN = N / BM; nwg = nM * nN; G = G_; c = c_; }
    __host__ __device__ bool next(int i, Unit& u) const {
        const long L = (long)i * G + c; if (L >= nwg) return false;
        int wgid = (int)L; { const int q = nwg / NXCD, r = nwg % NXCD, xcd = wgid % NXCD, off = wgid / NXCD; wgid = (xcd < r ? xcd * (q + 1) : r * (q + 1) + (xcd - r) * q) + off; }
        const int nig = WGM * nN, gid = wgid / nig, fm = gid * WGM, gsz = (nM - fm) < WGM ? (nM - fm) : WGM;
        u.pm = fm + ((wgid % nig) % gsz); u.pn = (wgid % nig) / gsz; return true;
    }
    __device__ __forceinline__ void a_ready(const Unit&) const {}
    __device__ __forceinline__ void done(const Unit&) const {}
};

typedef float cvt_f32x2_t __attribute__((ext_vector_type(2))); typedef __bf16 cvt_bf16x2_t __attribute__((ext_vector_type(2)));
__device__ __forceinline__ unsigned cvt_pk_bf16(float lo, float hi) { const cvt_f32x2_t v = {lo, hi}; const cvt_bf16x2_t b = __builtin_convertvector(v, cvt_bf16x2_t); return __builtin_bit_cast(unsigned, b); }
constexpr int NIN = ::NIN, NUP = ::NUP, DFFC = ::DFF, DMC = ::DM, MODLD = ::MODLD;
__device__ __forceinline__ float silu_f(float a) { return a * __builtin_amdgcn_rcpf(1.0f + __expf(-a)); }
__device__ __forceinline__ u32x4 pack8(const f32x4 v0, const f32x4 v1) { u32x4 w; w.x = cvt_pk_bf16(v0[0], v0[1]); w.y = cvt_pk_bf16(v0[2], v0[3]); w.z = cvt_pk_bf16(v1[0], v1[1]); w.w = cvt_pk_bf16(v1[2], v1[3]); return w; }

__device__ __forceinline__ void load_rstd8(const unsigned long long* sp, float (&rs)[2][4]) {
    unsigned long long raw[8];
    asm volatile("global_load_dwordx2 %0, %1, off" : "=v"(raw[0]) : "v"(sp));
    asm volatile("global_load_dwordx2 %0, %1, off offset:128" : "=v"(raw[1]) : "v"(sp));
    asm volatile("global_load_dwordx2 %0, %1, off offset:256" : "=v"(raw[2]) : "v"(sp));
    asm volatile("global_load_dwordx2 %0, %1, off offset:384" : "=v"(raw[3]) : "v"(sp));
    asm volatile("global_load_dwordx2 %0, %1, off offset:1024" : "=v"(raw[4]) : "v"(sp));
    asm volatile("global_load_dwordx2 %0, %1, off offset:1152" : "=v"(raw[5]) : "v"(sp));
    asm volatile("global_load_dwordx2 %0, %1, off offset:1280" : "=v"(raw[6]) : "v"(sp));
    asm volatile("global_load_dwordx2 %0, %1, off offset:1408" : "=v"(raw[7]) : "v"(sp));
    asm volatile("s_waitcnt vmcnt(0)" : "+v"(raw[0]), "+v"(raw[1]), "+v"(raw[2]), "+v"(raw[3]), "+v"(raw[4]), "+v"(raw[5]), "+v"(raw[6]), "+v"(raw[7]) :: "memory");
#pragma unroll
    for (int i = 0; i < 8; ++i) rs[i >> 2][i & 3] = rstd_of(raw[i]);
}

struct EpiInProj {
    static constexpr bool PERM = true, AFTER_DRAIN = false;
    const PG8_LAS float* cbl; const PG8_LAS float* rsl; int pm0; const float* rot; unsigned char* ws;
    template <bool ROT>
    __device__ __forceinline__ void tile(const f32x4 (&acc)[2][2][4][2], const float (&rs)[2][4], const f32x4 (&c0)[2], const f32x4 (&c1)[2], int pn, int row0, int cl, int bq) const {
        int clq = cl; asm volatile("" : "+v"(clq));
        const int i0 = (clq & 63) >> 1;
#pragma unroll
        for (int ai = 0; ai < 2; ++ai) {
            f32x4 t0[4], t1[4];
            if constexpr (ROT) {
#pragma unroll
                for (int m = 0; m < 4; ++m) { const int pos = (row0 + ai * HALF + m * 16) & 4095; t0[m] = *(const f32x4*)(rot + ((size_t)pos * 32 + i0) * 2); t1[m] = *(const f32x4*)(rot + ((size_t)pos * 32 + i0 + 2) * 2); }
                asm volatile("" ::: "memory");
            }
#pragma unroll
            for (int bj = 0; bj < 2; ++bj) {
                unsigned long long off; int ldl, colb = bj * HALF; float sc = 1.0f;
                if (ROT) { ldl = 8; if (pn == 3) { off = WS_RQ; } else { off = WS_RK; sc = 0.125f; } }
                else if (pn == 0) { ldl = 7; colb = 0; if (bj == 0) { off = WS_GQ; sc = 0.17677669529663687f; } else { off = WS_GK; } }
                else if (pn == 1) { off = WS_GV; ldl = 8; }
                else if (pn == 2) { off = WS_GG; ldl = 8; }
                else if (pn == 5) { off = WS_RV; ldl = 8; }
                else if (pn == 6) { off = WS_RG; ldl = 8; }
                else if (pn <= 8) { off = WS_SQ; ldl = 9; colb += (pn - 7) * BM; sc = SB_QSCALE; }
                else if (pn <= 10) { off = WS_SK; ldl = 9; colb += (pn - 9) * BM; }
                else { off = WS_SV; ldl = 9; colb += (pn - 11) * BM; }
                off = ((unsigned long long)__builtin_amdgcn_readfirstlane((unsigned)(off >> 20))) << 20; ldl = __builtin_amdgcn_readfirstlane(ldl); colb = __builtin_amdgcn_readfirstlane(colb);
                asm volatile("" : "+s"(off), "+s"(ldl), "+s"(colb));
                unsigned char* dstb = ws + off + (size_t)bq * (::PBS - ((size_t)4096 << (ldl + 1)));
#pragma unroll
                for (int m = 0; m < 4; ++m) { const int row = row0 + ai * HALF + m * 16; const float r = rs[ai][m];
                    f32x4 v0 = acc[ai][bj][m][0] * r + c0[bj], v1 = acc[ai][bj][m][1] * r + c1[bj];
                    if constexpr (ROT) {
                        const f32x4 w0 = {v0[0] * t0[m][0] - v0[1] * t0[m][1], v0[0] * t0[m][1] + v0[1] * t0[m][0], v0[2] * t0[m][2] - v0[3] * t0[m][3], v0[2] * t0[m][3] + v0[3] * t0[m][2]};
                        const f32x4 w1 = {v1[0] * t1[m][0] - v1[1] * t1[m][1], v1[0] * t1[m][1] + v1[1] * t1[m][0], v1[2] * t1[m][2] - v1[3] * t1[m][3], v1[2] * t1[m][3] + v1[3] * t1[m][2]};
                        v0 = w0; v1 = w1; }
                    v0 = v0 * sc; v1 = v1 * sc;
                    *(u32x4*)(dstb + ((((size_t)row << ldl) + (size_t)(colb + cl)) << 1)) = pack8(v0, v1); } }
        }
    }
    __device__ __forceinline__ void operator()(const f32x4 (&acc)[2][2][4][2], const Unit& u, int wr, int wc, int fr, int fq) const {
        const int pn = u.pn, b = u.pm >> 4;
        const int row0 = u.pm * BM + wr * 64 + fr; const int cl = wc * 32 + 8 * fq;
        f32x4 c0[2], c1[2];
#pragma unroll
        for (int bj = 0; bj < 2; ++bj) { const PG8_LAS float* cbp = cbl + pn * BM + bj * HALF + cl; c0[bj] = *(const PG8_LAS f32x4*)(cbp); c1[bj] = *(const PG8_LAS f32x4*)(cbp + 4); }
        float rs[2][4];
        { const PG8_LAS float* rp = rsl + (u.pm == pm0 ? 0 : 256) + wr * 64 + fr;
#pragma unroll
          for (int ai = 0; ai < 2; ++ai)
#pragma unroll
              for (int m = 0; m < 4; ++m) rs[ai][m] = rp[ai * HALF + m * 16]; }
        int kind = (pn == 3 || pn == 4) ? 1 : (pn == 13 ? 2 : 0);
        kind = __builtin_amdgcn_readfirstlane(kind); asm volatile("" : "+s"(kind));
        if (kind == 2) {
            int clg = cl; unsigned long long goff = WS_GR; asm volatile("" : "+v"(clg), "+s"(goff));
            if (clg < 16) { float* gbase = (float*)(ws + goff);
#pragma unroll
                for (int ai = 0; ai < 2; ++ai)
#pragma unroll
                    for (int m = 0; m < 4; ++m) { const int row = row0 + ai * HALF + m * 16; const float r = rs[ai][m]; float* gp = gbase + (size_t)row * 16 + clg;
                        *(f32x4*)(gp) = acc[ai][0][m][0] * r + c0[0]; *(f32x4*)(gp + 4) = acc[ai][0][m][1] * r + c1[0]; } }
        } else if (kind == 1) { tile<true>(acc, rs, c0, c1, pn, row0, cl, b); }
        else { tile<false>(acc, rs, c0, c1, pn, row0, cl, b); }
    }
};

struct EpiResid {
    static constexpr bool PERM = true, AFTER_DRAIN = false;
    const bf16_t* xin; bf16_t* xout;
    const PG8_LAS float* gl; const PG8_LAS float* al;
    bf16_t* xa; unsigned long long* ssn; int write_xa;
    __device__ __forceinline__ void operator()(const f32x4 (&acc)[2][2][4][2], const Unit& u, int wr, int wc, int fr, int fq) const {
        const int row0 = u.pm * BM + wr * 64 + fr;
        const int colb = u.pn * BM + wc * 32 + 8 * fq;
        unsigned voff = (unsigned)(((size_t)row0 * DMC + colb) * 2); asm volatile("" : "+v"(voff));
#define RES_CO(ai, bj, m) ((size_t)(((ai) * HALF + (m) * 16) * DMC + (bj) * HALF) * 2)
#define RES_LD(ai, bj, buf) { _Pragma("unroll") for (int m = 0; m < 4; ++m) xr[buf][m] = *(const u32x4*)((const char*)xin + RES_CO(ai, bj, m) + voff); }
        u32x4 xr[2][4]; f32x4 g0, g1, a0, a1;
        RES_LD(0, 0, 0) RES_LD(1, 0, 1)
        asm volatile("" ::: "memory");
        float sq[2][4] = {{0.f, 0.f, 0.f, 0.f}, {0.f, 0.f, 0.f, 0.f}};
#pragma unroll
        for (int q = 0; q < 4; ++q) {
            const int bj = q >> 1, ai = q & 1, buf = q & 1;
            if (ai == 0) { const int col = colb + bj * HALF;
                g0 = *(const PG8_LAS f32x4*)(gl + col); g1 = *(const PG8_LAS f32x4*)(gl + col + 4); a0 = *(const PG8_LAS f32x4*)(al + col); a1 = *(const PG8_LAS f32x4*)(al + col + 4); }
#pragma unroll
            for (int m = 0; m < 4; ++m) { const u32x4 w = xr[buf][m];
                const f32x4 x0 = {__uint_as_float(w.x << 16), __uint_as_float(w.x & 0xffff0000u), __uint_as_float(w.y << 16), __uint_as_float(w.y & 0xffff0000u)};
                const f32x4 x1 = {__uint_as_float(w.z << 16), __uint_as_float(w.z & 0xffff0000u), __uint_as_float(w.w << 16), __uint_as_float(w.w & 0xffff0000u)};
                const f32x4 y0 = x0 + g0 * acc[ai][bj][m][0], y1 = x1 + g1 * acc[ai][bj][m][1];
                *(u32x4*)((char*)xout + RES_CO(ai, bj, m) + voff) = pack8(y0, y1);
                sq[ai][m] += (y0[0] * y0[0] + y0[1] * y0[1]) + (y0[2] * y0[2] + y0[3] * y0[3]) + (y1[0] * y1[0] + y1[1] * y1[1]) + (y1[2] * y1[2] + y1[3] * y1[3]);
                if (write_xa) *(u32x4*)((char*)xa + RES_CO(ai, bj, m) + voff) = pack8(y0 * a0, y1 * a1); }
            asm volatile("" ::: "memory");
            if (q == 0) RES_LD(0, 1, 0)
            if (q == 1) RES_LD(1, 1, 1)
            asm volatile("" ::: "memory");
            if (bj == 1) {
#pragma unroll
                for (int m = 0; m < 4; ++m) { float s2 = sq[ai][m]; s2 += shx<16>(s2); s2 = add_x32(s2);
                    if (fq == 0) __hip_atomic_fetch_add(ssn + (row0 + ai * HALF + m * 16), ss_fix(s2), __ATOMIC_RELAXED, __HIP_MEMORY_SCOPE_AGENT); }
            }
        }
#undef RES_LD
#undef RES_CO
    }
};

struct EpiFfnUp {
    static constexpr bool PERM = true, AFTER_DRAIN = false;
    const PG8_LAS float* cbl; const PG8_LAS float* rsl; int pm0; bf16_t* hb;
    __device__ __forceinline__ void operator()(const f32x4 (&acc)[2][2][4][2], const Unit& u, int wr, int wc, int fr, int fq) const {
        const int b = u.pm >> 4; const int row0 = u.pm * BM + wr * 64 + fr; const int cw = wc * 32 + 8 * fq;
        const PG8_LAS float* cbp = cbl + u.pn * BM + cw;
        const f32x4 cg0 = *(const PG8_LAS f32x4*)(cbp), cg1 = *(const PG8_LAS f32x4*)(cbp + 4), cu0 = *(const PG8_LAS f32x4*)(cbp + HALF), cu1 = *(const PG8_LAS f32x4*)(cbp + HALF + 4);
        float rs[2][4];
        { const PG8_LAS float* rp = rsl + (u.pm == pm0 ? 0 : 256) + wr * 64 + fr;
#pragma unroll
          for (int ai = 0; ai < 2; ++ai)
#pragma unroll
              for (int m = 0; m < 4; ++m) rs[ai][m] = rp[ai * HALF + m * 16]; }
#pragma unroll
        for (int ai = 0; ai < 2; ++ai)
#pragma unroll
            for (int m = 0; m < 4; ++m) { const int row = row0 + ai * HALF + m * 16;
                const float r = rs[ai][m];
                const f32x4 g0 = acc[ai][0][m][0] * r + cg0, g1 = acc[ai][0][m][1] * r + cg1, u0 = acc[ai][1][m][0] * r + cu0, u1 = acc[ai][1][m][1] * r + cu1;
                f32x4 h0, h1;
#pragma unroll
                for (int e = 0; e < 4; ++e) { h0[e] = silu_f(g0[e]) * u0[e]; h1[e] = silu_f(g1[e]) * u1[e]; }
                *(u32x4*)(hb + (size_t)b * ((::PBS - (size_t)4096 * DFFC * 2) / 2) + (size_t)row * DFFC + u.pn * HALF + cw) = pack8(h0, h1); }
    }
};

struct EpiNull {
    static constexpr bool PERM = true, AFTER_DRAIN = false;
    float* sink;
    __device__ __forceinline__ void operator()(const f32x4 (&acc)[2][2][4][2], const Unit& u, int wr, int wc, int fr, int fq) const {
        f32x4 s = (f32x4){0.f, 0.f, 0.f, 0.f};
#pragma unroll
        for (int ai = 0; ai < 2; ++ai)
#pragma unroll
            for (int bj = 0; bj < 2; ++bj)
#pragma unroll
                for (int m = 0; m < 4; ++m)
#pragma unroll
                    for (int n = 0; n < 2; ++n) s += acc[ai][bj][m][n];
        sink[(size_t)(u.pm * 32 + u.pn) * 512 + (wr * 4 + wc) * 64 + fq * 16 + fr] = (s[0] + s[1]) + (s[2] + s[3]);
    }
};
template <class Epi, class Sched, bool ALIGN_EPI = false, bool SP2 = false>
__device__ __forceinline__ void gemm_phase(PG8_LAS unsigned char* lds, const Gemm g, const Sched& S, const Epi& E, int tid) {
    asm volatile("" : "+v"(tid));
    const int wid = __builtin_amdgcn_readfirstlane(tid >> 6), lane = tid & 63, wr = wid >> 2, wc = wid & 3, fr = lane & 15, fq = lane >> 4;
    const int K = g.K, nt = K / BK;
    unsigned voffA[2], voffB[2];
#pragma unroll
    for (int i = 0; i < 2; ++i) { int R, C; stage_rc(tid * 16 + i * 8192, R, C); const int Rb = Epi::PERM ? ((R & ~31) + perm32(R & 31)) : R;
        voffA[i] = (unsigned)(R * K + C) * 2u; voffB[i] = (unsigned)(Rb * K + C) * 2u; }
    const size_t kstep = (size_t)(BK * 2);
    const size_t hstep = (size_t)HALF * K * 2;
    const size_t tstep = 2 * hstep;
    const unsigned ldsw = (unsigned)wid * 1024u;
    const int aoff = lds_byte(wr * 64 + fr, fq * 8), boff = lds_byte(wc * 32 + fr, fq * 8);
#define PG8_SA(b, h) (((b) * 2 + (h)) * HTB)
#define PG8_SB(b, h) ((4 + (b) * 2 + (h)) * HTB)
#define PG8_STAGE(bufoff, gbase, voff) do { _Pragma("unroll") for (int _i = 0; _i < 2; ++_i) \
        __builtin_amdgcn_global_load_lds((const unsigned*)((const char*)(gbase) + (voff)[_i]), (PG8_LAS unsigned*)(lds + (bufoff) + ldsw + _i * 8192), 16, 0, 0); } while (0)
#define PG8_LDA(dst, b, h) do { _Pragma("unroll") for (int m = 0; m < 4; ++m) _Pragma("unroll") for (int k = 0; k < 2; ++k) dst[m][k] = *(const PG8_LAS bf16x8*)(lds + PG8_SA(b, h) + aoff + m * 2048 + k * 1024); } while (0)
#define PG8_LDB(dst, b, h) do { _Pragma("unroll") for (int n = 0; n < 2; ++n) _Pragma("unroll") for (int k = 0; k < 2; ++k) dst[n][k] = *(const PG8_LAS bf16x8*)(lds + PG8_SB(b, h) + boff + n * 2048 + k * 1024); } while (0)
#define PG8_MMA(ai, bj, At, Bt) do { __builtin_amdgcn_s_setprio(1); _Pragma("unroll") for (int m = 0; m < 4; ++m) _Pragma("unroll") for (int n = 0; n < 2; ++n) _Pragma("unroll") for (int k = 0; k < 2; ++k) \
        acc[ai][bj][m][n] = __builtin_amdgcn_mfma_f32_16x16x32_bf16(Bt[n][k], At[m][k], acc[ai][bj][m][n], 0, 0, 0); __builtin_amdgcn_s_setprio(0); } while (0)
#define PG8_WAIT_V(n) asm volatile("s_waitcnt vmcnt(" #n ")" ::: "memory")
#define PG8_WAIT_L(n) asm volatile("s_waitcnt lgkmcnt(" #n ")" ::: "memory")
#define PG8_BAR __builtin_amdgcn_s_barrier()
#define PG8_SCHED __builtin_amdgcn_sched_barrier(0)
    Unit cur, nxt; int ui = 0;
    if (!S.next(0, cur)) return;
    f32x4 acc[2][2][4][2];
#pragma unroll
    for (int a = 0; a < 2; ++a)
#pragma unroll
        for (int b = 0; b < 2; ++b)
#pragma unroll
            for (int m = 0; m < 4; ++m)
#pragma unroll
                for (int n = 0; n < 2; ++n) acc[a][b][m][n] = (f32x4){0.f, 0.f, 0.f, 0.f};
    bf16x8 At[4][2], B0[2][2], B1[2][2];
    const char* cA = (const char*)g.A + (size_t)cur.pm * tstep + (size_t)(cur.pm >> 4) * g.abx; const char* cB = (const char*)g.Bt + (size_t)cur.pn * tstep;
    S.a_ready(cur);
    if constexpr (SP2) {
        PG8_STAGE(PG8_SB(0, 0), cB, voffB); PG8_STAGE(PG8_SB(0, 1), cB + hstep, voffB); PG8_STAGE(PG8_SA(0, 0), cA, voffA); PG8_STAGE(PG8_SA(0, 1), cA + hstep, voffA);
        if (wr == 1) PG8_BAR;
        PG8_WAIT_V(2); PG8_BAR;
        PG8_STAGE(PG8_SB(1, 0), cB + kstep, voffB); PG8_STAGE(PG8_SA(1, 0), cA + kstep, voffA); PG8_STAGE(PG8_SB(1, 1), cB + hstep + kstep, voffB);
        PG8_WAIT_V(6); PG8_BAR;
    } else {
        PG8_STAGE(PG8_SB(0, 0), cB, voffB); PG8_STAGE(PG8_SA(0, 0), cA, voffA); PG8_STAGE(PG8_SB(0, 1), cB + hstep, voffB); PG8_STAGE(PG8_SA(0, 1), cA + hstep, voffA);
        if (wr == 1) PG8_BAR;
        PG8_WAIT_V(4); PG8_BAR;
        PG8_STAGE(PG8_SB(1, 0), cB + kstep, voffB); PG8_STAGE(PG8_SA(1, 0), cA + kstep, voffA); PG8_STAGE(PG8_SB(1, 1), cB + hstep + kstep, voffB);
        PG8_WAIT_V(6); PG8_BAR;
    }
    for (;;) {
        const bool has_next = S.next(ui + 1, nxt);
        const char* nA = has_next ? (const char*)g.A + (size_t)nxt.pm * tstep + (size_t)(nxt.pm >> 4) * g.abx : cA; const char* nB = has_next ? (const char*)g.Bt + (size_t)nxt.pn * tstep : cB;
        for (int t = 0; t < nt; t += 2) {
            const bool last = (t == nt - 2);
            const char* a1 = cA + (size_t)(t + 1) * kstep;
            const char* a2 = last ? nA : cA + (size_t)(t + 2) * kstep; const char* b2 = last ? nB : cB + (size_t)(t + 2) * kstep;
            const char* a3 = a2 + kstep; const char* b3 = b2 + kstep;
            if (last && has_next) S.a_ready(nxt);
            if constexpr (SP2) {
            PG8_LDB(B0, 0, 0); PG8_LDB(B1, 0, 1); PG8_SCHED; PG8_LDA(At, 0, 0); PG8_STAGE(PG8_SA(1, 1), a1 + hstep, voffA);
            PG8_WAIT_V(8); PG8_WAIT_L(0); PG8_BAR; PG8_MMA(0, 0, At, B0); PG8_MMA(0, 1, At, B1); PG8_BAR; PG8_SCHED;
            PG8_LDA(At, 0, 1); PG8_STAGE(PG8_SB(0, 0), b2, voffB); PG8_STAGE(PG8_SB(0, 1), b2 + hstep, voffB); PG8_STAGE(PG8_SA(0, 0), a2, voffA);
            PG8_WAIT_V(8); PG8_WAIT_L(0); PG8_BAR; PG8_MMA(1, 0, At, B0); PG8_MMA(1, 1, At, B1); PG8_BAR; PG8_SCHED;
            PG8_LDB(B0, 1, 0); PG8_LDB(B1, 1, 1); PG8_SCHED; PG8_LDA(At, 1, 0); PG8_STAGE(PG8_SA(0, 1), a2 + hstep, voffA);
            PG8_WAIT_V(8); PG8_WAIT_L(0); PG8_BAR; PG8_MMA(0, 0, At, B0); PG8_MMA(0, 1, At, B1); PG8_BAR; PG8_SCHED;
            PG8_LDA(At, 1, 1); PG8_STAGE(PG8_SB(1, 0), b3, voffB); PG8_STAGE(PG8_SB(1, 1), b3 + hstep, voffB); PG8_STAGE(PG8_SA(1, 0), a3, voffA);
            PG8_WAIT_V(8); PG8_WAIT_L(0); PG8_BAR; PG8_MMA(1, 0, At, B0); PG8_MMA(1, 1, At, B1); PG8_BAR; PG8_SCHED;
            } else {
            PG8_LDB(B0, 0, 0); PG8_SCHED; PG8_LDA(At, 0, 0); PG8_STAGE(PG8_SA(1, 1), a1 + hstep, voffA);
            PG8_WAIT_L(8); PG8_BAR; PG8_WAIT_L(0); PG8_MMA(0, 0, At, B0); PG8_BAR; PG8_SCHED;
            PG8_LDB(B1, 0, 1); PG8_STAGE(PG8_SB(0, 0), b2, voffB);
            PG8_BAR; PG8_WAIT_L(0); PG8_MMA(0, 1, At, B1); PG8_BAR;
            PG8_LDA(At, 0, 1); PG8_STAGE(PG8_SA(0, 0), a2, voffA);
            PG8_BAR; PG8_WAIT_L(0); PG8_MMA(1, 0, At, B0); PG8_BAR; PG8_SCHED;
            PG8_STAGE(PG8_SB(0, 1), b2 + hstep, voffB);
            PG8_WAIT_V(6); PG8_BAR; PG8_MMA(1, 1, At, B1); PG8_BAR;
            PG8_LDB(B0, 1, 0); PG8_SCHED; PG8_LDA(At, 1, 0); PG8_STAGE(PG8_SA(0, 1), a2 + hstep, voffA);
            PG8_WAIT_L(8); PG8_BAR; PG8_WAIT_L(0); PG8_MMA(0, 0, At, B0); PG8_BAR; PG8_SCHED;
            PG8_LDB(B1, 1, 1); PG8_STAGE(PG8_SB(1, 0), b3, voffB);
            PG8_BAR; PG8_WAIT_L(0); PG8_MMA(0, 1, At, B1); PG8_BAR;
            PG8_LDA(At, 1, 1); PG8_STAGE(PG8_SA(1, 0), a3, voffA);
            PG8_BAR; PG8_WAIT_L(0); PG8_MMA(1, 0, At, B0); PG8_BAR; PG8_SCHED;
            PG8_STAGE(PG8_SB(1, 1), b3 + hstep, voffB);
            PG8_WAIT_V(6); PG8_BAR; PG8_MMA(1, 1, At, B1); PG8_BAR;
            }
        }
        if constexpr (ALIGN_EPI) { if (wr == 0) PG8_BAR; }
        if constexpr (!Epi::AFTER_DRAIN) { E(acc, cur, wr, wc, fr, fq); S.done(cur); }
        if (!has_next) break;
#pragma unroll
        for (int a = 0; a < 2; ++a)
#pragma unroll
            for (int b = 0; b < 2; ++b)
#pragma unroll
                for (int m = 0; m < 4; ++m)
#pragma unroll
                    for (int n = 0; n < 2; ++n) acc[a][b][m][n] = (f32x4){0.f, 0.f, 0.f, 0.f};
        cur = nxt; cA = nA; cB = nB; ++ui;
        if constexpr (ALIGN_EPI) { if (wr == 1) PG8_BAR; }
    }
    PG8_WAIT_V(0);
    if constexpr (!ALIGN_EPI) { if (wr == 0) PG8_BAR; }
    PG8_BAR;
    if constexpr (Epi::AFTER_DRAIN) { E.fused(acc, cur, wr, wc, fr, fq, lds, wid, lane); S.done(cur); }
#undef PG8_SA
#undef PG8_SB
#undef PG8_STAGE
#undef PG8_LDA
#undef PG8_LDB
#undef PG8_MMA
#undef PG8_WAIT_V
#undef PG8_WAIT_L
#undef PG8_BAR
#undef PG8_SCHED
}
}
#define GAS __attribute__((address_space(1)))
#define LAS __attribute__((address_space(3)))
typedef unsigned short bf16;
typedef unsigned v4u __attribute__((ext_vector_type(4)));
typedef float f32x4 __attribute__((ext_vector_type(4)));
typedef short bf16x8 __attribute__((ext_vector_type(8)));
typedef GAS unsigned gu32;
typedef GAS unsigned long long gu64;
#define RLX_AGENT __ATOMIC_RELAXED, __HIP_MEMORY_SCOPE_AGENT
#define LDS_WAIT() asm volatile("s_waitcnt lgkmcnt(0)" ::: "memory")
#define VM_WAIT() asm volatile("s_waitcnt vmcnt(0)" ::: "memory")
__device__ __forceinline__ unsigned long long rt() { return __builtin_amdgcn_s_memrealtime(); }
__device__ __forceinline__ unsigned f2bf(float f) { unsigned u = __builtin_bit_cast(unsigned, f); return (u + 0x7fffu + ((u >> 16) & 1u)) >> 16; }
__device__ __forceinline__ unsigned pk2(float lo, float hi) { return f2bf(lo) | (f2bf(hi) << 16); }
#define XB_TMO      128
#define XB_XCNT(j)  (256  + 64 * (j))
#define XB_XSUB(j)  (1280 + 64 * (j))
#define XB_XGEN(j)  (2304 + 64 * (j))
#define XB_TOP      3328
#define XB_TOPGEN   3392
#define XCD_BAR_WORDS 3456
#define XB_SPIN_CAP (1u << 18)

__device__ __forceinline__ unsigned xb_ld(unsigned* p)              { return __hip_atomic_load(p, __ATOMIC_RELAXED, __HIP_MEMORY_SCOPE_AGENT); }
__device__ __forceinline__ unsigned xb_add(unsigned* p, unsigned v) { return __hip_atomic_fetch_add(p, v, __ATOMIC_RELAXED, __HIP_MEMORY_SCOPE_AGENT); }
__device__ __forceinline__ unsigned xb_xcc_id() { return (unsigned)__builtin_amdgcn_s_getreg((3 << 11) | 20) & 0xFu; }
#define XB_SPIN(cond, bar) do { unsigned _sp = 0; while (cond) { __builtin_amdgcn_s_sleep(1); \
    if ((++_sp & 255u) == 0u) { if (xb_ld(&(bar)[XB_TMO])) break; if (_sp > XB_SPIN_CAP) { atomicAdd(&(bar)[XB_TMO], 1u); break; } } } } while (0)

struct XcdBarrier {
    unsigned* bar; unsigned x; int tid;
    volatile LAS unsigned* st;
};

__device__ __forceinline__ XcdBarrier xcd_barrier_post(unsigned* bar, volatile LAS unsigned* st) {
    XcdBarrier b; b.bar = bar; b.x = xb_xcc_id(); b.st = st; b.tid = (int)threadIdx.x;
    if (threadIdx.x == 0) st[2] = xb_add(&bar[XB_XCNT(b.x)], 1u);
    return b;
}
__device__ __forceinline__ void xcd_barrier_complete(unsigned* bar, unsigned x, unsigned& nloc, unsigned& nx, unsigned& uni) {
    const unsigned G = gridDim.x * gridDim.y * gridDim.z;
    unsigned sum, cnt, mine, n32, sp = 0u;
    for (;;) {
        sum = 0u; cnt = 0u; mine = 0u; n32 = 0u;
#pragma unroll
        for (unsigned j = 0; j < 16; ++j) { const unsigned c = xb_ld(&bar[XB_XCNT(j)]); sum += c; cnt += (c > 0u) ? 1u : 0u; mine = (j == x) ? c : mine; n32 += (j < 8u && c == 32u) ? 1u : 0u; }
        if (sum == G) break;
        __builtin_amdgcn_s_sleep(1);
        if ((++sp & 255u) == 0u) { if (xb_ld(&bar[XB_TMO])) break; if (sp > XB_SPIN_CAP) { atomicAdd(&bar[XB_TMO], 1u); break; } }
    }
    nloc = mine > 0u ? mine : 1u; nx = cnt > 0u ? cnt : 1u;
    uni = (sum == G && G == 256u && n32 == 8u) ? 1u : 2u;
}

__device__ __forceinline__ void xcd_barrier(const XcdBarrier& b, int local_only = 0) {
    asm volatile("s_waitcnt vmcnt(0)" ::: "memory");
    __syncthreads();
    if (b.tid == 0) {
        unsigned* bar = b.bar;
        __builtin_amdgcn_s_waitcnt(0);
        unsigned nloc = b.st[0], nx = b.st[1];
        if (nloc == 0u) { unsigned uni; xcd_barrier_complete(bar, b.x, nloc, nx, uni); b.st[0] = nloc; b.st[1] = nx; b.st[3] = uni; }
        const unsigned old = xb_add(&bar[XB_XSUB(b.x)], 1u);
        const unsigned gen = old / nloc;
        if (old + 1u == (gen + 1u) * nloc) {
            if (!local_only) {
            __builtin_amdgcn_fence(__ATOMIC_RELEASE, "agent");
            asm volatile("s_waitcnt vmcnt(0)" ::: "memory");
            const unsigned og = xb_add(&bar[XB_TOP], 1u);
            const unsigned tg = og / nx;
            if (og + 1u == (tg + 1u) * nx) xb_add(&bar[XB_TOPGEN], 1u);
            else XB_SPIN(xb_ld(&bar[XB_TOPGEN]) == tg, bar);
            }
            __builtin_amdgcn_fence(__ATOMIC_ACQUIRE, "agent");
            xb_add(&bar[XB_XGEN(b.x)], 1u);
            asm volatile("s_waitcnt vmcnt(0)" ::: "memory");
        } else {
            XB_SPIN(xb_ld(&bar[XB_XGEN(b.x)]) == gen, bar);
            __builtin_amdgcn_fence(__ATOMIC_ACQUIRE, "agent");
            asm volatile("s_waitcnt vmcnt(0)" ::: "memory");
        }
    }
    __syncthreads();
}
__device__ __forceinline__ float bf2f(unsigned short h) { return __uint_as_float((unsigned)h << 16); }
__device__ __forceinline__ float wave_sum(float v) {
    return add_x32(sum32(v));
}
__device__ __forceinline__ float rdl(float v, int l) { return __int_as_float(__builtin_amdgcn_readlane(__float_as_int(v), l)); }

struct TrDesc { const float* W; bf16* WT; int ldw, k0, src, nv, K, dst; };
__device__ __forceinline__ void tr_load(const TrDesc& d, f32x4 (&v)[8], int lane) {
    const int c4 = (lane & 7) * 4, kr = lane >> 3;
#pragma unroll
    for (int i = 0; i < 8; ++i) v[i] = (c4 < d.nv) ? *(const f32x4*)(d.W + (size_t)(d.k0 + kr + 8 * i) * d.ldw + d.src + c4) : (f32x4){0.f, 0.f, 0.f, 0.f};
}
__device__ __forceinline__ void tr_store(const TrDesc& d, const f32x4 (&v)[8], LAS float* scr, int lane) {
    const int c4 = (lane & 7) * 4, kr = lane >> 3;
#pragma unroll
    for (int i = 0; i < 8; ++i) *(LAS f32x4*)(scr + (kr + 8 * i) * 36 + c4) = v[i];
    LDS_WAIT(); asm volatile("" ::: "memory");
    const int c = lane & 7;
#pragma unroll
    for (int j = 0; j < 4; ++j) { const int n = (lane >> 3) + 8 * j; const LAS float* p = scr + (8 * c) * 36 + n;
        v4u o; o.x = pk2(p[0 * 36], p[1 * 36]); o.y = pk2(p[2 * 36], p[3 * 36]); o.z = pk2(p[4 * 36], p[5 * 36]); o.w = pk2(p[6 * 36], p[7 * 36]);
        *(GAS v4u*)(d.WT + (size_t)(d.dst + n) * d.K + d.k0 + 8 * c) = o; }
    LDS_WAIT(); asm volatile("" ::: "memory");
}

struct Ptrs {
    const float *x, *c, *ada_w, *ada_b, *norm1_g, *norm2_g, *w_in, *gla_wa2, *gla_ba, *gla_norm_g, *ret_norm_g, *w_out, *ffn_wg, *ffn_wu, *ffn_wd, *final_g;
    float* out; unsigned char* ws;
};

__device__ __forceinline__ void sincos_acc(float angf, float& s, float& c) {
    const double x = (double)angf;
    const double kq = __builtin_rint(x * 0.63661977236758134308);
    const double r = (x - kq * 1.57079632679489655800e+00) - kq * 6.12323399573676603587e-17;
    const double r2 = r * r;
    double sp = -1.0 / 1307674368000.0; sp = sp * r2 + 1.0 / 6227020800.0; sp = sp * r2 - 1.0 / 39916800.0; sp = sp * r2 + 1.0 / 362880.0; sp = sp * r2 - 1.0 / 5040.0; sp = sp * r2 + 1.0 / 120.0; sp = sp * r2 - 1.0 / 6.0; sp = sp * r2 + 1.0; sp *= r;
    double cp = 1.0 / 20922789888000.0; cp = cp * r2 - 1.0 / 87178291200.0; cp = cp * r2 + 1.0 / 479001600.0; cp = cp * r2 - 1.0 / 3628800.0; cp = cp * r2 + 1.0 / 40320.0; cp = cp * r2 - 1.0 / 720.0; cp = cp * r2 + 1.0 / 24.0; cp = cp * r2 - 0.5; cp = cp * r2 + 1.0;
    const int q = (int)kq & 3;
    const double sv = (q == 0) ? sp : (q == 1) ? cp : (q == 2) ? -sp : -cp;
    const double cv = (q == 0) ? cp : (q == 1) ? -sp : (q == 2) ? -cp : sp;
    s = (float)sv; c = (float)cv;
}

template <int DK, bool GLA>
__device__ __forceinline__ void seq_recurrent_v0(const bf16* Qp, const bf16* Kp, const bf16* Vp, const bf16* Gp, const float* GAp, const float* ng, bf16* OMp, int b, int h, int lane, int om_off) {
    float S[DK];
#pragma unroll
    for (int d = 0; d < DK; ++d) S[d] = 0.f;
    const float gam = GLA ? 0.f : (1.0f - exp2f(-5.0f - (float)h));
    const float ngv = ng[lane];
    const int dl = lane & (DK - 1);
    constexpr int LQK = DK * 4;
    size_t row = (size_t)b * SEQ;
    float qv = bf2f(Qp[row * LQK + h * DK + dl]), kv = bf2f(Kp[row * LQK + h * DK + dl]), av = GLA ? GAp[row * 128 + h * 32 + dl] : 0.f;
    float vv = bf2f(Vp[row * 256 + h * 64 + lane]), gv = bf2f(Gp[row * 256 + h * 64 + lane]);
    for (int t = 0; t < SEQ; ++t) {
        const size_t rn = (size_t)b * SEQ + (t + 1 < SEQ ? t + 1 : t);
        const float qn = bf2f(Qp[rn * LQK + h * DK + dl]), kn = bf2f(Kp[rn * LQK + h * DK + dl]), an = GLA ? GAp[rn * 128 + h * 32 + dl] : 0.f;
        const float vn = bf2f(Vp[rn * 256 + h * 64 + lane]), gn = bf2f(Gp[rn * 256 + h * 64 + lane]);
        float o = 0.f;
#pragma unroll
        for (int d = 0; d < DK; ++d) { const float kd = rdl(kv, d), qd = rdl(qv, d);
            if (GLA) { const float ad = rdl(av, d); S[d] = fmaf(kd, vv, ad * S[d]); } else { S[d] = fmaf(kd, vv, gam * S[d]); }
            o = fmaf(qd, S[d], o); }
        const float ms = wave_sum(o * o) * (1.0f / 64.0f);
        const float y = o * __builtin_amdgcn_rsqf(ms + 1e-6f) * ngv * (gv / (1.0f + __expf(-gv)));
        OMp[((size_t)b * SEQ + t) * DM + om_off + h * 64 + lane] = (bf16)f2bf(y);
        qv = qn; kv = kn; av = an; vv = vn; gv = gn;
    }
}

__device__ __forceinline__ void sb_unit_v0(const bf16* SQ, const bf16* SK, const bf16* SV, bf16* OM, int unit, int lane) {
    const int bh = unit >> 6, qb = unit & 63, b = bh >> 3, h = bh & 7;
    const int t = qb * 64 + lane; const size_t row = (size_t)b * SEQ + t;
    float q[64], o[64];
    { const v4u* qp = (const v4u*)(SQ + row * 512 + h * 64);
#pragma unroll
      for (int i = 0; i < 8; ++i) { const v4u w = qp[i];
          q[8 * i + 0] = __uint_as_float(w.x << 16); q[8 * i + 1] = __uint_as_float(w.x & 0xffff0000u); q[8 * i + 2] = __uint_as_float(w.y << 16); q[8 * i + 3] = __uint_as_float(w.y & 0xffff0000u);
          q[8 * i + 4] = __uint_as_float(w.z << 16); q[8 * i + 5] = __uint_as_float(w.z & 0xffff0000u); q[8 * i + 6] = __uint_as_float(w.w << 16); q[8 * i + 7] = __uint_as_float(w.w & 0xffff0000u); } }
#pragma unroll
    for (int i = 0; i < 64; ++i) o[i] = 0.f;
    float R = 0.f;
    for (int j = 1; j <= SEQ; ++j) {
        const bool act = (t - j >= 0) && (R > SB_THR);
        if (!__any(act)) break;
        if (act) {
            const v4u* kp = (const v4u*)(SK + (row - j) * 512 + h * 64);
            float z = 0.f;
#pragma unroll
            for (int i = 0; i < 8; ++i) { const v4u w = kp[i];
                z = fmaf(q[8 * i + 0], __uint_as_float(w.x << 16), z); z = fmaf(q[8 * i + 1], __uint_as_float(w.x & 0xffff0000u), z); z = fmaf(q[8 * i + 2], __uint_as_float(w.y << 16), z); z = fmaf(q[8 * i + 3], __uint_as_float(w.y & 0xffff0000u), z);
                z = fmaf(q[8 * i + 4], __uint_as_float(w.z << 16), z); z = fmaf(q[8 * i + 5], __uint_as_float(w.z & 0xffff0000u), z); z = fmaf(q[8 * i + 6], __uint_as_float(w.w << 16), z); z = fmaf(q[8 * i + 7], __uint_as_float(w.w & 0xffff0000u), z); }
            const float e = __expf(-fabsf(z)), l1p = __logf(1.0f + e);
            const float lsz = fminf(z, 0.f) - l1p, l1m = fminf(-z, 0.f) - l1p;
            const float w = __expf(lsz + R);
            const v4u* vp = (const v4u*)(SV + (row - j) * 512 + h * 64);
#pragma unroll
            for (int i = 0; i < 8; ++i) { const v4u x = vp[i];
                o[8 * i + 0] = fmaf(w, __uint_as_float(x.x << 16), o[8 * i + 0]); o[8 * i + 1] = fmaf(w, __uint_as_float(x.x & 0xffff0000u), o[8 * i + 1]); o[8 * i + 2] = fmaf(w, __uint_as_float(x.y << 16), o[8 * i + 2]); o[8 * i + 3] = fmaf(w, __uint_as_float(x.y & 0xffff0000u), o[8 * i + 3]);
                o[8 * i + 4] = fmaf(w, __uint_as_float(x.z << 16), o[8 * i + 4]); o[8 * i + 5] = fmaf(w, __uint_as_float(x.z & 0xffff0000u), o[8 * i + 5]); o[8 * i + 6] = fmaf(w, __uint_as_float(x.w << 16), o[8 * i + 6]); o[8 * i + 7] = fmaf(w, __uint_as_float(x.w & 0xffff0000u), o[8 * i + 7]); }
            R += l1m;
        }
    }
    v4u* op = (v4u*)(OM + row * DM + 512 + h * 64);
#pragma unroll
    for (int i = 0; i < 8; ++i) { v4u w; w.x = pk2(o[8 * i + 0], o[8 * i + 1]); w.y = pk2(o[8 * i + 2], o[8 * i + 3]); w.z = pk2(o[8 * i + 4], o[8 * i + 5]); w.w = pk2(o[8 * i + 6], o[8 * i + 7]); op[i] = w; }
}

typedef short v4i16_t __attribute__((ext_vector_type(4)));
typedef float f32x16 __attribute__((ext_vector_type(16)));
typedef float f32x2_t __attribute__((ext_vector_type(2)));
#define MFMA32(a, b, c) __builtin_amdgcn_mfma_f32_32x32x16_bf16((a), (b), (c), 0, 0, 0)
__device__ __forceinline__ int crow(int r, int hi) { return (r & 3) + 8 * (r >> 2) + 4 * hi; }
__device__ __forceinline__ int tr_lane_off(int lane) { return ((lane >> 4) & 1) * 32 + (lane & 3) * 8 + (4 * (lane >> 5) + ((lane & 15) >> 2)) * 64; }
__device__ __forceinline__ bf16x8 frag_tr(LAS unsigned char* p) {
    const v4i16_t lo = __builtin_amdgcn_ds_read_tr16_b64_v4i16((LAS v4i16_t*)p);
    const v4i16_t hi = __builtin_amdgcn_ds_read_tr16_b64_v4i16((LAS v4i16_t*)(p + 512));
    return (bf16x8){lo[0], lo[1], lo[2], lo[3], hi[0], hi[1], hi[2], hi[3]};
}
__device__ __forceinline__ void stage_row64(LAS unsigned char* slot, const bf16* src, int lane) {
    const v4u* sp = (const v4u*)src; v4u w[8];
#pragma unroll
    for (int j = 0; j < 8; ++j) w[j] = sp[j];
    LAS unsigned char* base = slot + (lane >> 4) * 1024 + (lane & 15) * 64;
#pragma unroll
    for (int j = 0; j < 8; ++j) *(LAS v4u*)(base + (j >> 2) * 4096 + (j & 3) * 16) = w[j];
}
__device__ __forceinline__ void unpack8(const v4u w, float* f) {
    f[0] = __uint_as_float(w.x << 16); f[1] = __uint_as_float(w.x & 0xffff0000u); f[2] = __uint_as_float(w.y << 16); f[3] = __uint_as_float(w.y & 0xffff0000u);
    f[4] = __uint_as_float(w.z << 16); f[5] = __uint_as_float(w.z & 0xffff0000u); f[6] = __uint_as_float(w.w << 16); f[7] = __uint_as_float(w.w & 0xffff0000u);
}
__device__ __forceinline__ v4u pack8f(const float* f) { v4u w; w.x = pg8::cvt_pk_bf16(f[0], f[1]); w.y = pg8::cvt_pk_bf16(f[2], f[3]); w.z = pg8::cvt_pk_bf16(f[4], f[5]); w.w = pg8::cvt_pk_bf16(f[6], f[7]); return w; }
__device__ __forceinline__ bf16x8 packP(const f32x16& P, int b0) {
    v4u w; w.x = pg8::cvt_pk_bf16(P[b0 + 0], P[b0 + 1]); w.y = pg8::cvt_pk_bf16(P[b0 + 2], P[b0 + 3]); w.z = pg8::cvt_pk_bf16(P[b0 + 4], P[b0 + 5]); w.w = pg8::cvt_pk_bf16(P[b0 + 6], P[b0 + 7]);
    return __builtin_bit_cast(bf16x8, w);
}
__device__ __forceinline__ float ret_log2_gamma(int h) { return log2f(1.0f - exp2f(-5.0f - (float)h)); }

template <int DK, bool GLA>
__device__ __forceinline__ void chunk_sum_unit(int ch, bf16* Qp, bf16* Kp, const bf16* Vp, const float* GRp, const float* wa2, const float* ba, float* KVT, float* DEC, LAS unsigned char* wlds, int lane) {
    asm volatile("" : "+v"(lane));
    const int b = ch >> 8, h = (ch >> 6) & 3, n = ch & 63; const size_t row = (size_t)b * SEQ + n * 64 + lane;
    constexpr int LQK = DK * 4;
    LAS unsigned char* vslot = wlds; LAS unsigned char* kslot = wlds + 8192;
    constexpr int PQ = DK / 8;
    constexpr int RQ_ = 64 / PQ;
    const size_t R0 = (size_t)b * SEQ + n * 64;
    const int pv = lane & 7, rv = lane >> 3;
    const int pq = lane & (PQ - 1), rq = lane / PQ;
    v4u vraw[8], kraw[PQ], qraw[PQ];
    float w[16], bias = 0.f;
    f32x4 grv[4];
    if (GLA) {
#pragma unroll
        for (int r = 0; r < 16; ++r) w[r] = wa2[r * 128 + h * 32 + (lane & 31)];
        bias = ba[h * 32 + (lane & 31)];
#pragma unroll
        for (int j = 0; j < 4; ++j) grv[j] = *(const f32x4*)(GRp + R0 * 16 + (size_t)(j * 64 + lane) * 4); }
#pragma unroll
    for (int i = 0; i < 8; ++i) vraw[i] = *(const v4u*)(Vp + (R0 + 8 * i + rv) * 256 + h * 64 + 8 * pv);
#pragma unroll
    for (int i = 0; i < PQ; ++i) { const size_t o = (R0 + RQ_ * i + rq) * LQK + h * DK + 8 * pq;
        kraw[i] = *(const v4u*)(Kp + o); if (GLA) qraw[i] = *(const v4u*)(Qp + o); }
    float ebls = 1.f, l2g = 0.f;
    LAS float* BT = (LAS float*)wlds; LAS float* grl = (LAS float*)(wlds + 12288); LAS float* T0 = (LAS float*)(wlds + 12288);
    if (GLA) {
#pragma unroll
        for (int j = 0; j < 4; ++j) *(LAS f32x4*)(grl + (j * 64 + lane) * 4) = grv[j];
        const int c = lane & 31, half = lane >> 5;
        asm volatile("s_waitcnt lgkmcnt(0)" ::: "memory");
        float run = 0.f;
#pragma unroll 4
        for (int tt = 0; tt < 32; ++tt) {
            const int t = half * 32 + tt;
            const f32x4 g0 = *(const LAS f32x4*)(grl + t * 16), g1 = *(const LAS f32x4*)(grl + t * 16 + 4), g2 = *(const LAS f32x4*)(grl + t * 16 + 8), g3 = *(const LAS f32x4*)(grl + t * 16 + 12);
            float u = bias;
            u = fmaf(g0[0], w[0], u); u = fmaf(g0[1], w[1], u); u = fmaf(g0[2], w[2], u); u = fmaf(g0[3], w[3], u);
            u = fmaf(g1[0], w[4], u); u = fmaf(g1[1], w[5], u); u = fmaf(g1[2], w[6], u); u = fmaf(g1[3], w[7], u);
            u = fmaf(g2[0], w[8], u); u = fmaf(g2[1], w[9], u); u = fmaf(g2[2], w[10], u); u = fmaf(g2[3], w[11], u);
            u = fmaf(g3[0], w[12], u); u = fmaf(g3[1], w[13], u); u = fmaf(g3[2], w[14], u); u = fmaf(g3[3], w[15], u);
            run += (fminf(u, 0.f) - __logf(1.0f + __expf(-fabsf(u)))) * (1.0f / 16.0f);
            BT[t * 32 + c] = run;
        }
        asm volatile("s_waitcnt lgkmcnt(0)" ::: "memory");
        if (half == 0) T0[c] = run;
        asm volatile("s_waitcnt lgkmcnt(0)" ::: "memory");
    } else {
        l2g = ret_log2_gamma(h); ebls = exp2f(64.0f * l2g);
    }
#pragma unroll
    for (int i = 0; i < PQ; ++i) {
        const int r = RQ_ * i + rq;
        float kk[8], qq[8], kh[8], e8[8], el8[8];
        if (GLA) {
            const f32x4 b0 = *(const LAS f32x4*)(BT + r * 32 + 8 * pq), b1 = *(const LAS f32x4*)(BT + r * 32 + 8 * pq + 4);
            const f32x4 t0 = *(const LAS f32x4*)(T0 + 8 * pq), t1 = *(const LAS f32x4*)(T0 + 8 * pq + 4);
            const f32x4 l0 = *(const LAS f32x4*)(BT + 63 * 32 + 8 * pq) + t0, l1 = *(const LAS f32x4*)(BT + 63 * 32 + 8 * pq + 4) + t1;
            const float addt = (r >= 32) ? 1.0f : 0.0f;
#pragma unroll
            for (int e = 0; e < 4; ++e) { e8[e] = __expf(b0[e] + addt * t0[e]); e8[4 + e] = __expf(b1[e] + addt * t1[e]); el8[e] = __expf(l0[e]); el8[4 + e] = __expf(l1[e]); }
            if (i == 0 && rq == 0) { *(f32x4*)(DEC + (size_t)(b * 64 + n) * 128 + h * 32 + 8 * pq) = (f32x4){el8[0], el8[1], el8[2], el8[3]}; *(f32x4*)(DEC + (size_t)(b * 64 + n) * 128 + h * 32 + 8 * pq + 4) = (f32x4){el8[4], el8[5], el8[6], el8[7]}; }
        }
        unpack8(kraw[i], kk); if (GLA) unpack8(qraw[i], qq);
        const float iebs = GLA ? 1.f : exp2f(-(float)(r + 1) * l2g);
#pragma unroll
        for (int e = 0; e < 8; ++e) {
            if (GLA) { qq[e] *= e8[e]; kk[e] *= __builtin_amdgcn_rcpf(e8[e]); kh[e] = kk[e] * el8[e]; }
            else { kk[e] *= iebs; kh[e] = kk[e] * ebls; }
        }
        if (GLA) { const size_t o = (R0 + r) * LQK + h * DK + 8 * pq; *(v4u*)(Qp + o) = pack8f(qq); *(v4u*)(Kp + o) = pack8f(kk); }
        *(LAS v4u*)(kslot + (pq >> 2) * 4096 + (r >> 4) * 1024 + (r & 15) * 64 + (pq & 3) * 16) = pack8f(kh);
    }
    asm volatile("s_waitcnt lgkmcnt(0)" ::: "memory");
#pragma unroll
    for (int i = 0; i < 8; ++i) { const int r = 8 * i + rv; *(LAS v4u*)(vslot + (pv >> 2) * 4096 + (r >> 4) * 1024 + (r & 15) * 64 + (pv & 3) * 16) = vraw[i]; }
    asm volatile("s_waitcnt lgkmcnt(0)" ::: "memory");
    const int hi = lane >> 5, tro = tr_lane_off(lane);
    f32x16 acc[2][DK / 32];
#pragma unroll
    for (int eh = 0; eh < 2; ++eh)
#pragma unroll
        for (int dh = 0; dh < DK / 32; ++dh) acc[eh][dh] = (f32x16){0.f, 0.f, 0.f, 0.f, 0.f, 0.f, 0.f, 0.f, 0.f, 0.f, 0.f, 0.f, 0.f, 0.f, 0.f, 0.f};
#pragma unroll
    for (int rg = 0; rg < 4; ++rg) {
        bf16x8 vf[2], kf[DK / 32];
#pragma unroll
        for (int eh = 0; eh < 2; ++eh) vf[eh] = frag_tr(vslot + eh * 4096 + rg * 1024 + tro);
#pragma unroll
        for (int dh = 0; dh < DK / 32; ++dh) kf[dh] = frag_tr(kslot + dh * 4096 + rg * 1024 + tro);
#pragma unroll
        for (int eh = 0; eh < 2; ++eh)
#pragma unroll
            for (int dh = 0; dh < DK / 32; ++dh) acc[eh][dh] = MFMA32(vf[eh], kf[dh], acc[eh][dh]);
    }
    unsigned short* kvp = (unsigned short*)KVT + (size_t)ch * (64 * DK);
#pragma unroll
    for (int eh = 0; eh < 2; ++eh)
#pragma unroll
        for (int dh = 0; dh < DK / 32; ++dh)
#pragma unroll
            for (int r = 0; r < 16; ++r) kvp[(32 * eh + crow(r, hi)) * DK + 32 * dh + (lane & 31)] = (unsigned short)f2bf(acc[eh][dh][r]);
    asm volatile("s_waitcnt lgkmcnt(0)" ::: "memory");
}

template <int DK, bool GLA>
__device__ __forceinline__ void scan_unit(int seq, int part, const float* KVT, const float* DEC, bf16* ST, int lane) {
    const int idx = part * 128 + lane * 2; const int d = idx & (DK - 1);
    const int b = seq >> 2, h = seq & 3;
    float s0 = 0.f, s1 = 0.f;
    const float gdec = GLA ? 0.f : exp2f(64.0f * ret_log2_gamma(h));
    for (int n0 = 0; n0 < 64; n0 += 32) {
        float kv0[32], kv1[32], d0[32], d1[32];
#pragma unroll
        for (int i = 0; i < 32; ++i) { const size_t chn = (size_t)seq * 64 + n0 + i;
            const unsigned kvw = *(const unsigned*)((const unsigned short*)KVT + chn * (64 * DK) + idx); kv0[i] = __uint_as_float(kvw << 16); kv1[i] = __uint_as_float(kvw & 0xffff0000u);
            if (GLA) { const f32x2_t dd = *(const f32x2_t*)(DEC + (size_t)(b * 64 + n0 + i) * 128 + h * 32 + d); d0[i] = dd.x; d1[i] = dd.y; } else { d0[i] = gdec; d1[i] = gdec; } }
#pragma unroll
        for (int i = 0; i < 32; ++i) { const size_t chn = (size_t)seq * 64 + n0 + i;
            *(unsigned*)(ST + chn * (64 * DK) + idx) = pg8::cvt_pk_bf16(s0, s1);
            s0 = fmaf(d0[i], s0, kv0[i]); s1 = fmaf(d1[i], s1, kv1[i]); }
    }
}

template <int DK>
__device__ __forceinline__ void chunk_out_unit(int ch, const bf16* Qp, const bf16* Kp, const bf16* Vp, const bf16* Gp, const bf16* ST, const float* ng, bf16* OMp, int om_off, LAS unsigned char* wlds, LAS float* ngl, int lane) {
    asm volatile("" : "+v"(lane));
    const float ngv = ng[lane];
    const int b = ch >> 8, h = (ch >> 6) & 3, n = ch & 63; const size_t R0 = (size_t)b * SEQ + n * 64;
    constexpr int LQK = DK * 4, NKS = DK / 16;
    const int hi = lane >> 5, l31 = lane & 31, tro = tr_lane_off(lane);
    LAS unsigned char* vslot = wlds;
    bf16x8 qf[2][NKS], kf[2][NKS], sf[NKS][2];
    v4u graw[2][4];
#pragma unroll
    for (int tb = 0; tb < 2; ++tb)
#pragma unroll
        for (int i = 0; i < 4; ++i) graw[tb][i] = *(const v4u*)(Gp + (R0 + 32 * tb + 8 * i + (lane >> 3)) * 256 + h * 64 + 8 * (lane & 7));
    constexpr int PQ = DK / 8, RQ_ = 64 / PQ;
    const int pq = lane & (PQ - 1), rq = lane / PQ, pv = lane & 7, rv = lane >> 3;
    v4u qraw[PQ], kraw[PQ], sraw[PQ], vrow[8];
#pragma unroll
    for (int i = 0; i < PQ; ++i) { const size_t o = (R0 + RQ_ * i + rq) * LQK + h * DK + 8 * pq;
        qraw[i] = *(const v4u*)(Qp + o); kraw[i] = *(const v4u*)(Kp + o);
        sraw[i] = *(const v4u*)(ST + (size_t)ch * (64 * DK) + (RQ_ * i + rq) * DK + 8 * pq); }
#pragma unroll
    for (int i = 0; i < 8; ++i) vrow[i] = *(const v4u*)(Vp + (R0 + 8 * i + rv) * 256 + h * 64 + 8 * pv);
    asm volatile("" ::: "memory");
    {
        LAS unsigned char* img = wlds + 8192;
#define CO_PUT(raw) { _Pragma("unroll") for (int i = 0; i < PQ; ++i) { const int r = RQ_ * i + rq; *(LAS v4u*)(img + (pq >> 2) * 4096 + (r >> 4) * 1024 + (r & 15) * 64 + (pq & 3) * 16) = raw[i]; } }
#define CO_FRAG(row, piece) (*(const LAS bf16x8*)(img + ((piece) >> 2) * 4096 + ((row) >> 4) * 1024 + ((row) & 15) * 64 + ((piece) & 3) * 16))
        CO_PUT(qraw) asm volatile("s_waitcnt lgkmcnt(0)" ::: "memory");
#pragma unroll
        for (int half = 0; half < 2; ++half)
#pragma unroll
            for (int ks = 0; ks < NKS; ++ks) qf[half][ks] = CO_FRAG(32 * half + l31, 2 * ks + hi);
        asm volatile("s_waitcnt lgkmcnt(0)" ::: "memory");
        CO_PUT(kraw) asm volatile("s_waitcnt lgkmcnt(0)" ::: "memory");
#pragma unroll
        for (int half = 0; half < 2; ++half)
#pragma unroll
            for (int ks = 0; ks < NKS; ++ks) kf[half][ks] = CO_FRAG(32 * half + l31, 2 * ks + hi);
        asm volatile("s_waitcnt lgkmcnt(0)" ::: "memory");
        CO_PUT(sraw) asm volatile("s_waitcnt lgkmcnt(0)" ::: "memory");
#pragma unroll
        for (int ks = 0; ks < NKS; ++ks)
#pragma unroll
            for (int dh = 0; dh < 2; ++dh) sf[ks][dh] = CO_FRAG(32 * dh + l31, 2 * ks + hi);
        asm volatile("s_waitcnt lgkmcnt(0)" ::: "memory");
#undef CO_PUT
#undef CO_FRAG
#pragma unroll
        for (int i = 0; i < 8; ++i) { const int r = 8 * i + rv; *(LAS v4u*)(vslot + (pv >> 2) * 4096 + (r >> 4) * 1024 + (r & 15) * 64 + (pv & 3) * 16) = vrow[i]; }
    }
    ngl[lane] = ngv;
    asm volatile("s_waitcnt lgkmcnt(0)" ::: "memory");
    if (DK == 64) {
        const float l2g = ret_log2_gamma(h);
#pragma unroll
        for (int half = 0; half < 2; ++half) { const float tq = (float)(32 * half + l31 + 1); const float sq_ = exp2f(tq * l2g), sk_ = exp2f(-tq * l2g);
#pragma unroll
            for (int ks = 0; ks < NKS; ++ks) { float f[8];
                unpack8(__builtin_bit_cast(v4u, qf[half][ks]), f);
#pragma unroll
                for (int e = 0; e < 8; ++e) f[e] *= sq_;
                qf[half][ks] = __builtin_bit_cast(bf16x8, pack8f(f));
                unpack8(__builtin_bit_cast(v4u, kf[half][ks]), f);
#pragma unroll
                for (int e = 0; e < 8; ++e) f[e] *= sk_;
                kf[half][ks] = __builtin_bit_cast(bf16x8, pack8f(f)); } }
    }
#pragma unroll
    for (int tb = 0; tb < 2; ++tb) {
        f32x16 o0 = (f32x16){0.f, 0.f, 0.f, 0.f, 0.f, 0.f, 0.f, 0.f, 0.f, 0.f, 0.f, 0.f, 0.f, 0.f, 0.f, 0.f}, o1 = o0;
#pragma unroll
        for (int ks = 0; ks < NKS; ++ks) { o0 = MFMA32(qf[tb][ks], sf[ks][0], o0); o1 = MFMA32(qf[tb][ks], sf[ks][1], o1); }
#pragma unroll
        for (int kh = 0; kh <= tb; ++kh) {
            f32x16 P = (f32x16){0.f, 0.f, 0.f, 0.f, 0.f, 0.f, 0.f, 0.f, 0.f, 0.f, 0.f, 0.f, 0.f, 0.f, 0.f, 0.f};
#pragma unroll
            for (int ks = 0; ks < NKS; ++ks) P = MFMA32(kf[kh][ks], qf[tb][ks], P);
            if (kh == tb) {
#pragma unroll
                for (int r = 0; r < 16; ++r) if (crow(r, hi) > l31) P[r] = 0.f;
            }
            const bf16x8 pa0 = packP(P, 0), pa1 = packP(P, 8);
            const bf16x8 v00 = frag_tr(vslot + 0 * 4096 + (2 * kh) * 1024 + tro), v01 = frag_tr(vslot + 0 * 4096 + (2 * kh + 1) * 1024 + tro);
            const bf16x8 v10 = frag_tr(vslot + 1 * 4096 + (2 * kh) * 1024 + tro), v11 = frag_tr(vslot + 1 * 4096 + (2 * kh + 1) * 1024 + tro);
            o0 = MFMA32(pa0, v00, o0); o0 = MFMA32(pa1, v01, o0);
            o1 = MFMA32(pa0, v10, o1); o1 = MFMA32(pa1, v11, o1);
        }
        {
            LAS float* OT = (LAS float*)(wlds + 8192);
#pragma unroll
            for (int r = 0; r < 16; ++r) { const int tt = crow(r, hi); OT[tt * 64 + (l31 ^ ((tt & 7) << 2))] = o0[r]; OT[tt * 64 + ((32 + l31) ^ ((tt & 7) << 2))] = o1[r]; }
            asm volatile("s_waitcnt lgkmcnt(0)" ::: "memory");
            const int pp = lane & 7;
            const f32x4 n0 = *(const LAS f32x4*)(ngl + 8 * pp), n1 = *(const LAS f32x4*)(ngl + 8 * pp + 4);
#pragma unroll
            for (int i = 0; i < 4; ++i) { const int rr = 8 * i + (lane >> 3); const int sw = (rr & 7) << 2;
                const f32x4 x0 = *(const LAS f32x4*)(OT + rr * 64 + ((8 * pp) ^ sw)), x1 = *(const LAS f32x4*)(OT + rr * 64 + ((8 * pp + 4) ^ sw));
                float sq = (x0[0] * x0[0] + x0[1] * x0[1]) + (x0[2] * x0[2] + x0[3] * x0[3]) + (x1[0] * x1[0] + x1[1] * x1[1]) + (x1[2] * x1[2] + x1[3] * x1[3]);
                sq += shx<1>(sq); sq += shx<2>(sq); sq += shx<4>(sq);
                const float rs = __builtin_amdgcn_rsqf(sq * (1.0f / 64.0f) + 1e-6f);
                float g[8], y[8]; unpack8(graw[tb][i], g);
#pragma unroll
                for (int e = 0; e < 8; ++e) { const float nn = (e < 4) ? n0[e & 3] : n1[e & 3]; const float xv = (e < 4) ? x0[e & 3] : x1[e & 3]; y[e] = xv * rs * nn * (g[e] * __builtin_amdgcn_rcpf(1.0f + __expf(-g[e]))); }
                *(v4u*)(OMp + (R0 + 32 * tb + rr) * DM + om_off + h * 64 + 8 * pp) = pack8f(y); }
            asm volatile("s_waitcnt lgkmcnt(0)" ::: "memory");
        }
    }
    asm volatile("s_waitcnt lgkmcnt(0)" ::: "memory");
}

struct SbK { bf16x8 a0[4], a1[4]; };
__device__ __forceinline__ void sb_dma_k(const bf16* SK, size_t rowbase, int s0, int h, int lane, LAS unsigned char* kslot) {
    const char* kb = (const char*)(SK + (rowbase + s0) * 512 + h * 64); const unsigned voff = (unsigned)(lane >> 3) * 1024u + (unsigned)((lane & 7) ^ (lane >> 3)) * 16u;
#pragma unroll
    for (int c = 0; c < 8; ++c) __builtin_amdgcn_global_load_lds((const unsigned*)(kb + c * 8192 + voff), (LAS unsigned*)(kslot + c * 1024), 16, 0, 0);
}
__device__ __forceinline__ void sb_dma_v(const bf16* SV, size_t rowbase, int s0, int h, int lane, LAS unsigned char* vslot) {
    const char* vb = (const char*)(SV + (rowbase + s0) * 512 + h * 64); const unsigned voff = (unsigned)(lane >> 2) * 1024u + (unsigned)(lane & 3) * 16u;
#pragma unroll
    for (int p = 0; p < 8; ++p)
        __builtin_amdgcn_global_load_lds((const unsigned*)(vb + (16 * (p & 3)) * 1024 + (p >> 2) * 64 + voff), (LAS unsigned*)(vslot + p * 1024), 16, 0, 0);
}
__device__ __forceinline__ void sb_read_k(SbK& k, LAS unsigned char* kslot, int lane) {
    const int l31 = lane & 31, hi = lane >> 5;
#pragma unroll
    for (int ks = 0; ks < 4; ++ks) { const int slot = (2 * ks + hi) ^ (l31 & 7);
        k.a0[ks] = *(const LAS bf16x8*)(kslot + l31 * 128 + slot * 16); k.a1[ks] = *(const LAS bf16x8*)(kslot + 4096 + l31 * 128 + slot * 16); }
}
template <bool DIAG>
__device__ __forceinline__ void sb_half(const bf16x8 (&ka)[4], const bf16x8 (&qr)[4], float& suf, int sbase, int t, int hi, bf16x8& paLo, bf16x8& paHi) {
    f32x16 p = (f32x16){0.f, 0.f, 0.f, 0.f, 0.f, 0.f, 0.f, 0.f, 0.f, 0.f, 0.f, 0.f, 0.f, 0.f, 0.f, 0.f};
#pragma unroll
    for (int ks = 0; ks < 4; ++ks) p = MFMA32(ka[ks], qr[ks], p);
    float om[16];
#pragma unroll
    for (int r = 0; r < 16; ++r) {
        const float e = __builtin_amdgcn_exp2f(-fmaxf(p[r], -100.0f)); float sg = __builtin_amdgcn_rcpf(1.0f + e), o1 = e * sg;
        if (DIAG) { const bool ok = (sbase + crow(r, hi) < t); sg = ok ? sg : 0.f; o1 = ok ? o1 : 1.0f; }
        p[r] = sg; om[r] = o1;
    }
    float G[4], H[4], sg4[4];
#pragma unroll
    for (int q = 0; q < 4; ++q) G[q] = (om[4 * q] * om[4 * q + 1]) * (om[4 * q + 2] * om[4 * q + 3]);
#pragma unroll
    for (int q = 0; q < 4; ++q) H[q] = get_x32(G[q], hi);
#pragma unroll
    for (int q = 3; q >= 0; --q) { sg4[q] = suf * (hi ? 1.0f : H[q]); suf *= G[q] * H[q]; }
#pragma unroll
    for (int q = 0; q < 4; ++q) { float s = sg4[q];
        p[4 * q + 3] *= s; s *= om[4 * q + 3]; p[4 * q + 2] *= s; s *= om[4 * q + 2]; p[4 * q + 1] *= s; s *= om[4 * q + 1]; p[4 * q] *= s; }
    paLo = packP(p, 0); paHi = packP(p, 8);
}
template <bool DIAG, int BLK>
__device__ __forceinline__ void sb_tile(const SbK& k, const bf16x8 (&qr)[4], const bf16x8 (&vf)[2][4], f32x16& o0, f32x16& o1, float& R, int s0, int t, int hi) {
    float suf = R; bf16x8 paLo, paHi;
    if (!(DIAG && BLK == 0)) {
    sb_half<DIAG>(k.a1, qr, suf, s0 + 32, t, hi, paLo, paHi);
    o0 = MFMA32(paLo, vf[0][2], o0); o1 = MFMA32(paLo, vf[1][2], o1);
    o0 = MFMA32(paHi, vf[0][3], o0); o1 = MFMA32(paHi, vf[1][3], o1);
    }
    sb_half<(DIAG && BLK == 0)>(k.a0, qr, suf, s0, t, hi, paLo, paHi);
    o0 = MFMA32(paLo, vf[0][0], o0); o1 = MFMA32(paLo, vf[1][0], o1);
    o0 = MFMA32(paHi, vf[0][1], o0); o1 = MFMA32(paHi, vf[1][1], o1);
    R = suf;
}
template <bool DIAG>
__device__ __forceinline__ void sb_iter(const bf16* SK, const bf16* SV, size_t rowbase, int j, int h, int lane, LAS unsigned char* kslot, LAS unsigned char* vslot,
                                        const bf16x8 (&qrA)[4], const bf16x8 (&qrB)[4], f32x16& oA0, f32x16& oA1, f32x16& oB0, f32x16& oB1, float& RA, float& RB, bool& doneA, bool& doneB, int tA, int hi, int tro) {
    asm volatile("s_waitcnt vmcnt(0)" ::: "memory");
    SbK k; sb_read_k(k, kslot, lane);
    bf16x8 vf[2][4];
#pragma unroll
    for (int ch2 = 0; ch2 < 2; ++ch2)
#pragma unroll
        for (int rg = 0; rg < 4; ++rg) vf[ch2][rg] = frag_tr(vslot + ch2 * 4096 + rg * 1024 + tro);
    asm volatile("s_waitcnt lgkmcnt(0)" ::: "memory");
    if (j > 0) { sb_dma_k(SK, rowbase, (j - 1) * 64, h, lane, kslot); sb_dma_v(SV, rowbase, (j - 1) * 64, h, lane, vslot); }
    if (!doneA) { sb_tile<DIAG, 0>(k, qrA, vf, oA0, oA1, RA, j * 64, tA, hi); doneA = __all(RA < SB_PMIN); }
    if (!doneB) { sb_tile<DIAG, 1>(k, qrB, vf, oB0, oB1, RB, j * 64, tA + 32, hi); doneB = __all(RB < SB_PMIN); }
}
__device__ __forceinline__ void sb_unit_v1(int unit, const bf16* SQ, const bf16* SK, const bf16* SV, bf16* OM, LAS unsigned char* wlds, int lane) {
    asm volatile("" : "+v"(lane));
    const int bh = unit >> 6, qb = unit & 63, b = bh >> 3, h = bh & 7;
    const int hi = lane >> 5, l31 = lane & 31, tro = tr_lane_off(lane);
    const size_t rowbase = (size_t)b * SEQ; const int t0 = qb * 64; const int tA = t0 + l31;
    LAS unsigned char* kslot = wlds; LAS unsigned char* vslot = wlds + 8192;
    asm volatile("s_waitcnt lgkmcnt(0)" ::: "memory");
    int j = qb;
    sb_dma_k(SK, rowbase, j * 64, h, lane, kslot); sb_dma_v(SV, rowbase, j * 64, h, lane, vslot);
    bf16x8 qrA[4], qrB[4];
#pragma unroll
    for (int ks = 0; ks < 4; ++ks) { qrA[ks] = *(const bf16x8*)(SQ + (rowbase + tA) * 512 + h * 64 + 16 * ks + 8 * hi); qrB[ks] = *(const bf16x8*)(SQ + (rowbase + tA + 32) * 512 + h * 64 + 16 * ks + 8 * hi); }
    const f32x16 zero16 = (f32x16){0.f, 0.f, 0.f, 0.f, 0.f, 0.f, 0.f, 0.f, 0.f, 0.f, 0.f, 0.f, 0.f, 0.f, 0.f, 0.f};
    f32x16 oA0 = zero16, oA1 = zero16, oB0 = zero16, oB1 = zero16;
    float RA = 1.0f, RB = 1.0f; bool doneA = false, doneB = false;
    sb_iter<true>(SK, SV, rowbase, j, h, lane, kslot, vslot, qrA, qrB, oA0, oA1, oB0, oB1, RA, RB, doneA, doneB, tA, hi, tro);
    while (j > 0 && !(doneA && doneB)) {
        --j;
        sb_iter<false>(SK, SV, rowbase, j, h, lane, kslot, vslot, qrA, qrB, oA0, oA1, oB0, oB1, RA, RB, doneA, doneB, tA, hi, tro);
    }
    asm volatile("s_waitcnt vmcnt(0) lgkmcnt(0)" ::: "memory");
    { LAS float* OT = (LAS float*)wlds;
#pragma unroll
      for (int r = 0; r < 16; ++r) { const int tt = crow(r, hi); const int sw = (tt & 7) << 2;
          OT[tt * 64 + (l31 ^ sw)] = oA0[r]; OT[tt * 64 + ((32 + l31) ^ sw)] = oA1[r]; OT[2048 + tt * 64 + (l31 ^ sw)] = oB0[r]; OT[2048 + tt * 64 + ((32 + l31) ^ sw)] = oB1[r]; }
      asm volatile("s_waitcnt lgkmcnt(0)" ::: "memory");
      const int pp = lane & 7;
#pragma unroll
      for (int i = 0; i < 8; ++i) { const int rr = 8 * i + (lane >> 3);
          const int sw = (rr & 7) << 2; const LAS float* src = OT + (rr >> 5) * 2048 + (rr & 31) * 64;
          const f32x4 x0 = *(const LAS f32x4*)(src + ((8 * pp) ^ sw)), x1 = *(const LAS f32x4*)(src + ((8 * pp + 4) ^ sw));
          float y[8] = {x0[0], x0[1], x0[2], x0[3], x1[0], x1[1], x1[2], x1[3]};
          *(v4u*)(OM + (rowbase + t0 + rr) * DM + 512 + h * 64 + 8 * pp) = pack8f(y); }
      asm volatile("s_waitcnt lgkmcnt(0)" ::: "memory"); }
}

__device__ __forceinline__ int lane_now() { int l; asm volatile("v_mbcnt_lo_u32_b32 %0, -1, 0\n\tv_mbcnt_hi_u32_b32 %0, -1, %0" : "=v"(l)); return l; }
struct Args { const float* in[16]; float* out; unsigned char* ws; int ph_lo, ph_hi; };
__global__ void __launch_bounds__(NWAVES * 64, 2) mk_fwd(Args args) {
    extern __shared__ __attribute__((aligned(16))) unsigned char lds_raw[];
    LAS unsigned char* lds = (LAS unsigned char*)lds_raw;
    volatile LAS unsigned* MISC = (volatile LAS unsigned*)(lds + MISC_OFF);
    const int wave_k = __builtin_amdgcn_readfirstlane((int)threadIdx.x >> 6);
#define TID_NOW() (wave_k * 64 + lane_now())
    const int G = gridDim.x; const int bx = blockIdx.x; const int NGW = G * NWAVES;
    int bxe = bx, lmode = 0;
    typedef __attribute__((address_space(4))) const unsigned long long kargw_t;
    const kargw_t* kargs = (const kargw_t*)__builtin_amdgcn_kernarg_segment_ptr();
#define PH_BEGIN() const kargw_t* kq_ = kargs; asm volatile("" : "+s"(kq_)); int tid = TID_NOW(); asm volatile("" : "+v"(tid)); const int lane = tid & 63, wave = __builtin_amdgcn_readfirstlane(tid >> 6); \
    const int vcu = (G % 8 == 0) ? (bxe % 8) * (G / 8) + bxe / 8 : bxe; const int gw = vcu * NWAVES + wave; (void)lane; (void)wave; (void)vcu; (void)gw; \
    unsigned char* ws = (unsigned char*)(GAS unsigned char*)kq_[17]; float* out = (float*)(GAS float*)kq_[16]; (void)out; \
    gu32* ctl = (gu32*)(ws + WS_CTL); (void)ctl; unsigned long long* SS = (unsigned long long*)(ws + WS_SS); float* MOD = (float*)(ws + WS_MOD); float* CBIN = (float*)(ws + WS_CBIN); float* CBUP = (float*)(ws + WS_CBUP); float* ROT = (float*)(ws + WS_ROT); \
    bf16 *WIN = (bf16*)(ws + WS_WIN), *WOUT = (bf16*)(ws + WS_WOUT), *WUP = (bf16*)(ws + WS_WUP), *WDN = (bf16*)(ws + WS_WDN); \
    bf16 *XA = (bf16*)(ws + WS_XA), *OM = (bf16*)(ws + WS_OM), *HB = (bf16*)(ws + WS_HB); \
    const size_t bq_ = (size_t)(gw >> 8);        \
    bf16 *GQ = (bf16*)(ws + WS_GQ + bq_ * (PBS - 1 * MiB)), *GK = (bf16*)(ws + WS_GK + bq_ * (PBS - 1 * MiB)), *GV = (bf16*)(ws + WS_GV + bq_ * (PBS - 2 * MiB)), *GG = (bf16*)(ws + WS_GG + bq_ * (PBS - 2 * MiB)), \
         *RQ = (bf16*)(ws + WS_RQ + bq_ * (PBS - 2 * MiB)), *RK = (bf16*)(ws + WS_RK + bq_ * (PBS - 2 * MiB)), *RV = (bf16*)(ws + WS_RV + bq_ * (PBS - 2 * MiB)), *RG = (bf16*)(ws + WS_RG + bq_ * (PBS - 2 * MiB)), \
         *SQ = (bf16*)(ws + WS_SQ + bq_ * (PBS - 4 * MiB)), *SK = (bf16*)(ws + WS_SK + bq_ * (PBS - 4 * MiB)), *SV = (bf16*)(ws + WS_SV + bq_ * (PBS - 4 * MiB)); \
    float *GR = (float*)(ws + WS_GR), *GA = (float*)(ws + WS_GA); \
    (void)SS; (void)MOD; (void)CBIN; (void)CBUP; (void)ROT; (void)WIN; (void)WOUT; (void)WUP; (void)WDN; (void)XA; (void)OM; (void)HB; (void)GQ; (void)GK; (void)GV; (void)GG; (void)RQ; (void)RK; (void)RV; (void)RG; (void)SQ; (void)SK; (void)SV; (void)GR; (void)GA;
#define IN_PTR(i) ((const float*)(const GAS float*)kq_[i])
    for (int u = (int)threadIdx.x; u < (LDS_BYTES - LDSCTL_OFF) / 4; u += NWAVES * 64) ((LAS unsigned*)(lds + LDSCTL_OFF))[u] = 0u;
    __syncthreads();
    { PH_BEGIN(); (void)xcd_barrier_post((unsigned*)(ctl + CW_BAR), MISC + 8); }
#if PROBE_ON
#define STAMP() do { if (blockIdx.x == 0 && TID_NOW() == 0) { ((volatile LAS unsigned long long*)(lds + LDSCTL_OFF + 1024))[nstamp_] = __builtin_amdgcn_s_memrealtime(); } ++nstamp_; } while (0)
    int nstamp_ = 0;
#else
#define STAMP() do {} while (0)
#endif
#define GRID_BAR() do { GRID_BAR_(0); STAMP(); } while (0)
#define XCC_BAR() do { GRID_BAR_(lmode); STAMP(); } while (0)
#define GRID_BAR_(loc) do { const kargw_t* kb_ = kargs; asm volatile("" : "+s"(kb_)); XcdBarrier bb_; bb_.bar = (unsigned*)((gu32*)(GAS unsigned char*)kb_[17] + CW_BAR); bb_.x = xb_xcc_id(); bb_.st = MISC + 8; bb_.tid = TID_NOW(); xcd_barrier(bb_, (loc)); } while (0)

    STAMP();
    {
        PH_BEGIN(); const float *cvec = IN_PTR(1), *ada_w = IN_PTR(2), *ada_b = IN_PTR(3), *w_in = IN_PTR(6), *w_out = IN_PTR(11), *ffn_wg = IN_PTR(12), *ffn_wu = IN_PTR(13), *ffn_wd = IN_PTR(14);
        LAS float* tbl = (LAS float*)(lds + RING_OFF); LAS float* red = (LAS float*)(lds + RING_OFF + 32768);
        if (bx < 192) {
            const int l = bx / 96, jblk = bx % 96, jq = tid & 15, kg = tid >> 4, j0 = jblk * 64 + 4 * jq;
            f32x4 w4[32]; float cv[16];
#pragma unroll
            for (int i = 0; i < 32; ++i) w4[i] = *(const f32x4*)(ada_w + ((size_t)l * DM + kg * 32 + i) * MODLD + j0);
#pragma unroll
            for (int q = 0; q < 16; ++q) cv[q] = cvec[tid + q * (NWAVES * 64)];
            asm volatile("" : "+v"(w4[0]), "+v"(w4[1]), "+v"(w4[2]), "+v"(w4[3]), "+v"(w4[4]), "+v"(w4[5]), "+v"(w4[6]), "+v"(w4[7]), "+v"(w4[8]), "+v"(w4[9]), "+v"(w4[10]), "+v"(w4[11]), "+v"(w4[12]), "+v"(w4[13]), "+v"(w4[14]), "+v"(w4[15]) :: "memory");
            asm volatile("" : "+v"(w4[16]), "+v"(w4[17]), "+v"(w4[18]), "+v"(w4[19]), "+v"(w4[20]), "+v"(w4[21]), "+v"(w4[22]), "+v"(w4[23]), "+v"(w4[24]), "+v"(w4[25]), "+v"(w4[26]), "+v"(w4[27]), "+v"(w4[28]), "+v"(w4[29]), "+v"(w4[30]), "+v"(w4[31]) :: "memory");
#pragma unroll
            for (int q = 0; q < 16; ++q) tbl[tid + q * (NWAVES * 64)] = cv[q] / (1.0f + __expf(-cv[q]));
            __syncthreads();
            f32x4 acc[8];
#pragma unroll
            for (int b = 0; b < 8; ++b) acc[b] = (f32x4){0.f, 0.f, 0.f, 0.f};
#pragma unroll
            for (int b = 0; b < 8; ++b)
#pragma unroll
                for (int i = 0; i < 32; ++i) acc[b] += w4[i] * tbl[b * DM + kg * 32 + i];
#pragma unroll
            for (int b = 0; b < 8; ++b) *(LAS f32x4*)(red + (kg * 8 + b) * 64 + 4 * jq) = acc[b];
            __syncthreads();
            { const int b = tid >> 6, j = tid & 63; float sum = ada_b[l * MODLD + jblk * 64 + j];
#pragma unroll 8
              for (int g8 = 0; g8 < 32; ++g8) sum += red[(g8 * 8 + b) * 64 + j];
              MOD[((size_t)l * 8 + b) * MODLD + jblk * 64 + j] = sum; }
        }
        __syncthreads();
        LAS float* scr = (LAS float*)(lds + RING_OFF + wave * 16384);
        constexpr int I_IN = 16 * (NIN / 32), I_OUT = 16 * 32, I_UP = 16 * (NUP / 32), I_DN = (DFF / 64) * 32, I_L = I_IN + I_OUT + I_UP + I_DN;
        auto mk = [&](int it) {
            TrDesc d; const int l = it / I_L; int r = it % I_L;
            if (r < I_IN) { const int nblk = NIN / 32, kb = r / nblk, nb = r % nblk, n0 = nb * 32;
                int src, nv; if (n0 < 768) { src = n0; nv = 32; } else if (n0 < 3328) { src = n0 + 16; nv = 32; } else if (n0 == 3328) { src = 768; nv = 16; } else { src = 0; nv = 0; }
                d.W = w_in + (size_t)l * DM * NIN_SRC; d.ldw = NIN_SRC; d.k0 = kb * 64; d.src = src; d.nv = nv; d.WT = WIN + (size_t)l * NIN * DM; d.K = DM; d.dst = n0; return d; }
            r -= I_IN;
            if (r < I_OUT) { const int kb = r / 32, nb = r % 32; d.W = w_out + (size_t)l * DM * DM; d.ldw = DM; d.k0 = kb * 64; d.src = nb * 32; d.nv = 32; d.WT = WOUT + (size_t)l * DM * DM; d.K = DM; d.dst = nb * 32; return d; }
            r -= I_OUT;
            if (r < I_UP) { const int nblk = NUP / 32, kb = r / nblk, nb = r % nblk, n0 = nb * 32, tile = n0 >> 8, jj = n0 & 255;
                d.W = ((jj < 128) ? ffn_wg : ffn_wu) + (size_t)l * DM * DFF; d.ldw = DFF; d.k0 = kb * 64; d.src = tile * 128 + (jj & 127); d.nv = 32; d.WT = WUP + (size_t)l * NUP * DM; d.K = DM; d.dst = n0; return d; }
            r -= I_UP;
            { const int kb = r / 32, nb = r % 32; d.W = ffn_wd + (size_t)l * DFF * DM; d.ldw = DM; d.k0 = kb * 64; d.src = nb * 32; d.nv = 32; d.WT = WDN + (size_t)l * DM * DFF; d.K = DFF; d.dst = nb * 32; return d; }
        };
        if (gw < 2 * I_L) {
            TrDesc dc = mk(gw); f32x4 vc[8]; tr_load(dc, vc, lane);
            for (int it = gw; it < 2 * I_L; it += NGW) {
                const bool more = it + NGW < 2 * I_L;
                TrDesc dn = dc; f32x4 vn[8];
                if (more) { dn = mk(it + NGW); tr_load(dn, vn, lane); }
                tr_store(dc, vc, scr, lane);
                if (more) { dc = dn;
#pragma unroll
                    for (int i = 0; i < 8; ++i) vc[i] = vn[i]; }
            }
        }
        for (int e = gw * 64 + lane; e < SEQ * 32; e += NGW * 64) { const int pos = e >> 5, i = e & 31;
            const float inv = powf(10000.0f, -(float)(2 * i) / 64.0f); const float ang = (float)pos * inv; float s, c; sincos_acc(ang, s, c);
            ROT[2 * e] = c; ROT[2 * e + 1] = s; }
    }
    GRID_BAR();
    { const unsigned m_ = MISC[11], r_ = MISC[10]; lmode = __builtin_amdgcn_readfirstlane((int)(m_ == 1u)); if (lmode) bxe = __builtin_amdgcn_readfirstlane((int)(r_ * 8u + xb_xcc_id())); }
    {
        PH_BEGIN(); const float *x = IN_PTR(0), *norm1_g = IN_PTR(4);
        {
            LAS float* shl = (LAS float*)(lds + RING_OFF);
#pragma unroll 4
            for (int q = 0; q < 16; ++q) { const int idx = tid + q * (NWAVES * 64); const int grp = idx >> 11, b = (idx >> 8) & 7, c4 = idx & 255;
                *(LAS f32x4*)(shl + (size_t)idx * 4) = *(const f32x4*)(MOD + ((size_t)(grp >> 1) * 8 + b) * MODLD + ((grp & 1) ? 3 : 0) * DM + c4 * 4); }
            unsigned long long wraw[9][4];
#pragma unroll
            for (int k = 0; k < 9; ++k) { const int r = gw + k * 2048;
                const int l = r >= (NIN + NUP) ? 1 : 0, rr = r - l * (NIN + NUP); const int kind = rr >= NIN ? 1 : 0, n = rr - kind * NIN;
                const bf16* W = kind ? (WUP + ((size_t)l * NUP + n) * DM) : (WIN + ((size_t)l * NIN + n) * DM);
#pragma unroll
                for (int j = 0; j < 4; ++j) wraw[k][j] = *(const unsigned long long*)(W + j * 256 + lane * 4); }
            asm volatile("" ::: "memory");
            __syncthreads();
            const int hi = lane >> 5, b4 = (lane >> 4) & 1, b3 = (lane >> 3) & 1;
#pragma unroll 1
            for (int k = 0; k < 9; ++k) { const int r = gw + k * 2048;
                const int l = r >= (NIN + NUP) ? 1 : 0, rr = r - l * (NIN + NUP); const int kind = rr >= NIN ? 1 : 0, n = rr - kind * NIN; const int grp = l * 2 + kind;
                float wv[16];
#pragma unroll
                for (int j = 0; j < 4; ++j) { unsigned long long w8 = 0;
#pragma unroll
                    for (int kk = 0; kk < 9; ++kk) w8 = (kk == k) ? wraw[kk][j] : w8;
                    const unsigned lo = (unsigned)w8, hi2 = (unsigned)(w8 >> 32);
                    wv[4 * j + 0] = __uint_as_float(lo << 16); wv[4 * j + 1] = __uint_as_float(lo & 0xffff0000u); wv[4 * j + 2] = __uint_as_float(hi2 << 16); wv[4 * j + 3] = __uint_as_float(hi2 & 0xffff0000u); }
                float sm[8];
#pragma unroll
                for (int b = 0; b < 8; ++b) { float a = 0.f;
#pragma unroll
                    for (int j = 0; j < 4; ++j) { const f32x4 s4 = *(const LAS f32x4*)(shl + ((size_t)(grp * 8 + b)) * 1024 + j * 256 + lane * 4);
                        a = fmaf(s4[0], wv[4 * j + 0], a); a = fmaf(s4[1], wv[4 * j + 1], a); a = fmaf(s4[2], wv[4 * j + 2], a); a = fmaf(s4[3], wv[4 * j + 3], a); }
                    sm[b] = a; }
                float u4[4], u2[2], u1;
#pragma unroll
                for (int i = 0; i < 4; ++i) { const float mine = hi ? sm[i + 4] : sm[i], send = hi ? sm[i] : sm[i + 4]; u4[i] = mine + get_x32(send, hi); }
#pragma unroll
                for (int i = 0; i < 2; ++i) { const float mine = b4 ? u4[i + 2] : u4[i], send = b4 ? u4[i] : u4[i + 2]; u2[i] = mine + shx<16>(send); }
                { const float mine = b3 ? u2[1] : u2[0], send = b3 ? u2[0] : u2[1]; u1 = mine + shx<8>(send); }
                u1 += shx<4>(u1); u1 += shx<2>(u1); u1 += shx<1>(u1);
                const int bb = hi * 4 + b4 * 2 + b3;
                float* CB = kind ? (CBUP + (size_t)l * 8 * NUP) : (CBIN + (size_t)l * 8 * NIN); const int NR = kind ? NUP : NIN;
                if ((lane & 7) == 0) CB[(size_t)bb * NR + n] = u1;
            }
            __syncthreads();
        }
        {
            f32x4 vcur[4], an[4];
            const int mb = (gw >> 8) * SEQ + (gw & 255);
            { const float* sp = MOD + (size_t)(gw >> 8) * MODLD + DM + lane * 4;
#pragma unroll
              for (int j = 0; j < 4; ++j) an[j] = *(const f32x4*)(norm1_g + j * 256 + lane * 4) * (*(const f32x4*)(sp + j * 256) + 1.0f); }
            { const GAS f32x4* xr = (const GAS f32x4*)(x + (size_t)mb * DM) + lane;
#pragma unroll
              for (int j = 0; j < 4; ++j) vcur[j] = xr[64 * j]; }
            asm volatile("" : "+v"(vcur[0]), "+v"(vcur[1]), "+v"(vcur[2]), "+v"(vcur[3]), "+v"(an[0]), "+v"(an[1]), "+v"(an[2]), "+v"(an[3]));
            for (int k = 0; k < SEQ / 256; ++k) { const int m = mb + 256 * k;
                f32x4 vnx[4]; const bool more = k + 1 < SEQ / 256;
                if (more) { const GAS f32x4* xn = (const GAS f32x4*)(x + (size_t)(m + 256) * DM) + lane;
#pragma unroll
                    for (int j = 0; j < 4; ++j) vnx[j] = xn[64 * j]; }
                asm volatile("" ::: "memory");
                float s = 0.f;
                GAS unsigned long long* o8 = (GAS unsigned long long*)(XA + (size_t)m * DM) + lane;
                GAS unsigned long long* r8 = (GAS unsigned long long*)((bf16*)out + (size_t)m * DM) + lane;
#pragma unroll
                for (int j = 0; j < 4; ++j) { const f32x4 v = vcur[j]; s += (v.x * v.x + v.y * v.y) + (v.z * v.z + v.w * v.w);
                    const f32x4 y = v * an[j]; o8[64 * j] = (unsigned long long)pk2(y.x, y.y) | ((unsigned long long)pk2(y.z, y.w) << 32);
                    r8[64 * j] = (unsigned long long)pk2(v.x, v.y) | ((unsigned long long)pk2(v.z, v.w) << 32); }
                s = wave_sum(s); if (lane == 0) SS[m] = ss_fix(s);
                if (more) {
#pragma unroll
                    for (int j = 0; j < 4; ++j) vcur[j] = vnx[j]; }
            }
        }
    }
    GRID_BAR();

    for (int l = 0; l < DEPTH; ++l) {
        {
            PH_BEGIN();
            LAS float* cbl = (LAS float*)(lds + CBL_OFF); LAS float* rsl = (LAS float*)(lds + RSL_OFF);
            const int pm0_ = 16 * (bxe & 7) + ((bxe >> 3) & 7);
            const float* cbg = CBIN + ((size_t)l * 8 + (bxe & 7)) * NIN;
            for (int i = tid; i < NIN / 4; i += NWAVES * 64) *(LAS f32x4*)(cbl + 4 * i) = *(const f32x4*)(cbg + 4 * i);
            const int pm_ = pm0_ + 8 * __builtin_amdgcn_readfirstlane(tid >> 8); rsl[tid] = row_rstd(SS + (size_t)(2 * l) * M, (size_t)pm_ * 256 + (tid & 255));
            __syncthreads();
        }
        {
            PH_BEGIN();
            pg8::Gemm g{XA, WIN + (size_t)l * NIN * DM, M, NIN, DM}; pg8::StaticOrder S; S.init(M, NIN, G, bxe);
            pg8::EpiInProj E{(LAS float*)(lds + CBL_OFF), (LAS float*)(lds + RSL_OFF), 16 * (bxe & 7) + ((bxe >> 3) & 7), ROT, ws};
            pg8::gemm_phase<pg8::EpiInProj, pg8::StaticOrder, true, true>(lds + RING_OFF, g, S, E, tid);
        }
        XCC_BAR();
#if !(MIX_GLA_V1)
        {
            PH_BEGIN(); const float *gla_wa2 = IN_PTR(7), *gla_ba = IN_PTR(8);
            float w0[16], w1[16];
#pragma unroll
            for (int r = 0; r < 16; ++r) { w0[r] = gla_wa2[((size_t)l * 16 + r) * 128 + lane]; w1[r] = gla_wa2[((size_t)l * 16 + r) * 128 + 64 + lane]; }
            const float b0 = gla_ba[l * 128 + lane], b1 = gla_ba[l * 128 + 64 + lane];
            for (int m = gw; m < M; m += NGW) {
                const float grv = GR[(size_t)m * 16 + (lane & 15)];
                float u0 = b0, u1 = b1;
#pragma unroll
                for (int r = 0; r < 16; ++r) { const float gr = rdl(grv, r); u0 = fmaf(gr, w0[r], u0); u1 = fmaf(gr, w1[r], u1); }
                const float l0 = fminf(u0, 0.f) - __logf(1.0f + __expf(-fabsf(u0))), l1 = fminf(u1, 0.f) - __logf(1.0f + __expf(-fabsf(u1)));
                GA[(size_t)m * 128 + lane] = __expf(l0 * (1.0f / 16.0f)); GA[(size_t)m * 128 + 64 + lane] = __expf(l1 * (1.0f / 16.0f));
            }
        }
        GRID_BAR();
#endif
#if MIX_GLA_V1 || MIX_RET_V1 || MIX_SB_V1
        {
            const int ord = wave_k >> 2;
#pragma unroll 1
            for (int step = 0; step < 3; ++step) {
                const int which = ord ? (step == 0 ? 2 : step - 1) : step;
                if (which == 0) { PH_BEGIN(); const float *gla_wa2 = IN_PTR(7), *gla_ba = IN_PTR(8); LAS unsigned char* wlds = lds + RING_OFF + wave * 16384;
                    for (int ch = gw; ch < 2048; ch += NGW) chunk_sum_unit<32, true>(ch, GQ, GK, GV, GR, gla_wa2 + (size_t)l * 16 * 128, gla_ba + l * 128, (float*)(ws + WS_KVTG), (float*)(ws + WS_DEC), wlds, lane_now()); }
                else if (which == 1) { PH_BEGIN(); LAS unsigned char* wlds = lds + RING_OFF + wave * 16384;
                    for (int ch = gw; ch < 2048; ch += NGW) chunk_sum_unit<64, false>(ch, RQ, RK, RV, nullptr, nullptr, nullptr, (float*)(ws + WS_KVTR), nullptr, wlds, lane_now()); }
                else { PH_BEGIN(); LAS unsigned char* wlds = lds + RING_OFF + wave * 16384;
                    { const int g_ = gw >> 8, u_ = gw & 255; sb_unit_v1(((g_ * 8 + (u_ >> 6)) << 6) | (u_ & 63), SQ, SK, SV, OM, wlds, lane_now()); } }
            }
        }
        XCC_BAR();
        {
            const int ord = wave_k >> 2;
#pragma unroll 1
            for (int step = 0; step < 2; ++step) {
                if ((ord ? 1 - step : step) == 0) { PH_BEGIN();
                    const int g_ = gw >> 8, u_ = gw & 255;
                    if (u_ < 64) scan_unit<32, true>(g_ * 4 + (u_ >> 4), u_ & 15, (const float*)(ws + WS_KVTG), (const float*)(ws + WS_DEC), (bf16*)(ws + WS_STG), lane);
                    else if (u_ < 192) scan_unit<64, false>(g_ * 4 + ((u_ - 64) >> 5), (u_ - 64) & 31, (const float*)(ws + WS_KVTR), nullptr, (bf16*)(ws + WS_STR), lane);
                } else { PH_BEGIN(); LAS unsigned char* wlds = lds + RING_OFF + wave * 16384;
                    { const int g_ = gw >> 8, u_ = gw & 255; sb_unit_v1(((g_ * 8 + 4 + (u_ >> 6)) << 6) | (u_ & 63), SQ, SK, SV, OM, wlds, lane_now()); } }
            }
        }
        XCC_BAR();
#endif
        {
            PH_BEGIN(); const float *gla_norm_g = IN_PTR(9), *ret_norm_g = IN_PTR(10);
            LAS unsigned char* wlds = lds + RING_OFF + wave * 16384; (void)wlds;
#if MIX_GLA_V1
            for (int ch = gw; ch < 2048; ch += NGW) chunk_out_unit<32>(ch, GQ, GK, GV, GG, (const bf16*)(ws + WS_STG), gla_norm_g + l * 64, OM, 0, wlds, (LAS float*)(lds + LDSCTL_OFF + 4096 + wave * 256), lane_now());
#else
            if (wave == 0 && vcu < 32) seq_recurrent_v0<32, true>(GQ, GK, GV, GG, GA, gla_norm_g + l * 64, OM, vcu >> 2, vcu & 3, lane, 0);
#endif
#if MIX_RET_V1
            for (int ch = gw; ch < 2048; ch += NGW) chunk_out_unit<64>(ch, RQ, RK, RV, RG, (const bf16*)(ws + WS_STR), ret_norm_g + l * 64, OM, 256, wlds, (LAS float*)(lds + LDSCTL_OFF + 4096 + wave * 256), lane_now());
#else
            if (wave == 0 && vcu >= 32 && vcu < 64) seq_recurrent_v0<64, false>(RQ, RK, RV, RG, nullptr, ret_norm_g + l * 64, OM, (vcu - 32) >> 2, (vcu - 32) & 3, lane, 256);
#endif
#if !(MIX_SB_V1)
            for (int unit = gw; unit < 4096; unit += NGW) sb_unit_v0(SQ, SK, SV, OM, unit, lane);
#endif
        }
        XCC_BAR();
#if PROBE_ON && PROBE_DUP3C
        {
            PH_BEGIN(); const float *gla_norm_g = IN_PTR(9), *ret_norm_g = IN_PTR(10);
            LAS unsigned char* wlds = lds + RING_OFF + wave * 16384; (void)wlds;
#if MIX_GLA_V1
            for (int ch = gw; ch < 2048; ch += NGW) chunk_out_unit<32>(ch, GQ, GK, GV, GG, (const bf16*)(ws + WS_STG), gla_norm_g + l * 64, OM, 0, wlds, (LAS float*)(lds + LDSCTL_OFF + 4096 + wave * 256), lane_now());
#else
            if (wave == 0 && vcu < 32) seq_recurrent_v0<32, true>(GQ, GK, GV, GG, GA, gla_norm_g + l * 64, OM, vcu >> 2, vcu & 3, lane, 0);
#endif
#if MIX_RET_V1
            for (int ch = gw; ch < 2048; ch += NGW) chunk_out_unit<64>(ch, RQ, RK, RV, RG, (const bf16*)(ws + WS_STR), ret_norm_g + l * 64, OM, 256, wlds, (LAS float*)(lds + LDSCTL_OFF + 4096 + wave * 256), lane_now());
#else
            if (wave == 0 && vcu >= 32 && vcu < 64) seq_recurrent_v0<64, false>(RQ, RK, RV, RG, nullptr, ret_norm_g + l * 64, OM, (vcu - 32) >> 2, (vcu - 32) & 3, lane, 256);
#endif
#if !(MIX_SB_V1)
            for (int unit = gw; unit < 4096; unit += NGW) sb_unit_v0(SQ, SK, SV, OM, unit, lane);
#endif
        }
        GRID_BAR();
#endif
        {
            PH_BEGIN(); const float *norm2_g = IN_PTR(5); const float* MODB = MOD + ((size_t)l * 8 + (bxe & 7)) * MODLD;
            { LAS float* gl_ = (LAS float*)(lds + CBL_OFF); LAS float* al_ = gl_ + DM;
              for (int i = tid; i < DM / 4; i += NWAVES * 64) { *(LAS f32x4*)(gl_ + 4 * i) = *(const f32x4*)(MODB + 2 * DM + 4 * i);
                  *(LAS f32x4*)(al_ + 4 * i) = *(const f32x4*)(norm2_g + l * DM + 4 * i) * (*(const f32x4*)(MODB + 4 * DM + 4 * i) + 1.0f); }
              __syncthreads(); }
            pg8::Gemm g{OM, WOUT + (size_t)l * DM * DM, M, DM, DM}; pg8::StaticOrder S; S.init(M, DM, G, bxe);
            bf16* XR = (bf16*)out;
            pg8::EpiResid E{XR, XR, (LAS float*)(lds + CBL_OFF), (LAS float*)(lds + CBL_OFF) + DM, XA, SS + (size_t)(2 * l + 1) * M, 1};
            pg8::gemm_phase<pg8::EpiResid, pg8::StaticOrder, true, true>(lds + RING_OFF, g, S, E, tid);
        }
        XCC_BAR();
#if PROBE_ON && PROBE_NULLEPI
        if (l == 0) {
            PH_BEGIN();
            pg8::Gemm g{XA, WUP + (size_t)l * NUP * DM, M, NUP, DM}; pg8::StaticOrder S; S.init(M, NUP, G, bxe);
            pg8::EpiNull E{(float*)(ws + WS_OM)};
            pg8::gemm_phase<pg8::EpiNull, pg8::StaticOrder, true, true>(lds + RING_OFF, g, S, E, tid);
            GRID_BAR();
        }
#endif
        {
            PH_BEGIN();
            LAS float* cbl = (LAS float*)(lds + CBL_OFF); LAS float* rsl = (LAS float*)(lds + RSL_OFF);
            const int pm0_ = 16 * (bxe & 7) + ((bxe >> 3) & 7);
            const float* cbg = CBUP + ((size_t)l * 8 + (bxe & 7)) * NUP;
            for (int i = tid; i < NUP / 4; i += NWAVES * 64) *(LAS f32x4*)(cbl + 4 * i) = *(const f32x4*)(cbg + 4 * i);
            const int pm_ = pm0_ + 8 * __builtin_amdgcn_readfirstlane(tid >> 8); rsl[tid] = row_rstd(SS + (size_t)(2 * l + 1) * M, (size_t)pm_ * 256 + (tid & 255));
            __syncthreads();
        }
        {
            PH_BEGIN();
            pg8::Gemm g{XA, WUP + (size_t)l * NUP * DM, M, NUP, DM}; pg8::StaticOrder S; S.init(M, NUP, G, bxe);
            pg8::EpiFfnUp E{(LAS float*)(lds + CBL_OFF), (LAS float*)(lds + RSL_OFF), 16 * (bxe & 7) + ((bxe >> 3) & 7), HB};
            pg8::gemm_phase<pg8::EpiFfnUp, pg8::StaticOrder, true, true>(lds + RING_OFF, g, S, E, tid);
        }
        XCC_BAR();
        {
            PH_BEGIN(); const float *norm1_g = IN_PTR(4); const float* MODB = MOD + ((size_t)l * 8 + (bxe & 7)) * MODLD;
            const int nl = (l + 1 < DEPTH) ? l + 1 : l;
            { LAS float* gl_ = (LAS float*)(lds + CBL_OFF); LAS float* al_ = gl_ + DM; const float* MODN = MOD + ((size_t)nl * 8 + (bxe & 7)) * MODLD;
              for (int i = tid; i < DM / 4; i += NWAVES * 64) { *(LAS f32x4*)(gl_ + 4 * i) = *(const f32x4*)(MODB + 5 * DM + 4 * i);
                  *(LAS f32x4*)(al_ + 4 * i) = *(const f32x4*)(norm1_g + nl * DM + 4 * i) * (*(const f32x4*)(MODN + 1 * DM + 4 * i) + 1.0f); }
              __syncthreads(); }
            pg8::Gemm g{HB, WDN + (size_t)l * DM * DFF, M, DM, DFF, PBS - (size_t)SEQ * DFF * 2}; pg8::StaticOrder S; S.init(M, DM, G, bxe);
            bf16* XR = (bf16*)out;
            pg8::EpiResid E{XR, (l + 1 < DEPTH) ? XR : XA, (LAS float*)(lds + CBL_OFF), (LAS float*)(lds + CBL_OFF) + DM, XA, SS + (size_t)(2 * l + 2) * M, (l + 1 < DEPTH) ? 1 : 0};
            pg8::gemm_phase<pg8::EpiResid, pg8::StaticOrder, true, true>(lds + RING_OFF, g, S, E, tid);
        }
        if (l + 1 < DEPTH) XCC_BAR(); else GRID_BAR();
    }
    {
        PH_BEGIN(); const float* final_g = IN_PTR(15);
        const unsigned long long* ssf = SS + (size_t)(2 * DEPTH) * M;
        f32x4 fg[4];
#pragma unroll
        for (int j = 0; j < 4; ++j) fg[j] = *(const f32x4*)(final_g + j * 256 + lane * 4);
        unsigned long long wcur[4], qcur;
        const int mb = (gw >> 8) * SEQ + (gw & 255);
        { const GAS unsigned long long* xr = (const GAS unsigned long long*)(XA + (size_t)mb * DM) + lane; qcur = ssf[mb];
#pragma unroll
          for (int j = 0; j < 4; ++j) wcur[j] = xr[64 * j]; }
        asm volatile("" : "+v"(wcur[0]), "+v"(wcur[1]), "+v"(wcur[2]), "+v"(wcur[3]), "+v"(qcur), "+v"(fg[0]), "+v"(fg[1]), "+v"(fg[2]), "+v"(fg[3]));
        for (int k = 0; k < SEQ / 256; ++k) { const int m = mb + 256 * k;
            unsigned long long wnx[4], qnx = 0; const bool more = k + 1 < SEQ / 256;
            if (more) { const GAS unsigned long long* xn = (const GAS unsigned long long*)(XA + (size_t)(m + 256) * DM) + lane; qnx = ssf[m + 256];
#pragma unroll
                for (int j = 0; j < 4; ++j) wnx[j] = xn[64 * j]; }
            asm volatile("" ::: "memory");
            const float r = rstd_of(qcur);
            GAS f32x4* orow = (GAS f32x4*)(out + (size_t)m * DM) + lane;
#pragma unroll
            for (int j = 0; j < 4; ++j) { const unsigned long long w = wcur[j]; const unsigned lo = (unsigned)w, hi2 = (unsigned)(w >> 32);
                const f32x4 v = {__uint_as_float(lo << 16), __uint_as_float(lo & 0xffff0000u), __uint_as_float(hi2 << 16), __uint_as_float(hi2 & 0xffff0000u)};
                orow[64 * j] = v * r * fg[j]; }
            if (more) { qcur = qnx;
#pragma unroll
                for (int j = 0; j < 4; ++j) wcur[j] = wnx[j]; }
        }
    }

#if PROBE_ON
    STAMP();
    if (blockIdx.x == 0 && TID_NOW() == 0) {
        volatile LAS unsigned long long* st_ = (volatile LAS unsigned long long*)(lds + LDSCTL_OFF + 1024);
        const unsigned long long d1 = st_[PROBE_I1B] - st_[PROBE_I1A], d2 = st_[PROBE_I2B] - st_[PROBE_I2A];
        unsigned long long q1 = (d1 + 400) / 800, q2 = (d2 + 400) / 800; if (q1 > 63) q1 = 63; if (q2 > 63) q2 = 63;
        const unsigned long long spin = (q1 + 64 * q2) * 1200ull, t0_ = __builtin_amdgcn_s_memrealtime();
        while (__builtin_amdgcn_s_memrealtime() - t0_ < spin) __builtin_amdgcn_s_sleep(8);
    }
#endif
}

extern "C" void kernel_launch(void* const* d_in, const int* in_sizes, int n_in, void* d_out, int out_size, void* d_ws, size_t ws_size, hipStream_t stream) {
    static int grid = 0;
    if (grid == 0) {
        if (n_in != 16 || in_sizes[0] != M * DM || out_size != M * DM || ws_size < WS_END) { fprintf(stderr, "kernel_launch: unexpected shapes (n_in %d, in0 %d, out %d, ws %zu); nothing launched\n", n_in, n_in > 0 ? in_sizes[0] : -1, out_size, ws_size); grid = -1; return; }
        int dev = 0, cus = 0, per_cu = 0;
        if (hipGetDevice(&dev) != hipSuccess || hipDeviceGetAttribute(&cus, hipDeviceAttributeMultiprocessorCount, dev) != hipSuccess) { grid = -1; return; }
        if (hipFuncSetAttribute((const void*)mk_fwd, hipFuncAttributeMaxDynamicSharedMemorySize, LDS_BYTES) != hipSuccess) { fprintf(stderr, "kernel_launch: hipFuncSetAttribute failed\n"); grid = -1; return; }
        if (hipOccupancyMaxActiveBlocksPerMultiprocessor(&per_cu, (const void*)mk_fwd, NWAVES * 64, LDS_BYTES) != hipSuccess || per_cu < 1) fprintf(stderr, "kernel_launch: note: occupancy query reports %d\n", per_cu);
        (void)hipGetLastError();
        if (cus != 256) { fprintf(stderr, "kernel_launch: built for a 256-CU device, found %d CUs; nothing launched\n", cus); grid = -1; return; }
        grid = cus;
    }
    if (grid < 0) return;
    if (hipMemsetAsync((char*)d_ws + WS_CTL, 0, CTL_ZERO_BYTES, stream) != hipSuccess) { fprintf(stderr, "kernel_launch: memset failed\n"); return; }
    Args a{};
    for (int i = 0; i < 16; ++i) a.in[i] = (const float*)d_in[i];
    a.out = (float*)d_out; a.ws = (unsigned char*)d_ws; a.ph_lo = 0; a.ph_hi = 99;
    hipLaunchKernelGGL(mk_fwd, dim3(grid), dim3(NWAVES * 64), LDS_BYTES, stream, a);
}
```

```cpp
#include <hip/hip_runtime.h>
#include <cstdio>
#include <cstdint>
#define MIX_GLA_V1 1
#define MIX_RET_V1 1
#define MIX_SB_V1 1
#define PROBE_ON 0
constexpr int NWAVES = 8;
constexpr int BATCH = 8, SEQ = 4096, DM = 1024, M = BATCH * SEQ, DEPTH = 2;
constexpr int NIN = 3584, NIN_SRC = 3344, DFF = 2816, NUP = 5632, MODLD = 6144;
constexpr float SB_THR = -110.0f, SB_PMIN = 1.1754944e-38f;

constexpr size_t MiB = 1u << 20;
constexpr size_t WS_CTL = 0;
constexpr size_t WS_SS = 1 * MiB;
constexpr size_t WS_MOD = 2 * MiB + 512 * 1024;
constexpr size_t CTL_ZERO_BYTES = 2 * MiB + 512 * 1024;
constexpr size_t WS_CBIN = 3 * MiB;
constexpr size_t WS_CBUP = 3 * MiB + 512 * 1024;
constexpr size_t WS_ROT = 4 * MiB;
constexpr size_t WS_WIN = 8 * MiB;
constexpr size_t WS_WOUT = 22 * MiB;
constexpr size_t WS_WUP = 26 * MiB;
constexpr size_t WS_WDN = 48 * MiB;
constexpr size_t WS_XA = 64 * MiB;
constexpr size_t WS_OM = 128 * MiB;
constexpr size_t PBS = 26 * MiB;
constexpr size_t WS_GQ = 192 * MiB, WS_GK = 193 * MiB, WS_GV = 194 * MiB, WS_GG = 196 * MiB;
constexpr size_t WS_RQ = 198 * MiB, WS_RK = 200 * MiB, WS_RV = 202 * MiB, WS_RG = 204 * MiB;
constexpr size_t WS_SQ = 206 * MiB, WS_SK = 210 * MiB, WS_SV = 214 * MiB;
constexpr size_t WS_GR = 400 * MiB;
constexpr size_t WS_GA = 402 * MiB;
constexpr size_t WS_HB = 192 * MiB;
constexpr size_t WS_KVTG = 418 * MiB, WS_KVTR = 434 * MiB, WS_STG = 466 * MiB, WS_STR = 474 * MiB, WS_DEC = 490 * MiB;
constexpr size_t WS_END = 501 * MiB;
constexpr int CW_BAR = 4096;

constexpr int RING_OFF = 0, RING_BYTES = 131072;
constexpr int LDSCTL_OFF = RING_BYTES, MISC_OFF = LDSCTL_OFF + 320;
constexpr int LDS_BYTES = 163840;
constexpr int CBL_OFF = LDSCTL_OFF + 6144, RSL_OFF = CBL_OFF + 22528;

#if MIX_SB_V1
constexpr float SB_QSCALE = 0.125f * 1.4426950408889634f;
#else
constexpr float SB_QSCALE = 0.125f;
#endif
template <int OFF> __device__ __forceinline__ float shx(float v) {
    static_assert(OFF >= 1 && OFF < 32, "shx: OFF");
    return __builtin_bit_cast(float, __builtin_amdgcn_ds_swizzle(__builtin_bit_cast(int, v), (OFF << 10) | 0x1f));
}
__device__ __forceinline__ void swap32(float& a, float& b) { asm volatile("s_nop 1\n\tv_permlane32_swap_b32 %0, %1\n\ts_nop 1" : "+v"(a), "+v"(b)); }
__device__ __forceinline__ float add_x32(float v) {
    float a = v, b = v; swap32(a, b); return a + b;
}
__device__ __forceinline__ float get_x32(float v, int hi) {
    float a = v, b = v; swap32(a, b); return hi ? a : b;
}
__device__ __forceinline__ float sum32(float v) { v += shx<1>(v); v += shx<2>(v); v += shx<4>(v); v += shx<8>(v); v += shx<16>(v); return v; }
__device__ __forceinline__ unsigned long long ss_fix(float sq) { return (unsigned long long)(unsigned)(sq * 4096.0f) << 20; }
__device__ __forceinline__ float rstd_of(unsigned long long q) { const float s = (float)(unsigned)(q >> 20) * (1.0f / 4096.0f); return __builtin_amdgcn_rsqf(s * (1.0f / 1024.0f) + 1e-6f); }
__device__ __forceinline__ float row_rstd(const unsigned long long* ssq, size_t row) { const float s = (float)(unsigned)(ssq[row] >> 20) * (1.0f / 4096.0f); return __builtin_amdgcn_rsqf(s * (1.0f / 1024.0f) + 1e-6f); }
namespace pg8 {
#define PG8_LAS __attribute__((address_space(3)))
typedef unsigned short bf16_t;
typedef short bf16x8 __attribute__((ext_vector_type(8)));
typedef float f32x4 __attribute__((ext_vector_type(4)));
typedef unsigned u32x4 __attribute__((ext_vector_type(4)));
constexpr int BM = 256, BK = 64, HALF = 128, HTB = HALF * BK * 2  , STAGE_BYTES = 8 * HTB, NXCD = 8, WGM = 8;

__host__ __device__ __forceinline__ int lds_byte(int r, int c) { const int st = (r >> 4) * 2 + (c >> 5), rr = r & 15, cc = c & 31, ob = rr * 64 + cc * 2; return st * 1024 + (ob ^ (((ob >> 9) & 1) << 5)); }
__host__ __device__ __forceinline__ void stage_rc(int b, int& R, int& C) { const int st = b / 1024, sb = b % 1024, swz = sb ^ (((sb >> 9) & 1) << 5); R = (st >> 1) * 16 + swz / 64; C = (st & 1) * 32 + (swz % 64) / 2; }
__host__ __device__ __forceinline__ int perm32(int rho) { const int n = rho >> 4, i = rho & 15; return 8 * (i >> 2) + 4 * n + (i & 3); }

struct Unit { int pm, pn; };
struct Gemm { const bf16_t* A; const bf16_t* Bt; int M, N, K; size_t abx = 0; };

struct StaticOrder {
    int nM, nN, nwg, G, c;
    __host__ __device__ void init(int M, int N, int G_, int c_) { nM = M / BM; nN = N / BM; nwg = nM * nN; G = G_; c = c_; }
    __host__ __device__ bool next(int i, Unit& u) const {
        const long L = (long)i * G + c; if (L >= nwg) return false;
        int wgid = (int)L; { const int q = nwg / NXCD, r = nwg % NXCD, xcd = wgid % NXCD, off = wgid / NXCD; wgid = (xcd < r ? xcd * (q + 1) : r * (q + 1) + (xcd - r) * q) + off; }
        const int nig = WGM * nN, gid = wgid / nig, fm = gid * WGM, gsz = (nM - fm) < WGM ? (nM - fm) : WGM;
        u.pm = fm + ((wgid % nig) % gsz); u.pn = (wgid % nig) / gsz; return true;
    }
    __device__ __forceinline__ void a_ready(const Unit&) const {}
    __device__ __forceinline__ void done(const Unit&) const {}
};

typedef float cvt_f32x2_t __attribute__((ext_vector_type(2))); typedef __bf16 cvt_bf16x2_t __attribute__((ext_vector_type(2)));
__device__ __forceinline__ unsigned cvt_pk_bf16(float lo, float hi) { const cvt_f32x2_t v = {lo, hi}; const cvt_bf16x2_t b = __builtin_convertvector(v, cvt_bf16x2_t); return __builtin_bit_cast(unsigned, b); }
constexpr int NIN = ::NIN, NUP = ::NUP, DFFC = ::DFF, DMC = ::DM, MODLD = ::MODLD;
__device__ __forceinline__ float silu_f(float a) { return a * __builtin_amdgcn_rcpf(1.0f + __expf(-a)); }
__device__ __forceinline__ u32x4 pack8(const f32x4 v0, const f32x4 v1) { u32x4 w; w.x = cvt_pk_bf16(v0[0], v0[1]); w.y = cvt_pk_bf16(v0[2], v0[3]); w.z = cvt_pk_bf16(v1[0], v1[1]); w.w = cvt_pk_bf16(v1[2], v1[3]); return w; }

__device__ __forceinline__ void load_rstd8(const unsigned long long* sp, float (&rs)[2][4]) {
    unsigned long long raw[8];
    asm volatile("global_load_dwordx2 %0, %1, off" : "=v"(raw[0]) : "v"(sp));
    asm volatile("global_load_dwordx2 %0, %1, off offset:128" : "=v"(raw[1]) : "v"(sp));
    asm volatile("global_load_dwordx2 %0, %1, off offset:256" : "=v"(raw[2]) : "v"(sp));
    asm volatile("global_load_dwordx2 %0, %1, off offset:384" : "=v"(raw[3]) : "v"(sp));
    asm volatile("global_load_dwordx2 %0, %1, off offset:1024" : "=v"(raw[4]) : "v"(sp));
    asm volatile("global_load_dwordx2 %0, %1, off offset:1152" : "=v"(raw[5]) : "v"(sp));
    asm volatile("global_load_dwordx2 %0, %1, off offset:1280" : "=v"(raw[6]) : "v"(sp));
    asm volatile("global_load_dwordx2 %0, %1, off offset:1408" : "=v"(raw[7]) : "v"(sp));
    asm volatile("s_waitcnt vmcnt(0)" : "+v"(raw[0]), "+v"(raw[1]), "+v"(raw[2]), "+v"(raw[3]), "+v"(raw[4]), "+v"(raw[5]), "+v"(raw[6]), "+v"(raw[7]) :: "memory");
#pragma unroll
    for (int i = 0; i < 8; ++i) rs[i >> 2][i & 3] = rstd_of(raw[i]);
}

struct EpiInProj {
    static constexpr bool PERM = true, AFTER_DRAIN = false;
    const PG8_LAS float* cbl; const PG8_LAS float* rsl; int pm0; const float* rot; unsigned char* ws;
    template <bool ROT>
    __device__ __forceinline__ void tile(const f32x4 (&acc)[2][2][4][2], const float (&rs)[2][4], const f32x4 (&c0)[2], const f32x4 (&c1)[2], int pn, int row0, int cl, int bq) const {
        int clq = cl; asm volatile("" : "+v"(clq));
        const int i0 = (clq & 63) >> 1;
#pragma unroll
        for (int ai = 0; ai < 2; ++ai) {
            f32x4 t0[4], t1[4];
            if constexpr (ROT) {
#pragma unroll
                for (int m = 0; m < 4; ++m) { const int pos = (row0 + ai * HALF + m * 16) & 4095; t0[m] = *(const f32x4*)(rot + ((size_t)pos * 32 + i0) * 2); t1[m] = *(const f32x4*)(rot + ((size_t)pos * 32 + i0 + 2) * 2); }
                asm volatile("" ::: "memory");
            }
#pragma unroll
            for (int bj = 0; bj < 2; ++bj) {
                unsigned long long off; int ldl, colb = bj * HALF; float sc = 1.0f;
                if (ROT) { ldl = 8; if (pn == 3) { off = WS_RQ; } else { off = WS_RK; sc = 0.125f; } }
                else if (pn == 0) { ldl = 7; colb = 0; if (bj == 0) { off = WS_GQ; sc = 0.17677669529663687f; } else { off = WS_GK; } }
                else if (pn == 1) { off = WS_GV; ldl = 8; }
                else if (pn == 2) { off = WS_GG; ldl = 8; }
                else if (pn == 5) { off = WS_RV; ldl = 8; }
                else if (pn == 6) { off = WS_RG; ldl = 8; }
                else if (pn <= 8) { off = WS_SQ; ldl = 9; colb += (pn - 7) * BM; sc = SB_QSCALE; }
                else if (pn <= 10) { off = WS_SK; ldl = 9; colb += (pn - 9) * BM; }
                else { off = WS_SV; ldl = 9; colb += (pn - 11) * BM; }
                off = ((unsigned long long)__builtin_amdgcn_readfirstlane((unsigned)(off >> 20))) << 20; ldl = __builtin_amdgcn_readfirstlane(ldl); colb = __builtin_amdgcn_readfirstlane(colb);
                asm volatile("" : "+s"(off), "+s"(ldl), "+s"(colb));
                unsigned char* dstb = ws + off + (size_t)bq * (::PBS - ((size_t)4096 << (ldl + 1)));
#pragma unroll
                for (int m = 0; m < 4; ++m) { const int row = row0 + ai * HALF + m * 16; const float r = rs[ai][m];
                    f32x4 v0 = acc[ai][bj][m][0] * r + c0[bj], v1 = acc[ai][bj][m][1] * r + c1[bj];
                    if constexpr (ROT) {
                        const f32x4 w0 = {v0[0] * t0[m][0] - v0[1] * t0[m][1], v0[0] * t0[m][1] + v0[1] * t0[m][0], v0[2] * t0[m][2] - v0[3] * t0[m][3], v0[2] * t0[m][3] + v0[3] * t0[m][2]};
                        const f32x4 w1 = {v1[0] * t1[m][0] - v1[1] * t1[m][1], v1[0] * t1[m][1] + v1[1] * t1[m][0], v1[2] * t1[m][2] - v1[3] * t1[m][3], v1[2] * t1[m][3] + v1[3] * t1[m][2]};
                        v0 = w0; v1 = w1; }
                    v0 = v0 * sc; v1 = v1 * sc;
                    *(u32x4*)(dstb + ((((size_t)row << ldl) + (size_t)(colb + cl)) << 1)) = pack8(v0, v1); } }
        }
    }
    __device__ __forceinline__ void operator()(const f32x4 (&acc)[2][2][4][2], const Unit& u, int wr, int wc, int fr, int fq) const {
        const int pn = u.pn, b = u.pm >> 4;
        const int row0 = u.pm * BM + wr * 64 + fr; const int cl = wc * 32 + 8 * fq;
        f32x4 c0[2], c1[2];
#pragma unroll
        for (int bj = 0; bj < 2; ++bj) { const PG8_LAS float* cbp = cbl + pn * BM + bj * HALF + cl; c0[bj] = *(const PG8_LAS f32x4*)(cbp); c1[bj] = *(const PG8_LAS f32x4*)(cbp + 4); }
        float rs[2][4];
        { const PG8_LAS float* rp = rsl + (u.pm == pm0 ? 0 : 256) + wr * 64 + fr;
#pragma unroll
          for (int ai = 0; ai < 2; ++ai)
#pragma unroll
              for (int m = 0; m < 4; ++m) rs[ai][m] = rp[ai * HALF + m * 16]; }
        int kind = (pn == 3 || pn == 4) ? 1 : (pn == 13 ? 2 : 0);
        kind = __builtin_amdgcn_readfirstlane(kind); asm volatile("" : "+s"(kind));
        if (kind == 2) {
            int clg = cl; unsigned long long goff = WS_GR; asm volatile("" : "+v"(clg), "+s"(goff));
            if (clg < 16) { float* gbase = (float*)(ws + goff);
#pragma unroll
                for (int ai = 0; ai < 2; ++ai)
#pragma unroll
                    for (int m = 0; m < 4; ++m) { const int row = row0 + ai * HALF + m * 16; const float r = rs[ai][m]; float* gp = gbase + (size_t)row * 16 + clg;
                        *(f32x4*)(gp) = acc[ai][0][m][0] * r + c0[0]; *(f32x4*)(gp + 4) = acc[ai][0][m][1] * r + c1[0]; } }
        } else if (kind == 1) { tile<true>(acc, rs, c0, c1, pn, row0, cl, b); }
        else { tile<false>(acc, rs, c0, c1, pn, row0, cl, b); }
    }
};

struct EpiResid {
    static constexpr bool PERM = true, AFTER_DRAIN = false;
    const bf16_t* xin; bf16_t* xout;
    const PG8_LAS float* gl; const PG8_LAS float* al;
    bf16_t* xa; unsigned long long* ssn; int write_xa;
    __device__ __forceinline__ void operator()(const f32x4 (&acc)[2][2][4][2], const Unit& u, int wr, int wc, int fr, int fq) const {
        const int row0 = u.pm * BM + wr * 64 + fr;
        const int colb = u.pn * BM + wc * 32 + 8 * fq;
        unsigned voff = (unsigned)(((size_t)row0 * DMC + colb) * 2); asm volatile("" : "+v"(voff));
#define RES_CO(ai, bj, m) ((size_t)(((ai) * HALF + (m) * 16) * DMC + (bj) * HALF) * 2)
#define RES_LD(ai, bj, buf) { _Pragma("unroll") for (int m = 0; m < 4; ++m) xr[buf][m] = *(const u32x4*)((const char*)xin + RES_CO(ai, bj, m) + voff); }
        u32x4 xr[2][4]; f32x4 g0, g1, a0, a1;
        RES_LD(0, 0, 0) RES_LD(1, 0, 1)
        asm volatile("" ::: "memory");
        float sq[2][4] = {{0.f, 0.f, 0.f, 0.f}, {0.f, 0.f, 0.f, 0.f}};
#pragma unroll
        for (int q = 0; q < 4; ++q) {
            const int bj = q >> 1, ai = q & 1, buf = q & 1;
            if (ai == 0) { const int col = colb + bj * HALF;
                g0 = *(const PG8_LAS f32x4*)(gl + col); g1 = *(const PG8_LAS f32x4*)(gl + col + 4); a0 = *(const PG8_LAS f32x4*)(al + col); a1 = *(const PG8_LAS f32x4*)(al + col + 4); }
#pragma unroll
            for (int m = 0; m < 4; ++m) { const u32x4 w = xr[buf][m];
                const f32x4 x0 = {__uint_as_float(w.x << 16), __uint_as_float(w.x & 0xffff0000u), __uint_as_float(w.y << 16), __uint_as_float(w.y & 0xffff0000u)};
                const f32x4 x1 = {__uint_as_float(w.z << 16), __uint_as_float(w.z & 0xffff0000u), __uint_as_float(w.w << 16), __uint_as_float(w.w & 0xffff0000u)};
                const f32x4 y0 = x0 + g0 * acc[ai][bj][m][0], y1 = x1 + g1 * acc[ai][bj][m][1];
                *(u32x4*)((char*)xout + RES_CO(ai, bj, m) + voff) = pack8(y0, y1);
                sq[ai][m] += (y0[0] * y0[0] + y0[1] * y0[1]) + (y0[2] * y0[2] + y0[3] * y0[3]) + (y1[0] * y1[0] + y1[1] * y1[1]) + (y1[2] * y1[2] + y1[3] * y1[3]);
                if (write_xa) *(u32x4*)((char*)xa + RES_CO(ai, bj, m) + voff) = pack8(y0 * a0, y1 * a1); }
            asm volatile("" ::: "memory");
            if (q == 0) RES_LD(0, 1, 0)
            if (q == 1) RES_LD(1, 1, 1)
            asm volatile("" ::: "memory");
            if (bj == 1) {
#pragma unroll
                for (int m = 0; m < 4; ++m) { float s2 = sq[ai][m]; s2 += shx<16>(s2); s2 = add_x32(s2);
                    if (fq == 0) __hip_atomic_fetch_add(ssn + (row0 + ai * HALF + m * 16), ss_fix(s2), __ATOMIC_RELAXED, __HIP_MEMORY_SCOPE_AGENT); }
            }
        }
#undef RES_LD
#undef RES_CO
    }
};

struct EpiFfnUp {
    static constexpr bool PERM = true, AFTER_DRAIN = false;
    const PG8_LAS float* cbl; const PG8_LAS float* rsl; int pm0; bf16_t* hb;
    __device__ __forceinline__ void operator()(const f32x4 (&acc)[2][2][4][2], const Unit& u, int wr, int wc, int fr, int fq) const {
        const int b = u.pm >> 4; const int row0 = u.pm * BM + wr * 64 + fr; const int cw = wc * 32 + 8 * fq;
        const PG8_LAS float* cbp = cbl + u.pn * BM + cw;
        const f32x4 cg0 = *(const PG8_LAS f32x4*)(cbp), cg1 = *(const PG8_LAS f32x4*)(cbp + 4), cu0 = *(const PG8_LAS f32x4*)(cbp + HALF), cu1 = *(const PG8_LAS f32x4*)(cbp + HALF + 4);
        float rs[2][4];
        { const PG8_LAS float* rp = rsl + (u.pm == pm0 ? 0 : 256) + wr * 64 + fr;
#pragma unroll
          for (int ai = 0; ai < 2; ++ai)
#pragma unroll
              for (int m = 0; m < 4; ++m) rs[ai][m] = rp[ai * HALF + m * 16]; }
#pragma unroll
        for (int ai = 0; ai < 2; ++ai)
#pragma unroll
            for (int m = 0; m < 4; ++m) { const int row = row0 + ai * HALF + m * 16;
                const float r = rs[ai][m];
                const f32x4 g0 = acc[ai][0][m][0] * r + cg0, g1 = acc[ai][0][m][1] * r + cg1, u0 = acc[ai][1][m][0] * r + cu0, u1 = acc[ai][1][m][1] * r + cu1;
                f32x4 h0, h1;
#pragma unroll
                for (int e = 0; e < 4; ++e) { h0[e] = silu_f(g0[e]) * u0[e]; h1[e] = silu_f(g1[e]) * u1[e]; }
                *(u32x4*)(hb + (size_t)b * ((::PBS - (size_t)4096 * DFFC * 2) / 2) + (size_t)row * DFFC + u.pn * HALF + cw) = pack8(h0, h1); }
    }
};

struct EpiNull {
    static constexpr bool PERM = true, AFTER_DRAIN = false;
    float* sink;
    __device__ __forceinline__ void operator()(const f32x4 (&acc)[2][2][4][2], const Unit& u, int wr, int wc, int fr, int fq) const {
        f32x4 s = (f32x4){0.f, 0.f, 0.f, 0.f};
#pragma unroll
        for (int ai = 0; ai < 2; ++ai)
#pragma unroll
            for (int bj = 0; bj < 2; ++bj)
#pragma unroll
                for (int m = 0; m < 4; ++m)
#pragma unroll
                    for (int n = 0; n < 2; ++n) s += acc[ai][bj][m][n];
        sink[(size_t)(u.pm * 32 + u.pn) * 512 + (wr * 4 + wc) * 64 + fq * 16 + fr] = (s[0] + s[1]) + (s[2] + s[3]);
    }
};
template <class Epi, class Sched, bool ALIGN_EPI = false, bool SP2 = false>
__device__ __forceinline__ void gemm_phase(PG8_LAS unsigned char* lds, const Gemm g, const Sched& S, const Epi& E, int tid) {
    asm volatile("" : "+v"(tid));
    const int wid = __builtin_amdgcn_readfirstlane(tid >> 6), lane = tid & 63, wr = wid >> 2, wc = wid & 3, fr = lane & 15, fq = lane >> 4;
    const int K = g.K, nt = K / BK;
    unsigned voffA[2], voffB[2];
#pragma unroll
    for (int i = 0; i < 2; ++i) { int R, C; stage_rc(tid * 16 + i * 8192, R, C); const int Rb = Epi::PERM ? ((R & ~31) + perm32(R & 31)) : R;
        voffA[i] = (unsigned)(R * K + C) * 2u; voffB[i] = (unsigned)(Rb * K + C) * 2u; }
    const size_t kstep = (size_t)(BK * 2);
    const size_t hstep = (size_t)HALF * K * 2;
    const size_t tstep = 2 * hstep;
    const unsigned ldsw = (unsigned)wid * 1024u;
    const int aoff = lds_byte(wr * 64 + fr, fq * 8), boff = lds_byte(wc * 32 + fr, fq * 8);
#define PG8_SA(b, h) (((b) * 2 + (h)) * HTB)
#define PG8_SB(b, h) ((4 + (b) * 2 + (h)) * HTB)
#define PG8_STAGE(bufoff, gbase, voff) do { _Pragma("unroll") for (int _i = 0; _i < 2; ++_i) \
        __builtin_amdgcn_global_load_lds((const unsigned*)((const char*)(gbase) + (voff)[_i]), (PG8_LAS unsigned*)(lds + (bufoff) + ldsw + _i * 8192), 16, 0, 0); } while (0)
#define PG8_LDA(dst, b, h) do { _Pragma("unroll") for (int m = 0; m < 4; ++m) _Pragma("unroll") for (int k = 0; k < 2; ++k) dst[m][k] = *(const PG8_LAS bf16x8*)(lds + PG8_SA(b, h) + aoff + m * 2048 + k * 1024); } while (0)
#define PG8_LDB(dst, b, h) do { _Pragma("unroll") for (int n = 0; n < 2; ++n) _Pragma("unroll") for (int k = 0; k < 2; ++k) dst[n][k] = *(const PG8_LAS bf16x8*)(lds + PG8_SB(b, h) + boff + n * 2048 + k * 1024); } while (0)
#define PG8_MMA(ai, bj, At, Bt) do { __builtin_amdgcn_s_setprio(1); _Pragma("unroll") for (int m = 0; m < 4; ++m) _Pragma("unroll") for (int n = 0; n < 2; ++n) _Pragma("unroll") for (int k = 0; k < 2; ++k) \
        acc[ai][bj][m][n] = __builtin_amdgcn_mfma_f32_16x16x32_bf16(Bt[n][k], At[m][k], acc[ai][bj][m][n], 0, 0, 0); __builtin_amdgcn_s_setprio(0); } while (0)
#define PG8_WAIT_V(n) asm volatile("s_waitcnt vmcnt(" #n ")" ::: "memory")
#define PG8_WAIT_L(n) asm volatile("s_waitcnt lgkmcnt(" #n ")" ::: "memory")
#define PG8_BAR __builtin_amdgcn_s_barrier()
#define PG8_SCHED __builtin_amdgcn_sched_barrier(0)
    Unit cur, nxt; int ui = 0;
    if (!S.next(0, cur)) return;
    f32x4 acc[2][2][4][2];
#pragma unroll
    for (int a = 0; a < 2; ++a)
#pragma unroll
        for (int b = 0; b < 2; ++b)
#pragma unroll
            for (int m = 0; m < 4; ++m)
#pragma unroll
                for (int n = 0; n < 2; ++n) acc[a][b][m][n] = (f32x4){0.f, 0.f, 0.f, 0.f};
    bf16x8 At[4][2], B0[2][2], B1[2][2];
    const char* cA = (const char*)g.A + (size_t)cur.pm * tstep + (size_t)(cur.pm >> 4) * g.abx; const char* cB = (const char*)g.Bt + (size_t)cur.pn * tstep;
    S.a_ready(cur);
    if constexpr (SP2) {
        PG8_STAGE(PG8_SB(0, 0), cB, voffB); PG8_STAGE(PG8_SB(0, 1), cB + hstep, voffB); PG8_STAGE(PG8_SA(0, 0), cA, voffA); PG8_STAGE(PG8_SA(0, 1), cA + hstep, voffA);
        if (wr == 1) PG8_BAR;
        PG8_WAIT_V(2); PG8_BAR;
        PG8_STAGE(PG8_SB(1, 0), cB + kstep, voffB); PG8_STAGE(PG8_SA(1, 0), cA + kstep, voffA); PG8_STAGE(PG8_SB(1, 1), cB + hstep + kstep, voffB);
        PG8_WAIT_V(6); PG8_BAR;
    } else {
        PG8_STAGE(PG8_SB(0, 0), cB, voffB); PG8_STAGE(PG8_SA(0, 0), cA, voffA); PG8_STAGE(PG8_SB(0, 1), cB + hstep, voffB); PG8_STAGE(PG8_SA(0, 1), cA + hstep, voffA);
        if (wr == 1) PG8_BAR;
        PG8_WAIT_V(4); PG8_BAR;
        PG8_STAGE(PG8_SB(1, 0), cB + kstep, voffB); PG8_STAGE(PG8_SA(1, 0), cA + kstep, voffA); PG8_STAGE(PG8_SB(1, 1), cB + hstep + kstep, voffB);
        PG8_WAIT_V(6); PG8_BAR;
    }
    for (;;) {
        const bool has_next = S.next(ui + 1, nxt);
        const char* nA = has_next ? (const char*)g.A + (size_t)nxt.pm * tstep + (size_t)(nxt.pm >> 4) * g.abx : cA; const char* nB = has_next ? (const char*)g.Bt + (size_t)nxt.pn * tstep : cB;
        for (int t = 0; t < nt; t += 2) {
            const bool last = (t == nt - 2);
            const char* a1 = cA + (size_t)(t + 1) * kstep;
            const char* a2 = last ? nA : cA + (size_t)(t + 2) * kstep; const char* b2 = last ? nB : cB + (size_t)(t + 2) * kstep;
            const char* a3 = a2 + kstep; const char* b3 = b2 + kstep;
            if (last && has_next) S.a_ready(nxt);
            if constexpr (SP2) {
            PG8_LDB(B0, 0, 0); PG8_LDB(B1, 0, 1); PG8_SCHED; PG8_LDA(At, 0, 0); PG8_STAGE(PG8_SA(1, 1), a1 + hstep, voffA);
            PG8_WAIT_V(8); PG8_WAIT_L(0); PG8_BAR; PG8_MMA(0, 0, At, B0); PG8_MMA(0, 1, At, B1); PG8_BAR; PG8_SCHED;
            PG8_LDA(At, 0, 1); PG8_STAGE(PG8_SB(0, 0), b2, voffB); PG8_STAGE(PG8_SB(0, 1), b2 + hstep, voffB); PG8_STAGE(PG8_SA(0, 0), a2, voffA);
            PG8_WAIT_V(8); PG8_WAIT_L(0); PG8_BAR; PG8_MMA(1, 0, At, B0); PG8_MMA(1, 1, At, B1); PG8_BAR; PG8_SCHED;
            PG8_LDB(B0, 1, 0); PG8_LDB(B1, 1, 1); PG8_SCHED; PG8_LDA(At, 1, 0); PG8_STAGE(PG8_SA(0, 1), a2 + hstep, voffA);
            PG8_WAIT_V(8); PG8_WAIT_L(0); PG8_BAR; PG8_MMA(0, 0, At, B0); PG8_MMA(0, 1, At, B1); PG8_BAR; PG8_SCHED;
            PG8_LDA(At, 1, 1); PG8_STAGE(PG8_SB(1, 0), b3, voffB); PG8_STAGE(PG8_SB(1, 1), b3 + hstep, voffB); PG8_STAGE(PG8_SA(1, 0), a3, voffA);
            PG8_WAIT_V(8); PG8_WAIT_L(0); PG8_BAR; PG8_MMA(1, 0, At, B0); PG8_MMA(1, 1, At, B1); PG8_BAR; PG8_SCHED;
            } else {
            PG8_LDB(B0, 0, 0); PG8_SCHED; PG8_LDA(At, 0, 0); PG8_STAGE(PG8_SA(1, 1), a1 + hstep, voffA);
            PG8_WAIT_L(8); PG8_BAR; PG8_WAIT_L(0); PG8_MMA(0, 0, At, B0); PG8_BAR; PG8_SCHED;
            PG8_LDB(B1, 0, 1); PG8_STAGE(PG8_SB(0, 0), b2, voffB);
            PG8_BAR; PG8_WAIT_L(0); PG8_MMA(0, 1, At, B1); PG8_BAR;
            PG8_LDA(At, 0, 1); PG8_STAGE(PG8_SA(0, 0), a2, voffA);
            PG8_BAR; PG8_WAIT_L(0); PG8_MMA(1, 0, At, B0); PG8_BAR; PG8_SCHED;
            PG8_STAGE(PG8_SB(0, 1), b2 + hstep, voffB);
            PG8_WAIT_V(6); PG8_BAR; PG8_MMA(1, 1, At, B1); PG8_BAR;
            PG8_LDB(B0, 1, 0); PG8_SCHED; PG8_LDA(At, 1, 0); PG8_STAGE(PG8_SA(0, 1), a2 + hstep, voffA);
            PG8_WAIT_L(8); PG8_BAR; PG8_WAIT_L(0); PG8_MMA(0, 0, At, B0); PG8_BAR; PG8_SCHED;
            PG8_LDB(B1, 1, 1); PG8_STAGE(PG8_SB(1, 0), b3, voffB);
            PG8_BAR; PG8_WAIT_L(0); PG8_MMA(0, 1, At, B1); PG8_BAR;
            PG8_LDA(At, 1, 1); PG8_STAGE(PG8_SA(1, 0), a3, voffA);
            PG8_BAR; PG8_WAIT_L(0); PG8_MMA(1, 0, At, B0); PG8_BAR; PG8_SCHED;
            PG8_STAGE(PG8_SB(1, 1), b3 + hstep, voffB);
            PG8_WAIT_V(6); PG8_BAR; PG8_MMA(1, 1, At, B1); PG8_BAR;
            }
        }
        if constexpr (ALIGN_EPI) { if (wr == 0) PG8_BAR; }
        if constexpr (!Epi::AFTER_DRAIN) { E(acc, cur, wr, wc, fr, fq); S.done(cur); }
        if (!has_next) break;
#pragma unroll
        for (int a = 0; a < 2; ++a)
#pragma unroll
            for (int b = 0; b < 2; ++b)
#pragma unroll
                for (int m = 0; m < 4; ++m)
#pragma unroll
                    for (int n = 0; n < 2; ++n) acc[a][b][m][n] = (f32x4){0.f, 0.f, 0.f, 0.f};
        cur = nxt; cA = nA; cB = nB; ++ui;
        if constexpr (ALIGN_EPI) { if (wr == 1) PG8_BAR; }
    }
    PG8_WAIT_V(0);
    if constexpr (!ALIGN_EPI) { if (wr == 0) PG8_BAR; }
    PG8_BAR;
    if constexpr (Epi::AFTER_DRAIN) { E.fused(acc, cur, wr, wc, fr, fq, lds, wid, lane); S.done(cur); }
#undef PG8_SA
#undef PG8_SB
#undef PG8_STAGE
#undef PG8_LDA
#undef PG8_LDB
#undef PG8_MMA
#undef PG8_WAIT_V
#undef PG8_WAIT_L
#undef PG8_BAR
#undef PG8_SCHED
}
}
#define GAS __attribute__((address_space(1)))
#define LAS __attribute__((address_space(3)))
typedef unsigned short bf16;
typedef unsigned v4u __attribute__((ext_vector_type(4)));
typedef float f32x4 __attribute__((ext_vector_type(4)));
typedef short bf16x8 __attribute__((ext_vector_type(8)));
typedef GAS unsigned gu32;
typedef GAS unsigned long long gu64;
#define RLX_AGENT __ATOMIC_RELAXED, __HIP_MEMORY_SCOPE_AGENT
#define LDS_WAIT() asm volatile("s_waitcnt lgkmcnt(0)" ::: "memory")
#define VM_WAIT() asm volatile("s_waitcnt vmcnt(0)" ::: "memory")
__device__ __forceinline__ unsigned long long rt() { return __builtin_amdgcn_s_memrealtime(); }
__device__ __forceinline__ unsigned f2bf(float f) { unsigned u = __builtin_bit_cast(unsigned, f); return (u + 0x7fffu + ((u >> 16) & 1u)) >> 16; }
__device__ __forceinline__ unsigned pk2(float lo, float hi) { return f2bf(lo) | (f2bf(hi) << 16); }
#define XB_TMO      128
#define XB_XCNT(j)  (256  + 64 * (j))
#define XB_XSUB(j)  (1280 + 64 * (j))
#define XB_XGEN(j)  (2304 + 64 * (j))
#define XB_TOP      3328
#define XB_TOPGEN   3392
#define XCD_BAR_WORDS 3456
#define XB_SPIN_CAP (1u << 18)

__device__ __forceinline__ unsigned xb_ld(unsigned* p)              { return __hip_atomic_load(p, __ATOMIC_RELAXED, __HIP_MEMORY_SCOPE_AGENT); }
__device__ __forceinline__ unsigned xb_add(unsigned* p, unsigned v) { return __hip_atomic_fetch_add(p, v, __ATOMIC_RELAXED, __HIP_MEMORY_SCOPE_AGENT); }
__device__ __forceinline__ unsigned xb_xcc_id() { return (unsigned)__builtin_amdgcn_s_getreg((3 << 11) | 20) & 0xFu; }
#define XB_SPIN(cond, bar) do { unsigned _sp = 0; while (cond) { __builtin_amdgcn_s_sleep(1); \
    if ((++_sp & 255u) == 0u) { if (xb_ld(&(bar)[XB_TMO])) break; if (_sp > XB_SPIN_CAP) { atomicAdd(&(bar)[XB_TMO], 1u); break; } } } } while (0)

struct XcdBarrier {
    unsigned* bar; unsigned x; int tid;
    volatile LAS unsigned* st;
};

__device__ __forceinline__ XcdBarrier xcd_barrier_post(unsigned* bar, volatile LAS unsigned* st) {
    XcdBarrier b; b.bar = bar; b.x = xb_xcc_id(); b.st = st; b.tid = (int)threadIdx.x;
    if (threadIdx.x == 0) st[2] = xb_add(&bar[XB_XCNT(b.x)], 1u);
    return b;
}
__device__ __forceinline__ void xcd_barrier_complete(unsigned* bar, unsigned x, unsigned& nloc, unsigned& nx, unsigned& uni) {
    const unsigned G = gridDim.x * gridDim.y * gridDim.z;
    unsigned sum, cnt, mine, n32, sp = 0u;
    for (;;) {
        sum = 0u; cnt = 0u; mine = 0u; n32 = 0u;
#pragma unroll
        for (unsigned j = 0; j < 16; ++j) { const unsigned c = xb_ld(&bar[XB_XCNT(j)]); sum += c; cnt += (c > 0u) ? 1u : 0u; mine = (j == x) ? c : mine; n32 += (j < 8u && c == 32u) ? 1u : 0u; }
        if (sum == G) break;
        __builtin_amdgcn_s_sleep(1);
        if ((++sp & 255u) == 0u) { if (xb_ld(&bar[XB_TMO])) break; if (sp > XB_SPIN_CAP) { atomicAdd(&bar[XB_TMO], 1u); break; } }
    }
    nloc = mine > 0u ? mine : 1u; nx = cnt > 0u ? cnt : 1u;
    uni = (sum == G && G == 256u && n32 == 8u) ? 1u : 2u;
}

__device__ __forceinline__ void xcd_barrier(const XcdBarrier& b, int local_only = 0) {
    asm volatile("s_waitcnt vmcnt(0)" ::: "memory");
    __syncthreads();
    if (b.tid == 0) {
        unsigned* bar = b.bar;
        __builtin_amdgcn_s_waitcnt(0);
        unsigned nloc = b.st[0], nx = b.st[1];
        if (nloc == 0u) { unsigned uni; xcd_barrier_complete(bar, b.x, nloc, nx, uni); b.st[0] = nloc; b.st[1] = nx; b.st[3] = uni; }
        const unsigned old = xb_add(&bar[XB_XSUB(b.x)], 1u);
        const unsigned gen = old / nloc;
        if (old + 1u == (gen + 1u) * nloc) {
            if (!local_only) {
            __builtin_amdgcn_fence(__ATOMIC_RELEASE, "agent");
            asm volatile("s_waitcnt vmcnt(0)" ::: "memory");
            const unsigned og = xb_add(&bar[XB_TOP], 1u);
            const unsigned tg = og / nx;
            if (og + 1u == (tg + 1u) * nx) xb_add(&bar[XB_TOPGEN], 1u);
            else XB_SPIN(xb_ld(&bar[XB_TOPGEN]) == tg, bar);
            }
            __builtin_amdgcn_fence(__ATOMIC_ACQUIRE, "agent");
            xb_add(&bar[XB_XGEN(b.x)], 1u);
            asm volatile("s_waitcnt vmcnt(0)" ::: "memory");
        } else {
            XB_SPIN(xb_ld(&bar[XB_XGEN(b.x)]) == gen, bar);
            __builtin_amdgcn_fence(__ATOMIC_ACQUIRE, "agent");
            asm volatile("s_waitcnt vmcnt(0)" ::: "memory");
        }
    }
    __syncthreads();
}
__device__ __forceinline__ float bf2f(unsigned short h) { return __uint_as_float((unsigned)h << 16); }
__device__ __forceinline__ float wave_sum(float v) {
    return add_x32(sum32(v));
}
__device__ __forceinline__ float rdl(float v, int l) { return __int_as_float(__builtin_amdgcn_readlane(__float_as_int(v), l)); }

struct TrDesc { const float* W; bf16* WT; int ldw, k0, src, nv, K, dst; };
__device__ __forceinline__ void tr_load(const TrDesc& d, f32x4 (&v)[8], int lane) {
    const int c4 = (lane & 7) * 4, kr = lane >> 3;
#pragma unroll
    for (int i = 0; i < 8; ++i) v[i] = (c4 < d.nv) ? *(const f32x4*)(d.W + (size_t)(d.k0 + kr + 8 * i) * d.ldw + d.src + c4) : (f32x4){0.f, 0.f, 0.f, 0.f};
}
__device__ __forceinline__ void tr_store(const TrDesc& d, const f32x4 (&v)[8], LAS float* scr, int lane) {
    const int c4 = (lane & 7) * 4, kr = lane >> 3;
#pragma unroll
    for (int i = 0; i < 8; ++i) *(LAS f32x4*)(scr + (kr + 8 * i) * 36 + c4) = v[i];
    LDS_WAIT(); asm volatile("" ::: "memory");
    const int c = lane & 7;
#pragma unroll
    for (int j = 0; j < 4; ++j) { const int n = (lane >> 3) + 8 * j; const LAS float* p = scr + (8 * c) * 36 + n;
        v4u o; o.x = pk2(p[0 * 36], p[1 * 36]); o.y = pk2(p[2 * 36], p[3 * 36]); o.z = pk2(p[4 * 36], p[5 * 36]); o.w = pk2(p[6 * 36], p[7 * 36]);
        *(GAS v4u*)(d.WT + (size_t)(d.dst + n) * d.K + d.k0 + 8 * c) = o; }
    LDS_WAIT(); asm volatile("" ::: "memory");
}

struct Ptrs {
    const float *x, *c, *ada_w, *ada_b, *norm1_g, *norm2_g, *w_in, *gla_wa2, *gla_ba, *gla_norm_g, *ret_norm_g, *w_out, *ffn_wg, *ffn_wu, *ffn_wd, *final_g;
    float* out; unsigned char* ws;
};

__device__ __forceinline__ void sincos_acc(float angf, float& s, float& c) {
    const double x = (double)angf;
    const double kq = __builtin_rint(x * 0.63661977236758134308);
    const double r = (x - kq * 1.57079632679489655800e+00) - kq * 6.12323399573676603587e-17;
    const double r2 = r * r;
    double sp = -1.0 / 1307674368000.0; sp = sp * r2 + 1.0 / 6227020800.0; sp = sp * r2 - 1.0 / 39916800.0; sp = sp * r2 + 1.0 / 362880.0; sp = sp * r2 - 1.0 / 5040.0; sp = sp * r2 + 1.0 / 120.0; sp = sp * r2 - 1.0 / 6.0; sp = sp * r2 + 1.0; sp *= r;
    double cp = 1.0 / 20922789888000.0; cp = cp * r2 - 1.0 / 87178291200.0; cp = cp * r2 + 1.0 / 479001600.0; cp = cp * r2 - 1.0 / 3628800.0; cp = cp * r2 + 1.0 / 40320.0; cp = cp * r2 - 1.0 / 720.0; cp = cp * r2 + 1.0 / 24.0; cp = cp * r2 - 0.5; cp = cp * r2 + 1.0;
    const int q = (int)kq & 3;
    const double sv = (q == 0) ? sp : (q == 1) ? cp : (q == 2) ? -sp : -cp;
    const double cv = (q == 0) ? cp : (q == 1) ? -sp : (q == 2) ? -cp : sp;
    s = (float)sv; c = (float)cv;
}

template <int DK, bool GLA>
__device__ __forceinline__ void seq_recurrent_v0(const bf16* Qp, const bf16* Kp, const bf16* Vp, const bf16* Gp, const float* GAp, const float* ng, bf16* OMp, int b, int h, int lane, int om_off) {
    float S[DK];
#pragma unroll
    for (int d = 0; d < DK; ++d) S[d] = 0.f;
    const float gam = GLA ? 0.f : (1.0f - exp2f(-5.0f - (float)h));
    const float ngv = ng[lane];
    const int dl = lane & (DK - 1);
    constexpr int LQK = DK * 4;
    size_t row = (size_t)b * SEQ;
    float qv = bf2f(Qp[row * LQK + h * DK + dl]), kv = bf2f(Kp[row * LQK + h * DK + dl]), av = GLA ? GAp[row * 128 + h * 32 + dl] : 0.f;
    float vv = bf2f(Vp[row * 256 + h * 64 + lane]), gv = bf2f(Gp[row * 256 + h * 64 + lane]);
    for (int t = 0; t < SEQ; ++t) {
        const size_t rn = (size_t)b * SEQ + (t + 1 < SEQ ? t + 1 : t);
        const float qn = bf2f(Qp[rn * LQK + h * DK + dl]), kn = bf2f(Kp[rn * LQK + h * DK + dl]), an = GLA ? GAp[rn * 128 + h * 32 + dl] : 0.f;
        const float vn = bf2f(Vp[rn * 256 + h * 64 + lane]), gn = bf2f(Gp[rn * 256 + h * 64 + lane]);
        float o = 0.f;
#pragma unroll
        for (int d = 0; d < DK; ++d) { const float kd = rdl(kv, d), qd = rdl(qv, d);
            if (GLA) { const float ad = rdl(av, d); S[d] = fmaf(kd, vv, ad * S[d]); } else { S[d] = fmaf(kd, vv, gam * S[d]); }
            o = fmaf(qd, S[d], o); }
        const float ms = wave_sum(o * o) * (1.0f / 64.0f);
        const float y = o * __builtin_amdgcn_rsqf(ms + 1e-6f) * ngv * (gv / (1.0f + __expf(-gv)));
        OMp[((size_t)b * SEQ + t) * DM + om_off + h * 64 + lane] = (bf16)f2bf(y);
        qv = qn; kv = kn; av = an; vv = vn; gv = gn;
    }
}

__device__ __forceinline__ void sb_unit_v0(const bf16* SQ, const bf16* SK, const bf16* SV, bf16* OM, int unit, int lane) {
    const int bh = unit >> 6, qb = unit & 63, b = bh >> 3, h = bh & 7;
    const int t = qb * 64 + lane; const size_t row = (size_t)b * SEQ + t;
    float q[64], o[64];
    { const v4u* qp = (const v4u*)(SQ + row * 512 + h * 64);
#pragma unroll
      for (int i = 0; i < 8; ++i) { const v4u w = qp[i];
          q[8 * i + 0] = __uint_as_float(w.x << 16); q[8 * i + 1] = __uint_as_float(w.x & 0xffff0000u); q[8 * i + 2] = __uint_as_float(w.y << 16); q[8 * i + 3] = __uint_as_float(w.y & 0xffff0000u);
          q[8 * i + 4] = __uint_as_float(w.z << 16); q[8 * i + 5] = __uint_as_float(w.z & 0xffff0000u); q[8 * i + 6] = __uint_as_float(w.w << 16); q[8 * i + 7] = __uint_as_float(w.w & 0xffff0000u); } }
#pragma unroll
    for (int i = 0; i < 64; ++i) o[i] = 0.f;
    float R = 0.f;
    for (int j = 1; j <= SEQ; ++j) {
        const bool act = (t - j >= 0) && (R > SB_THR);
        if (!__any(act)) break;
        if (act) {
            const v4u* kp = (const v4u*)(SK + (row - j) * 512 + h * 64);
            float z = 0.f;
#pragma unroll
            for (int i = 0; i < 8; ++i) { const v4u w = kp[i];
                z = fmaf(q[8 * i + 0], __uint_as_float(w.x << 16), z); z = fmaf(q[8 * i + 1], __uint_as_float(w.x & 0xffff0000u), z); z = fmaf(q[8 * i + 2], __uint_as_float(w.y << 16), z); z = fmaf(q[8 * i + 3], __uint_as_float(w.y & 0xffff0000u), z);
                z = fmaf(q[8 * i + 4], __uint_as_float(w.z << 16), z); z = fmaf(q[8 * i + 5], __uint_as_float(w.z & 0xffff0000u), z); z = fmaf(q[8 * i + 6], __uint_as_float(w.w << 16), z); z = fmaf(q[8 * i + 7], __uint_as_float(w.w & 0xffff0000u), z); }
            const float e = __expf(-fabsf(z)), l1p = __logf(1.0f + e);
            const float lsz = fminf(z, 0.f) - l1p, l1m = fminf(-z, 0.f) - l1p;
            const float w = __expf(lsz + R);
            const v4u* vp = (const v4u*)(SV + (row - j) * 512 + h * 64);
#pragma unroll
            for (int i = 0; i < 8; ++i) { const v4u x = vp[i];
                o[8 * i + 0] = fmaf(w, __uint_as_float(x.x << 16), o[8 * i + 0]); o[8 * i + 1] = fmaf(w, __uint_as_float(x.x & 0xffff0000u), o[8 * i + 1]); o[8 * i + 2] = fmaf(w, __uint_as_float(x.y << 16), o[8 * i + 2]); o[8 * i + 3] = fmaf(w, __uint_as_float(x.y & 0xffff0000u), o[8 * i + 3]);
                o[8 * i + 4] = fmaf(w, __uint_as_float(x.z << 16), o[8 * i + 4]); o[8 * i + 5] = fmaf(w, __uint_as_float(x.z & 0xffff0000u), o[8 * i + 5]); o[8 * i + 6] = fmaf(w, __uint_as_float(x.w << 16), o[8 * i + 6]); o[8 * i + 7] = fmaf(w, __uint_as_float(x.w & 0xffff0000u), o[8 * i + 7]); }
            R += l1m;
        }
    }
    v4u* op = (v4u*)(OM + row * DM + 512 + h * 64);
#pragma unroll
    for (int i = 0; i < 8; ++i) { v4u w; w.x = pk2(o[8 * i + 0], o[8 * i + 1]); w.y = pk2(o[8 * i + 2], o[8 * i + 3]); w.z = pk2(o[8 * i + 4], o[8 * i + 5]); w.w = pk2(o[8 * i + 6], o[8 * i + 7]); op[i] = w; }
}

typedef short v4i16_t __attribute__((ext_vector_type(4)));
typedef float f32x16 __attribute__((ext_vector_type(16)));
typedef float f32x2_t __attribute__((ext_vector_type(2)));
#define MFMA32(a, b, c) __builtin_amdgcn_mfma_f32_32x32x16_bf16((a), (b), (c), 0, 0, 0)
__device__ __forceinline__ int crow(int r, int hi) { return (r & 3) + 8 * (r >> 2) + 4 * hi; }
__device__ __forceinline__ int tr_lane_off(int lane) { return ((lane >> 4) & 1) * 32 + (lane & 3) * 8 + (4 * (lane >> 5) + ((lane & 15) >> 2)) * 64; }
__device__ __forceinline__ bf16x8 frag_tr(LAS unsigned char* p) {
    const v4i16_t lo = __builtin_amdgcn_ds_read_tr16_b64_v4i16((LAS v4i16_t*)p);
    const v4i16_t hi = __builtin_amdgcn_ds_read_tr16_b64_v4i16((LAS v4i16_t*)(p + 512));
    return (bf16x8){lo[0], lo[1], lo[2], lo[3], hi[0], hi[1], hi[2], hi[3]};
}
__device__ __forceinline__ void stage_row64(LAS unsigned char* slot, const bf16* src, int lane) {
    const v4u* sp = (const v4u*)src; v4u w[8];
#pragma unroll
    for (int j = 0; j < 8; ++j) w[j] = sp[j];
    LAS unsigned char* base = slot + (lane >> 4) * 1024 + (lane & 15) * 64;
#pragma unroll
    for (int j = 0; j < 8; ++j) *(LAS v4u*)(base + (j >> 2) * 4096 + (j & 3) * 16) = w[j];
}
__device__ __forceinline__ void unpack8(const v4u w, float* f) {
    f[0] = __uint_as_float(w.x << 16); f[1] = __uint_as_float(w.x & 0xffff0000u); f[2] = __uint_as_float(w.y << 16); f[3] = __uint_as_float(w.y & 0xffff0000u);
    f[4] = __uint_as_float(w.z << 16); f[5] = __uint_as_float(w.z & 0xffff0000u); f[6] = __uint_as_float(w.w << 16); f[7] = __uint_as_float(w.w & 0xffff0000u);
}
__device__ __forceinline__ v4u pack8f(const float* f) { v4u w; w.x = pg8::cvt_pk_bf16(f[0], f[1]); w.y = pg8::cvt_pk_bf16(f[2], f[3]); w.z = pg8::cvt_pk_bf16(f[4], f[5]); w.w = pg8::cvt_pk_bf16(f[6], f[7]); return w; }
__device__ __forceinline__ bf16x8 packP(const f32x16& P, int b0) {
    v4u w; w.x = pg8::cvt_pk_bf16(P[b0 + 0], P[b0 + 1]); w.y = pg8::cvt_pk_bf16(P[b0 + 2], P[b0 + 3]); w.z = pg8::cvt_pk_bf16(P[b0 + 4], P[b0 + 5]); w.w = pg8::cvt_pk_bf16(P[b0 + 6], P[b0 + 7]);
    return __builtin_bit_cast(bf16x8, w);
}
__device__ __forceinline__ float ret_log2_gamma(int h) { return log2f(1.0f - exp2f(-5.0f - (float)h)); }

template <int DK, bool GLA>
__device__ __forceinline__ void chunk_sum_unit(int ch, bf16* Qp, bf16* Kp, const bf16* Vp, const float* GRp, const float* wa2, const float* ba, float* KVT, float* DEC, LAS unsigned char* wlds, int lane) {
    asm volatile("" : "+v"(lane));
    const int b = ch >> 8, h = (ch >> 6) & 3, n = ch & 63; const size_t row = (size_t)b * SEQ + n * 64 + lane;
    constexpr int LQK = DK * 4;
    LAS unsigned char* vslot = wlds; LAS unsigned char* kslot = wlds + 8192;
    constexpr int PQ = DK / 8;
    constexpr int RQ_ = 64 / PQ;
    const size_t R0 = (size_t)b * SEQ + n * 64;
    const int pv = lane & 7, rv = lane >> 3;
    const int pq = lane & (PQ - 1), rq = lane / PQ;
    v4u vraw[8], kraw[PQ], qraw[PQ];
    float w[16], bias = 0.f;
    f32x4 grv[4];
    if (GLA) {
#pragma unroll
        for (int r = 0; r < 16; ++r) w[r] = wa2[r * 128 + h * 32 + (lane & 31)];
        bias = ba[h * 32 + (lane & 31)];
#pragma unroll
        for (int j = 0; j < 4; ++j) grv[j] = *(const f32x4*)(GRp + R0 * 16 + (size_t)(j * 64 + lane) * 4); }
#pragma unroll
    for (int i = 0; i < 8; ++i) vraw[i] = *(const v4u*)(Vp + (R0 + 8 * i + rv) * 256 + h * 64 + 8 * pv);
#pragma unroll
    for (int i = 0; i < PQ; ++i) { const size_t o = (R0 + RQ_ * i + rq) * LQK + h * DK + 8 * pq;
        kraw[i] = *(const v4u*)(Kp + o); if (GLA) qraw[i] = *(const v4u*)(Qp + o); }
    float ebls = 1.f, l2g = 0.f;
    LAS float* BT = (LAS float*)wlds; LAS float* grl = (LAS float*)(wlds + 12288); LAS float* T0 = (LAS float*)(wlds + 12288);
    if (GLA) {
#pragma unroll
        for (int j = 0; j < 4; ++j) *(LAS f32x4*)(grl + (j * 64 + lane) * 4) = grv[j];
        const int c = lane & 31, half = lane >> 5;
        asm volatile("s_waitcnt lgkmcnt(0)" ::: "memory");
        float run = 0.f;
#pragma unroll 4
        for (int tt = 0; tt < 32; ++tt) {
            const int t = half * 32 + tt;
            const f32x4 g0 = *(const LAS f32x4*)(grl + t * 16), g1 = *(const LAS f32x4*)(grl + t * 16 + 4), g2 = *(const LAS f32x4*)(grl + t * 16 + 8), g3 = *(const LAS f32x4*)(grl + t * 16 + 12);
            float u = bias;
            u = fmaf(g0[0], w[0], u); u = fmaf(g0[1], w[1], u); u = fmaf(g0[2], w[2], u); u = fmaf(g0[3], w[3], u);
            u = fmaf(g1[0], w[4], u); u = fmaf(g1[1], w[5], u); u = fmaf(g1[2], w[6], u); u = fmaf(g1[3], w[7], u);
            u = fmaf(g2[0], w[8], u); u = fmaf(g2[1], w[9], u); u = fmaf(g2[2], w[10], u); u = fmaf(g2[3], w[11], u);
            u = fmaf(g3[0], w[12], u); u = fmaf(g3[1], w[13], u); u = fmaf(g3[2], w[14], u); u = fmaf(g3[3], w[15], u);
            run += (fminf(u, 0.f) - __logf(1.0f + __expf(-fabsf(u)))) * (1.0f / 16.0f);
            BT[t * 32 + c] = run;
        }
        asm volatile("s_waitcnt lgkmcnt(0)" ::: "memory");
        if (half == 0) T0[c] = run;
        asm volatile("s_waitcnt lgkmcnt(0)" ::: "memory");
    } else {
        l2g = ret_log2_gamma(h); ebls = exp2f(64.0f * l2g);
    }
#pragma unroll
    for (int i = 0; i < PQ; ++i) {
        const int r = RQ_ * i + rq;
        float kk[8], qq[8], kh[8], e8[8], el8[8];
        if (GLA) {
            const f32x4 b0 = *(const LAS f32x4*)(BT + r * 32 + 8 * pq), b1 = *(const LAS f32x4*)(BT + r * 32 + 8 * pq + 4);
            const f32x4 t0 = *(const LAS f32x4*)(T0 + 8 * pq), t1 = *(const LAS f32x4*)(T0 + 8 * pq + 4);
            const f32x4 l0 = *(const LAS f32x4*)(BT + 63 * 32 + 8 * pq) + t0, l1 = *(const LAS f32x4*)(BT + 63 * 32 + 8 * pq + 4) + t1;
            const float addt = (r >= 32) ? 1.0f : 0.0f;
#pragma unroll
            for (int e = 0; e < 4; ++e) { e8[e] = __expf(b0[e] + addt * t0[e]); e8[4 + e] = __expf(b1[e] + addt * t1[e]); el8[e] = __expf(l0[e]); el8[4 + e] = __expf(l1[e]); }
            if (i == 0 && rq == 0) { *(f32x4*)(DEC + (size_t)(b * 64 + n) * 128 + h * 32 + 8 * pq) = (f32x4){el8[0], el8[1], el8[2], el8[3]}; *(f32x4*)(DEC + (size_t)(b * 64 + n) * 128 + h * 32 + 8 * pq + 4) = (f32x4){el8[4], el8[5], el8[6], el8[7]}; }
        }
        unpack8(kraw[i], kk); if (GLA) unpack8(qraw[i], qq);
        const float iebs = GLA ? 1.f : exp2f(-(float)(r + 1) * l2g);
#pragma unroll
        for (int e = 0; e < 8; ++e) {
            if (GLA) { qq[e] *= e8[e]; kk[e] *= __builtin_amdgcn_rcpf(e8[e]); kh[e] = kk[e] * el8[e]; }
            else { kk[e] *= iebs; kh[e] = kk[e] * ebls; }
        }
        if (GLA) { const size_t o = (R0 + r) * LQK + h * DK + 8 * pq; *(v4u*)(Qp + o) = pack8f(qq); *(v4u*)(Kp + o) = pack8f(kk); }
        *(LAS v4u*)(kslot + (pq >> 2) * 4096 + (r >> 4) * 1024 + (r & 15) * 64 + (pq & 3) * 16) = pack8f(kh);
    }
    asm volatile("s_waitcnt lgkmcnt(0)" ::: "memory");
#pragma unroll
    for (int i = 0; i < 8; ++i) { const int r = 8 * i + rv; *(LAS v4u*)(vslot + (pv >> 2) * 4096 + (r >> 4) * 1024 + (r & 15) * 64 + (pv & 3) * 16) = vraw[i]; }
    asm volatile("s_waitcnt lgkmcnt(0)" ::: "memory");
    const int hi = lane >> 5, tro = tr_lane_off(lane);
    f32x16 acc[2][DK / 32];
#pragma unroll
    for (int eh = 0; eh < 2; ++eh)
#pragma unroll
        for (int dh = 0; dh < DK / 32; ++dh) acc[eh][dh] = (f32x16){0.f, 0.f, 0.f, 0.f, 0.f, 0.f, 0.f, 0.f, 0.f, 0.f, 0.f, 0.f, 0.f, 0.f, 0.f, 0.f};
#pragma unroll
    for (int rg = 0; rg < 4; ++rg) {
        bf16x8 vf[2], kf[DK / 32];
#pragma unroll
        for (int eh = 0; eh < 2; ++eh) vf[eh] = frag_tr(vslot + eh * 4096 + rg * 1024 + tro);
#pragma unroll
        for (int dh = 0; dh < DK / 32; ++dh) kf[dh] = frag_tr(kslot + dh * 4096 + rg * 1024 + tro);
#pragma unroll
        for (int eh = 0; eh < 2; ++eh)
#pragma unroll
            for (int dh = 0; dh < DK / 32; ++dh) acc[eh][dh] = MFMA32(vf[eh], kf[dh], acc[eh][dh]);
    }
    unsigned short* kvp = (unsigned short*)KVT + (size_t)ch * (64 * DK);
#pragma unroll
    for (int eh = 0; eh < 2; ++eh)
#pragma unroll
        for (int dh = 0; dh < DK / 32; ++dh)
#pragma unroll
            for (int r = 0; r < 16; ++r) kvp[(32 * eh + crow(r, hi)) * DK + 32 * dh + (lane & 31)] = (unsigned short)f2bf(acc[eh][dh][r]);
    asm volatile("s_waitcnt lgkmcnt(0)" ::: "memory");
}

template <int DK, bool GLA>
__device__ __forceinline__ void scan_unit(int seq, int part, const float* KVT, const float* DEC, bf16* ST, int lane) {
    const int idx = part * 128 + lane * 2; const int d = idx & (DK - 1);
    const int b = seq >> 2, h = seq & 3;
    float s0 = 0.f, s1 = 0.f;
    const float gdec = GLA ? 0.f : exp2f(64.0f * ret_log2_gamma(h));
    for (int n0 = 0; n0 < 64; n0 += 32) {
        float kv0[32], kv1[32], d0[32], d1[32];
#pragma unroll
        for (int i = 0; i < 32; ++i) { const size_t chn = (size_t)seq * 64 + n0 + i;
            const unsigned kvw = *(const unsigned*)((const unsigned short*)KVT + chn * (64 * DK) + idx); kv0[i] = __uint_as_float(kvw << 16); kv1[i] = __uint_as_float(kvw & 0xffff0000u);
            if (GLA) { const f32x2_t dd = *(const f32x2_t*)(DEC + (size_t)(b * 64 + n0 + i) * 128 + h * 32 + d); d0[i] = dd.x; d1[i] = dd.y; } else { d0[i] = gdec; d1[i] = gdec; } }
#pragma unroll
        for (int i = 0; i < 32; ++i) { const size_t chn = (size_t)seq * 64 + n0 + i;
            *(unsigned*)(ST + chn * (64 * DK) + idx) = pg8::cvt_pk_bf16(s0, s1);
            s0 = fmaf(d0[i], s0, kv0[i]); s1 = fmaf(d1[i], s1, kv1[i]); }
    }
}

template <int DK>
__device__ __forceinline__ void chunk_out_unit(int ch, const bf16* Qp, const bf16* Kp, const bf16* Vp, const bf16* Gp, const bf16* ST, const float* ng, bf16* OMp, int om_off, LAS unsigned char* wlds, LAS float* ngl, int lane) {
    asm volatile("" : "+v"(lane));
    const float ngv = ng[lane];
    const int b = ch >> 8, h = (ch >> 6) & 3, n = ch & 63; const size_t R0 = (size_t)b * SEQ + n * 64;
    constexpr int LQK = DK * 4, NKS = DK / 16;
    const int hi = lane >> 5, l31 = lane & 31, tro = tr_lane_off(lane);
    LAS unsigned char* vslot = wlds;
    bf16x8 qf[2][NKS], kf[2][NKS], sf[NKS][2];
    v4u graw[2][4];
#pragma unroll
    for (int tb = 0; tb < 2; ++tb)
#pragma unroll
        for (int i = 0; i < 4; ++i) graw[tb][i] = *(const v4u*)(Gp + (R0 + 32 * tb + 8 * i + (lane >> 3)) * 256 + h * 64 + 8 * (lane & 7));
    constexpr int PQ = DK / 8, RQ_ = 64 / PQ;
    const int pq = lane & (PQ - 1), rq = lane / PQ, pv = lane & 7, rv = lane >> 3;
    v4u qraw[PQ], kraw[PQ], sraw[PQ], vrow[8];
#pragma unroll
    for (int i = 0; i < PQ; ++i) { const size_t o = (R0 + RQ_ * i + rq) * LQK + h * DK + 8 * pq;
        qraw[i] = *(const v4u*)(Qp + o); kraw[i] = *(const v4u*)(Kp + o);
        sraw[i] = *(const v4u*)(ST + (size_t)ch * (64 * DK) + (RQ_ * i + rq) * DK + 8 * pq); }
#pragma unroll
    for (int i = 0; i < 8; ++i) vrow[i] = *(const v4u*)(Vp + (R0 + 8 * i + rv) * 256 + h * 64 + 8 * pv);
    asm volatile("" ::: "memory");
    {
        LAS unsigned char* img = wlds + 8192;
#define CO_PUT(raw) { _Pragma("unroll") for (int i = 0; i < PQ; ++i) { const int r = RQ_ * i + rq; *(LAS v4u*)(img + (pq >> 2) * 4096 + (r >> 4) * 1024 + (r & 15) * 64 + (pq & 3) * 16) = raw[i]; } }
#define CO_FRAG(row, piece) (*(const LAS bf16x8*)(img + ((piece) >> 2) * 4096 + ((row) >> 4) * 1024 + ((row) & 15) * 64 + ((piece) & 3) * 16))
        CO_PUT(qraw) asm volatile("s_waitcnt lgkmcnt(0)" ::: "memory");
#pragma unroll
        for (int half = 0; half < 2; ++half)
#pragma unroll
            for (int ks = 0; ks < NKS; ++ks) qf[half][ks] = CO_FRAG(32 * half + l31, 2 * ks + hi);
        asm volatile("s_waitcnt lgkmcnt(0)" ::: "memory");
        CO_PUT(kraw) asm volatile("s_waitcnt lgkmcnt(0)" ::: "memory");
#pragma unroll
        for (int half = 0; half < 2; ++half)
#pragma unroll
            for (int ks = 0; ks < NKS; ++ks) kf[half][ks] = CO_FRAG(32 * half + l31, 2 * ks + hi);
        asm volatile("s_waitcnt lgkmcnt(0)" ::: "memory");
        CO_PUT(sraw) asm volatile("s_waitcnt lgkmcnt(0)" ::: "memory");
#pragma unroll
        for (int ks = 0; ks < NKS; ++ks)
#pragma unroll
            for (int dh = 0; dh < 2; ++dh) sf[ks][dh] = CO_FRAG(32 * dh + l31, 2 * ks + hi);
        asm volatile("s_waitcnt lgkmcnt(0)" ::: "memory");
#undef CO_PUT
#undef CO_FRAG
#pragma unroll
        for (int i = 0; i < 8; ++i) { const int r = 8 * i + rv; *(LAS v4u*)(vslot + (pv >> 2) * 4096 + (r >> 4) * 1024 + (r & 15) * 64 + (pv & 3) * 16) = vrow[i]; }
    }
    ngl[lane] = ngv;
    asm volatile("s_waitcnt lgkmcnt(0)" ::: "memory");
    if (DK == 64) {
        const float l2g = ret_log2_gamma(h);
#pragma unroll
        for (int half = 0; half < 2; ++half) { const float tq = (float)(32 * half + l31 + 1); const float sq_ = exp2f(tq * l2g), sk_ = exp2f(-tq * l2g);
#pragma unroll
            for (int ks = 0; ks < NKS; ++ks) { float f[8];
                unpack8(__builtin_bit_cast(v4u, qf[half][ks]), f);
#pragma unroll
                for (int e = 0; e < 8; ++e) f[e] *= sq_;
                qf[half][ks] = __builtin_bit_cast(bf16x8, pack8f(f));
                unpack8(__builtin_bit_cast(v4u, kf[half][ks]), f);
#pragma unroll
                for (int e = 0; e < 8; ++e) f[e] *= sk_;
                kf[half][ks] = __builtin_bit_cast(bf16x8, pack8f(f)); } }
    }
#pragma unroll
    for (int tb = 0; tb < 2; ++tb) {
        f32x16 o0 = (f32x16){0.f, 0.f, 0.f, 0.f, 0.f, 0.f, 0.f, 0.f, 0.f, 0.f, 0.f, 0.f, 0.f, 0.f, 0.f, 0.f}, o1 = o0;
#pragma unroll
        for (int ks = 0; ks < NKS; ++ks) { o0 = MFMA32(qf[tb][ks], sf[ks][0], o0); o1 = MFMA32(qf[tb][ks], sf[ks][1], o1); }
#pragma unroll
        for (int kh = 0; kh <= tb; ++kh) {
            f32x16 P = (f32x16){0.f, 0.f, 0.f, 0.f, 0.f, 0.f, 0.f, 0.f, 0.f, 0.f, 0.f, 0.f, 0.f, 0.f, 0.f, 0.f};
#pragma unroll
            for (int ks = 0; ks < NKS; ++ks) P = MFMA32(kf[kh][ks], qf[tb][ks], P);
            if (kh == tb) {
#pragma unroll
                for (int r = 0; r < 16; ++r) if (crow(r, hi) > l31) P[r] = 0.f;
            }
            const bf16x8 pa0 = packP(P, 0), pa1 = packP(P, 8);
            const bf16x8 v00 = frag_tr(vslot + 0 * 4096 + (2 * kh) * 1024 + tro), v01 = frag_tr(vslot + 0 * 4096 + (2 * kh + 1) * 1024 + tro);
            const bf16x8 v10 = frag_tr(vslot + 1 * 4096 + (2 * kh) * 1024 + tro), v11 = frag_tr(vslot + 1 * 4096 + (2 * kh + 1) * 1024 + tro);
            o0 = MFMA32(pa0, v00, o0); o0 = MFMA32(pa1, v01, o0);
            o1 = MFMA32(pa0, v10, o1); o1 = MFMA32(pa1, v11, o1);
        }
        {
            LAS float* OT = (LAS float*)(wlds + 8192);
#pragma unroll
            for (int r = 0; r < 16; ++r) { const int tt = crow(r, hi); OT[tt * 64 + (l31 ^ ((tt & 7) << 2))] = o0[r]; OT[tt * 64 + ((32 + l31) ^ ((tt & 7) << 2))] = o1[r]; }
            asm volatile("s_waitcnt lgkmcnt(0)" ::: "memory");
            const int pp = lane & 7;
            const f32x4 n0 = *(const LAS f32x4*)(ngl + 8 * pp), n1 = *(const LAS f32x4*)(ngl + 8 * pp + 4);
#pragma unroll
            for (int i = 0; i < 4; ++i) { const int rr = 8 * i + (lane >> 3); const int sw = (rr & 7) << 2;
                const f32x4 x0 = *(const LAS f32x4*)(OT + rr * 64 + ((8 * pp) ^ sw)), x1 = *(const LAS f32x4*)(OT + rr * 64 + ((8 * pp + 4) ^ sw));
                float sq = (x0[0] * x0[0] + x0[1] * x0[1]) + (x0[2] * x0[2] + x0[3] * x0[3]) + (x1[0] * x1[0] + x1[1] * x1[1]) + (x1[2] * x1[2] + x1[3] * x1[3]);
                sq += shx<1>(sq); sq += shx<2>(sq); sq += shx<4>(sq);
                const float rs = __builtin_amdgcn_rsqf(sq * (1.0f / 64.0f) + 1e-6f);
                float g[8], y[8]; unpack8(graw[tb][i], g);
#pragma unroll
                for (int e = 0; e < 8; ++e) { const float nn = (e < 4) ? n0[e & 3] : n1[e & 3]; const float xv = (e < 4) ? x0[e & 3] : x1[e & 3]; y[e] = xv * rs * nn * (g[e] * __builtin_amdgcn_rcpf(1.0f + __expf(-g[e]))); }
                *(v4u*)(OMp + (R0 + 32 * tb + rr) * DM + om_off + h * 64 + 8 * pp) = pack8f(y); }
            asm volatile("s_waitcnt lgkmcnt(0)" ::: "memory");
        }
    }
    asm volatile("s_waitcnt lgkmcnt(0)" ::: "memory");
}

struct SbK { bf16x8 a0[4], a1[4]; };
__device__ __forceinline__ void sb_dma_k(const bf16* SK, size_t rowbase, int s0, int h, int lane, LAS unsigned char* kslot) {
    const char* kb = (const char*)(SK + (rowbase + s0) * 512 + h * 64); const unsigned voff = (unsigned)(lane >> 3) * 1024u + (unsigned)((lane & 7) ^ (lane >> 3)) * 16u;
#pragma unroll
    for (int c = 0; c < 8; ++c) __builtin_amdgcn_global_load_lds((const unsigned*)(kb + c * 8192 + voff), (LAS unsigned*)(kslot + c * 1024), 16, 0, 0);
}
__device__ __forceinline__ void sb_dma_v(const bf16* SV, size_t rowbase, int s0, int h, int lane, LAS unsigned char* vslot) {
    const char* vb = (const char*)(SV + (rowbase + s0) * 512 + h * 64); const unsigned voff = (unsigned)(lane >> 2) * 1024u + (unsigned)(lane & 3) * 16u;
#pragma unroll
    for (int p = 0; p < 8; ++p)
        __builtin_amdgcn_global_load_lds((const unsigned*)(vb + (16 * (p & 3)) * 1024 + (p >> 2) * 64 + voff), (LAS unsigned*)(vslot + p * 1024), 16, 0, 0);
}
__device__ __forceinline__ void sb_read_k(SbK& k, LAS unsigned char* kslot, int lane) {
    const int l31 = lane & 31, hi = lane >> 5;
#pragma unroll
    for (int ks = 0; ks < 4; ++ks) { const int slot = (2 * ks + hi) ^ (l31 & 7);
        k.a0[ks] = *(const LAS bf16x8*)(kslot + l31 * 128 + slot * 16); k.a1[ks] = *(const LAS bf16x8*)(kslot + 4096 + l31 * 128 + slot * 16); }
}
template <bool DIAG>
__device__ __forceinline__ void sb_half(const bf16x8 (&ka)[4], const bf16x8 (&qr)[4], float& suf, int sbase, int t, int hi, bf16x8& paLo, bf16x8& paHi) {
    f32x16 p = (f32x16){0.f, 0.f, 0.f, 0.f, 0.f, 0.f, 0.f, 0.f, 0.f, 0.f, 0.f, 0.f, 0.f, 0.f, 0.f, 0.f};
#pragma unroll
    for (int ks = 0; ks < 4; ++ks) p = MFMA32(ka[ks], qr[ks], p);
    float om[16];
#pragma unroll
    for (int r = 0; r < 16; ++r) {
        const float e = __builtin_amdgcn_exp2f(-__builtin_amdgcn_fmed3f(p[r], -100.0f, 3.0e38f)); float sg = __builtin_amdgcn_rcpf(1.0f + e), o1 = e * sg;
        if (DIAG) { const bool ok = (sbase + crow(r, hi) < t); sg = ok ? sg : 0.f; o1 = ok ? o1 : 1.0f; }
        p[r] = sg; om[r] = o1;
    }
    float G[4], H[4], sg4[4];
#pragma unroll
    for (int q = 0; q < 4; ++q) G[q] = (om[4 * q] * om[4 * q + 1]) * (om[4 * q + 2] * om[4 * q + 3]);
#pragma unroll
    for (int q = 0; q < 4; ++q) H[q] = get_x32(G[q], hi);
#pragma unroll
    for (int q = 3; q >= 0; --q) { sg4[q] = suf * (hi ? 1.0f : H[q]); suf *= G[q] * H[q]; }
#pragma unroll
    for (int q = 0; q < 4; ++q) { float s = sg4[q];
        p[4 * q + 3] *= s; s *= om[4 * q + 3]; p[4 * q + 2] *= s; s *= om[4 * q + 2]; p[4 * q + 1] *= s; s *= om[4 * q + 1]; p[4 * q] *= s; }
    paLo = packP(p, 0); paHi = packP(p, 8);
}
template <bool DIAG, int BLK>
__device__ __forceinline__ void sb_tile(const SbK& k, const bf16x8 (&qr)[4], const bf16x8 (&vf)[2][4], f32x16& o0, f32x16& o1, float& R, int s0, int t, int hi) {
    float suf = R; bf16x8 paLo, paHi;
    if (!(DIAG && BLK == 0)) {
    sb_half<DIAG>(k.a1, qr, suf, s0 + 32, t, hi, paLo, paHi);
    o0 = MFMA32(paLo, vf[0][2], o0); o1 = MFMA32(paLo, vf[1][2], o1);
    o0 = MFMA32(paHi, vf[0][3], o0); o1 = MFMA32(paHi, vf[1][3], o1);
    }
    sb_half<(DIAG && BLK == 0)>(k.a0, qr, suf, s0, t, hi, paLo, paHi);
    o0 = MFMA32(paLo, vf[0][0], o0); o1 = MFMA32(paLo, vf[1][0], o1);
    o0 = MFMA32(paHi, vf[0][1], o0); o1 = MFMA32(paHi, vf[1][1], o1);
    R = suf;
}
template <bool DIAG>
__device__ __forceinline__ void sb_iter(const bf16* SK, const bf16* SV, size_t rowbase, int j, int h, int lane, LAS unsigned char* kslot, LAS unsigned char* vslot,
                                        const bf16x8 (&qrA)[4], const bf16x8 (&qrB)[4], f32x16& oA0, f32x16& oA1, f32x16& oB0, f32x16& oB1, float& RA, float& RB, bool& doneA, bool& doneB, int tA, int hi, int tro) {
    asm volatile("s_waitcnt vmcnt(0)" ::: "memory");
    SbK k; sb_read_k(k, kslot, lane);
    bf16x8 vf[2][4];
#pragma unroll
    for (int ch2 = 0; ch2 < 2; ++ch2)
#pragma unroll
        for (int rg = 0; rg < 4; ++rg) vf[ch2][rg] = frag_tr(vslot + ch2 * 4096 + rg * 1024 + tro);
    asm volatile("s_waitcnt lgkmcnt(0)" ::: "memory");
    if (j > 0) { sb_dma_k(SK, rowbase, (j - 1) * 64, h, lane, kslot); sb_dma_v(SV, rowbase, (j - 1) * 64, h, lane, vslot); }
    if (!doneA) { sb_tile<DIAG, 0>(k, qrA, vf, oA0, oA1, RA, j * 64, tA, hi); doneA = __all(RA < SB_PMIN); }
    if (!doneB) { sb_tile<DIAG, 1>(k, qrB, vf, oB0, oB1, RB, j * 64, tA + 32, hi); doneB = __all(RB < SB_PMIN); }
}
__device__ __forceinline__ void sb_unit_v1(int unit, const bf16* SQ, const bf16* SK, const bf16* SV, bf16* OM, LAS unsigned char* wlds, int lane) {
    asm volatile("" : "+v"(lane));
    const int bh = unit >> 6, qb = unit & 63, b = bh >> 3, h = bh & 7;
    const int hi = lane >> 5, l31 = lane & 31, tro = tr_lane_off(lane);
    const size_t rowbase = (size_t)b * SEQ; const int t0 = qb * 64; const int tA = t0 + l31;
    LAS unsigned char* kslot = wlds; LAS unsigned char* vslot = wlds + 8192;
    asm volatile("s_waitcnt lgkmcnt(0)" ::: "memory");
    int j = qb;
    sb_dma_k(SK, rowbase, j * 64, h, lane, kslot); sb_dma_v(SV, rowbase, j * 64, h, lane, vslot);
    bf16x8 qrA[4], qrB[4];
#pragma unroll
    for (int ks = 0; ks < 4; ++ks) { qrA[ks] = *(const bf16x8*)(SQ + (rowbase + tA) * 512 + h * 64 + 16 * ks + 8 * hi); qrB[ks] = *(const bf16x8*)(SQ + (rowbase + tA + 32) * 512 + h * 64 + 16 * ks + 8 * hi); }
    const f32x16 zero16 = (f32x16){0.f, 0.f, 0.f, 0.f, 0.f, 0.f, 0.f, 0.f, 0.f, 0.f, 0.f, 0.f, 0.f, 0.f, 0.f, 0.f};
    f32x16 oA0 = zero16, oA1 = zero16, oB0 = zero16, oB1 = zero16;
    float RA = 1.0f, RB = 1.0f; bool doneA = false, doneB = false;
    sb_iter<true>(SK, SV, rowbase, j, h, lane, kslot, vslot, qrA, qrB, oA0, oA1, oB0, oB1, RA, RB, doneA, doneB, tA, hi, tro);
    while (j > 0 && !(doneA && doneB)) {
        --j;
        sb_iter<false>(SK, SV, rowbase, j, h, lane, kslot, vslot, qrA, qrB, oA0, oA1, oB0, oB1, RA, RB, doneA, doneB, tA, hi, tro);
    }
    asm volatile("s_waitcnt vmcnt(0) lgkmcnt(0)" ::: "memory");
    { LAS float* OT = (LAS float*)wlds;
#pragma unroll
      for (int r = 0; r < 16; ++r) { const int tt = crow(r, hi); const int sw = (tt & 7) << 2;
          OT[tt * 64 + (l31 ^ sw)] = oA0[r]; OT[tt * 64 + ((32 + l31) ^ sw)] = oA1[r]; OT[2048 + tt * 64 + (l31 ^ sw)] = oB0[r]; OT[2048 + tt * 64 + ((32 + l31) ^ sw)] = oB1[r]; }
      asm volatile("s_waitcnt lgkmcnt(0)" ::: "memory");
      const int pp = lane & 7;
#pragma unroll
      for (int i = 0; i < 8; ++i) { const int rr = 8 * i + (lane >> 3);
          const int sw = (rr & 7) << 2; const LAS float* src = OT + (rr >> 5) * 2048 + (rr & 31) * 64;
          const f32x4 x0 = *(const LAS f32x4*)(src + ((8 * pp) ^ sw)), x1 = *(const LAS f32x4*)(src + ((8 * pp + 4) ^ sw));
          float y[8] = {x0[0], x0[1], x0[2], x0[3], x1[0], x1[1], x1[2], x1[3]};
          *(v4u*)(OM + (rowbase + t0 + rr) * DM + 512 + h * 64 + 8 * pp) = pack8f(y); }
      asm volatile("s_waitcnt lgkmcnt(0)" ::: "memory"); }
}

__device__ __forceinline__ int lane_now() { int l; asm volatile("v_mbcnt_lo_u32_b32 %0, -1, 0\n\tv_mbcnt_hi_u32_b32 %0, -1, %0" : "=v"(l)); return l; }
struct Args { const float* in[16]; float* out; unsigned char* ws; int ph_lo, ph_hi; };
__global__ void __launch_bounds__(NWAVES * 64, 2) mk_fwd(Args args) {
    extern __shared__ __attribute__((aligned(16))) unsigned char lds_raw[];
    LAS unsigned char* lds = (LAS unsigned char*)lds_raw;
    volatile LAS unsigned* MISC = (volatile LAS unsigned*)(lds + MISC_OFF);
    const int wave_k = __builtin_amdgcn_readfirstlane((int)threadIdx.x >> 6);
#define TID_NOW() (wave_k * 64 + lane_now())
    const int G = gridDim.x; const int bx = blockIdx.x; const int NGW = G * NWAVES;
    int bxe = bx, lmode = 0;
    typedef __attribute__((address_space(4))) const unsigned long long kargw_t;
    const kargw_t* kargs = (const kargw_t*)__builtin_amdgcn_kernarg_segment_ptr();
#define PH_BEGIN() const kargw_t* kq_ = kargs; asm volatile("" : "+s"(kq_)); int tid = TID_NOW(); asm volatile("" : "+v"(tid)); const int lane = tid & 63, wave = __builtin_amdgcn_readfirstlane(tid >> 6); \
    const int vcu = (G % 8 == 0) ? (bxe % 8) * (G / 8) + bxe / 8 : bxe; const int gw = vcu * NWAVES + wave; (void)lane; (void)wave; (void)vcu; (void)gw; \
    unsigned char* ws = (unsigned char*)(GAS unsigned char*)kq_[17]; float* out = (float*)(GAS float*)kq_[16]; (void)out; \
    gu32* ctl = (gu32*)(ws + WS_CTL); (void)ctl; unsigned long long* SS = (unsigned long long*)(ws + WS_SS); float* MOD = (float*)(ws + WS_MOD); float* CBIN = (float*)(ws + WS_CBIN); float* CBUP = (float*)(ws + WS_CBUP); float* ROT = (float*)(ws + WS_ROT); \
    bf16 *WIN = (bf16*)(ws + WS_WIN), *WOUT = (bf16*)(ws + WS_WOUT), *WUP = (bf16*)(ws + WS_WUP), *WDN = (bf16*)(ws + WS_WDN); \
    bf16 *XA = (bf16*)(ws + WS_XA), *OM = (bf16*)(ws + WS_OM), *HB = (bf16*)(ws + WS_HB); \
    const size_t bq_ = (size_t)(gw >> 8);        \
    bf16 *GQ = (bf16*)(ws + WS_GQ + bq_ * (PBS - 1 * MiB)), *GK = (bf16*)(ws + WS_GK + bq_ * (PBS - 1 * MiB)), *GV = (bf16*)(ws + WS_GV + bq_ * (PBS - 2 * MiB)), *GG = (bf16*)(ws + WS_GG + bq_ * (PBS - 2 * MiB)), \
         *RQ = (bf16*)(ws + WS_RQ + bq_ * (PBS - 2 * MiB)), *RK = (bf16*)(ws + WS_RK + bq_ * (PBS - 2 * MiB)), *RV = (bf16*)(ws + WS_RV + bq_ * (PBS - 2 * MiB)), *RG = (bf16*)(ws + WS_RG + bq_ * (PBS - 2 * MiB)), \
         *SQ = (bf16*)(ws + WS_SQ + bq_ * (PBS - 4 * MiB)), *SK = (bf16*)(ws + WS_SK + bq_ * (PBS - 4 * MiB)), *SV = (bf16*)(ws + WS_SV + bq_ * (PBS - 4 * MiB)); \
    float *GR = (float*)(ws + WS_GR), *GA = (float*)(ws + WS_GA); \
    (void)SS; (void)MOD; (void)CBIN; (void)CBUP; (void)ROT; (void)WIN; (void)WOUT; (void)WUP; (void)WDN; (void)XA; (void)OM; (void)HB; (void)GQ; (void)GK; (void)GV; (void)GG; (void)RQ; (void)RK; (void)RV; (void)RG; (void)SQ; (void)SK; (void)SV; (void)GR; (void)GA;
#define IN_PTR(i) ((const float*)(const GAS float*)kq_[i])
    for (int u = (int)threadIdx.x; u < (LDS_BYTES - LDSCTL_OFF) / 4; u += NWAVES * 64) ((LAS unsigned*)(lds + LDSCTL_OFF))[u] = 0u;
    __syncthreads();
    { PH_BEGIN(); (void)xcd_barrier_post((unsigned*)(ctl + CW_BAR), MISC + 8); }
#if PROBE_ON
#define STAMP() do { if (blockIdx.x == 0 && TID_NOW() == 0) { ((volatile LAS unsigned long long*)(lds + LDSCTL_OFF + 1024))[nstamp_] = __builtin_amdgcn_s_memrealtime(); } ++nstamp_; } while (0)
    int nstamp_ = 0;
#else
#define STAMP() do {} while (0)
#endif
#define GRID_BAR() do { GRID_BAR_(0); STAMP(); } while (0)
#define XCC_BAR() do { GRID_BAR_(lmode); STAMP(); } while (0)
#define GRID_BAR_(loc) do { const kargw_t* kb_ = kargs; asm volatile("" : "+s"(kb_)); XcdBarrier bb_; bb_.bar = (unsigned*)((gu32*)(GAS unsigned char*)kb_[17] + CW_BAR); bb_.x = xb_xcc_id(); bb_.st = MISC + 8; bb_.tid = TID_NOW(); xcd_barrier(bb_, (loc)); } while (0)

    STAMP();
    {
        PH_BEGIN(); const float *cvec = IN_PTR(1), *ada_w = IN_PTR(2), *ada_b = IN_PTR(3), *w_in = IN_PTR(6), *w_out = IN_PTR(11), *ffn_wg = IN_PTR(12), *ffn_wu = IN_PTR(13), *ffn_wd = IN_PTR(14);
        LAS float* tbl = (LAS float*)(lds + RING_OFF); LAS float* red = (LAS float*)(lds + RING_OFF + 32768);
        if (bx < 192) {
            const int l = bx / 96, jblk = bx % 96, jq = tid & 15, kg = tid >> 4, j0 = jblk * 64 + 4 * jq;
            f32x4 w4[32]; float cv[16];
#pragma unroll
            for (int i = 0; i < 32; ++i) w4[i] = *(const f32x4*)(ada_w + ((size_t)l * DM + kg * 32 + i) * MODLD + j0);
#pragma unroll
            for (int q = 0; q < 16; ++q) cv[q] = cvec[tid + q * (NWAVES * 64)];
            asm volatile("" : "+v"(w4[0]), "+v"(w4[1]), "+v"(w4[2]), "+v"(w4[3]), "+v"(w4[4]), "+v"(w4[5]), "+v"(w4[6]), "+v"(w4[7]), "+v"(w4[8]), "+v"(w4[9]), "+v"(w4[10]), "+v"(w4[11]), "+v"(w4[12]), "+v"(w4[13]), "+v"(w4[14]), "+v"(w4[15]) :: "memory");
            asm volatile("" : "+v"(w4[16]), "+v"(w4[17]), "+v"(w4[18]), "+v"(w4[19]), "+v"(w4[20]), "+v"(w4[21]), "+v"(w4[22]), "+v"(w4[23]), "+v"(w4[24]), "+v"(w4[25]), "+v"(w4[26]), "+v"(w4[27]), "+v"(w4[28]), "+v"(w4[29]), "+v"(w4[30]), "+v"(w4[31]) :: "memory");
#pragma unroll
            for (int q = 0; q < 16; ++q) tbl[tid + q * (NWAVES * 64)] = cv[q] / (1.0f + __expf(-cv[q]));
            __syncthreads();
            f32x4 acc[8];
#pragma unroll
            for (int b = 0; b < 8; ++b) acc[b] = (f32x4){0.f, 0.f, 0.f, 0.f};
#pragma unroll
            for (int b = 0; b < 8; ++b)
#pragma unroll
                for (int i = 0; i < 32; ++i) acc[b] += w4[i] * tbl[b * DM + kg * 32 + i];
#pragma unroll
            for (int b = 0; b < 8; ++b) *(LAS f32x4*)(red + (kg * 8 + b) * 64 + 4 * jq) = acc[b];
            __syncthreads();
            { const int b = tid >> 6, j = tid & 63; float sum = ada_b[l * MODLD + jblk * 64 + j];
#pragma unroll 8
              for (int g8 = 0; g8 < 32; ++g8) sum += red[(g8 * 8 + b) * 64 + j];
              MOD[((size_t)l * 8 + b) * MODLD + jblk * 64 + j] = sum; }
        }
        __syncthreads();
        LAS float* scr = (LAS float*)(lds + RING_OFF + wave * 16384);
        constexpr int I_IN = 16 * (NIN / 32), I_OUT = 16 * 32, I_UP = 16 * (NUP / 32), I_DN = (DFF / 64) * 32, I_L = I_IN + I_OUT + I_UP + I_DN;
        auto mk = [&](int it) {
            TrDesc d; const int l = it / I_L; int r = it % I_L;
            if (r < I_IN) { const int nblk = NIN / 32, kb = r / nblk, nb = r % nblk, n0 = nb * 32;
                int src, nv; if (n0 < 768) { src = n0; nv = 32; } else if (n0 < 3328) { src = n0 + 16; nv = 32; } else if (n0 == 3328) { src = 768; nv = 16; } else { src = 0; nv = 0; }
                d.W = w_in + (size_t)l * DM * NIN_SRC; d.ldw = NIN_SRC; d.k0 = kb * 64; d.src = src; d.nv = nv; d.WT = WIN + (size_t)l * NIN * DM; d.K = DM; d.dst = n0; return d; }
            r -= I_IN;
            if (r < I_OUT) { const int kb = r / 32, nb = r % 32; d.W = w_out + (size_t)l * DM * DM; d.ldw = DM; d.k0 = kb * 64; d.src = nb * 32; d.nv = 32; d.WT = WOUT + (size_t)l * DM * DM; d.K = DM; d.dst = nb * 32; return d; }
            r -= I_OUT;
            if (r < I_UP) { const int nblk = NUP / 32, kb = r / nblk, nb = r % nblk, n0 = nb * 32, tile = n0 >> 8, jj = n0 & 255;
                d.W = ((jj < 128) ? ffn_wg : ffn_wu) + (size_t)l * DM * DFF; d.ldw = DFF; d.k0 = kb * 64; d.src = tile * 128 + (jj & 127); d.nv = 32; d.WT = WUP + (size_t)l * NUP * DM; d.K = DM; d.dst = n0; return d; }
            r -= I_UP;
            { const int kb = r / 32, nb = r % 32; d.W = ffn_wd + (size_t)l * DFF * DM; d.ldw = DM; d.k0 = kb * 64; d.src = nb * 32; d.nv = 32; d.WT = WDN + (size_t)l * DM * DFF; d.K = DFF; d.dst = nb * 32; return d; }
        };
        if (gw < 2 * I_L) {
            TrDesc dc = mk(gw); f32x4 vc[8]; tr_load(dc, vc, lane);
            for (int it = gw; it < 2 * I_L; it += NGW) {
                const bool more = it + NGW < 2 * I_L;
                TrDesc dn = dc; f32x4 vn[8];
                if (more) { dn = mk(it + NGW); tr_load(dn, vn, lane); }
                tr_store(dc, vc, scr, lane);
                if (more) { dc = dn;
#pragma unroll
                    for (int i = 0; i < 8; ++i) vc[i] = vn[i]; }
            }
        }
        for (int e = gw * 64 + lane; e < SEQ * 32; e += NGW * 64) { const int pos = e >> 5, i = e & 31;
            const float inv = powf(10000.0f, -(float)(2 * i) / 64.0f); const float ang = (float)pos * inv; float s, c; sincos_acc(ang, s, c);
            ROT[2 * e] = c; ROT[2 * e + 1] = s; }
    }
    GRID_BAR();
    { const unsigned m_ = MISC[11], r_ = MISC[10]; lmode = __builtin_amdgcn_readfirstlane((int)(m_ == 1u)); if (lmode) bxe = __builtin_amdgcn_readfirstlane((int)(r_ * 8u + xb_xcc_id())); }
    {
        PH_BEGIN(); const float *x = IN_PTR(0), *norm1_g = IN_PTR(4);
        {
            LAS float* shl = (LAS float*)(lds + RING_OFF);
#pragma unroll 4
            for (int q = 0; q < 16; ++q) { const int idx = tid + q * (NWAVES * 64); const int grp = idx >> 11, b = (idx >> 8) & 7, c4 = idx & 255;
                *(LAS f32x4*)(shl + (size_t)idx * 4) = *(const f32x4*)(MOD + ((size_t)(grp >> 1) * 8 + b) * MODLD + ((grp & 1) ? 3 : 0) * DM + c4 * 4); }
            unsigned long long wraw[9][4];
#pragma unroll
            for (int k = 0; k < 9; ++k) { const int r = gw + k * 2048;
                const int l = r >= (NIN + NUP) ? 1 : 0, rr = r - l * (NIN + NUP); const int kind = rr >= NIN ? 1 : 0, n = rr - kind * NIN;
                const bf16* W = kind ? (WUP + ((size_t)l * NUP + n) * DM) : (WIN + ((size_t)l * NIN + n) * DM);
#pragma unroll
                for (int j = 0; j < 4; ++j) wraw[k][j] = *(const unsigned long long*)(W + j * 256 + lane * 4); }
            asm volatile("" ::: "memory");
            __syncthreads();
            const int hi = lane >> 5, b4 = (lane >> 4) & 1, b3 = (lane >> 3) & 1;
#pragma unroll 1
            for (int k = 0; k < 9; ++k) { const int r = gw + k * 2048;
                const int l = r >= (NIN + NUP) ? 1 : 0, rr = r - l * (NIN + NUP); const int kind = rr >= NIN ? 1 : 0, n = rr - kind * NIN; const int grp = l * 2 + kind;
                float wv[16];
#pragma unroll
                for (int j = 0; j < 4; ++j) { unsigned long long w8 = 0;
#pragma unroll
                    for (int kk = 0; kk < 9; ++kk) w8 = (kk == k) ? wraw[kk][j] : w8;
                    const unsigned lo = (unsigned)w8, hi2 = (unsigned)(w8 >> 32);
                    wv[4 * j + 0] = __uint_as_float(lo << 16); wv[4 * j + 1] = __uint_as_float(lo & 0xffff0000u); wv[4 * j + 2] = __uint_as_float(hi2 << 16); wv[4 * j + 3] = __uint_as_float(hi2 & 0xffff0000u); }
                float sm[8];
#pragma unroll
                for (int b = 0; b < 8; ++b) { float a = 0.f;
#pragma unroll
                    for (int j = 0; j < 4; ++j) { const f32x4 s4 = *(const LAS f32x4*)(shl + ((size_t)(grp * 8 + b)) * 1024 + j * 256 + lane * 4);
                        a = fmaf(s4[0], wv[4 * j + 0], a); a = fmaf(s4[1], wv[4 * j + 1], a); a = fmaf(s4[2], wv[4 * j + 2], a); a = fmaf(s4[3], wv[4 * j + 3], a); }
                    sm[b] = a; }
                float u4[4], u2[2], u1;
#pragma unroll
                for (int i = 0; i < 4; ++i) { const float mine = hi ? sm[i + 4] : sm[i], send = hi ? sm[i] : sm[i + 4]; u4[i] = mine + get_x32(send, hi); }
#pragma unroll
                for (int i = 0; i < 2; ++i) { const float mine = b4 ? u4[i + 2] : u4[i], send = b4 ? u4[i] : u4[i + 2]; u2[i] = mine + shx<16>(send); }
                { const float mine = b3 ? u2[1] : u2[0], send = b3 ? u2[0] : u2[1]; u1 = mine + shx<8>(send); }
                u1 += shx<4>(u1); u1 += shx<2>(u1); u1 += shx<1>(u1);
                const int bb = hi * 4 + b4 * 2 + b3;
                float* CB = kind ? (CBUP + (size_t)l * 8 * NUP) : (CBIN + (size_t)l * 8 * NIN); const int NR = kind ? NUP : NIN;
                if ((lane & 7) == 0) CB[(size_t)bb * NR + n] = u1;
            }
            __syncthreads();
        }
        {
            f32x4 vcur[4], an[4];
            const int mb = (gw >> 8) * SEQ + (gw & 255);
            { const float* sp = MOD + (size_t)(gw >> 8) * MODLD + DM + lane * 4;
#pragma unroll
              for (int j = 0; j < 4; ++j) an[j] = *(const f32x4*)(norm1_g + j * 256 + lane * 4) * (*(const f32x4*)(sp + j * 256) + 1.0f); }
            { const GAS f32x4* xr = (const GAS f32x4*)(x + (size_t)mb * DM) + lane;
#pragma unroll
              for (int j = 0; j < 4; ++j) vcur[j] = xr[64 * j]; }
            asm volatile("" : "+v"(vcur[0]), "+v"(vcur[1]), "+v"(vcur[2]), "+v"(vcur[3]), "+v"(an[0]), "+v"(an[1]), "+v"(an[2]), "+v"(an[3]));
            for (int k = 0; k < SEQ / 256; ++k) { const int m = mb + 256 * k;
                f32x4 vnx[4]; const bool more = k + 1 < SEQ / 256;
                if (more) { const GAS f32x4* xn = (const GAS f32x4*)(x + (size_t)(m + 256) * DM) + lane;
#pragma unroll
                    for (int j = 0; j < 4; ++j) vnx[j] = xn[64 * j]; }
                asm volatile("" ::: "memory");
                float s = 0.f;
                GAS unsigned long long* o8 = (GAS unsigned long long*)(XA + (size_t)m * DM) + lane;
                GAS unsigned long long* r8 = (GAS unsigned long long*)((bf16*)out + (size_t)m * DM) + lane;
#pragma unroll
                for (int j = 0; j < 4; ++j) { const f32x4 v = vcur[j]; s += (v.x * v.x + v.y * v.y) + (v.z * v.z + v.w * v.w);
                    const f32x4 y = v * an[j]; o8[64 * j] = (unsigned long long)pk2(y.x, y.y) | ((unsigned long long)pk2(y.z, y.w) << 32);
                    r8[64 * j] = (unsigned long long)pk2(v.x, v.y) | ((unsigned long long)pk2(v.z, v.w) << 32); }
                s = wave_sum(s); if (lane == 0) SS[m] = ss_fix(s);
                if (more) {
#pragma unroll
                    for (int j = 0; j < 4; ++j) vcur[j] = vnx[j]; }
            }
        }
    }
    GRID_BAR();

    for (int l = 0; l < DEPTH; ++l) {
        {
            PH_BEGIN();
            LAS float* cbl = (LAS float*)(lds + CBL_OFF); LAS float* rsl = (LAS float*)(lds + RSL_OFF);
            const int pm0_ = 16 * (bxe & 7) + ((bxe >> 3) & 7);
            const float* cbg = CBIN + ((size_t)l * 8 + (bxe & 7)) * NIN;
            for (int i = tid; i < NIN / 4; i += NWAVES * 64) *(LAS f32x4*)(cbl + 4 * i) = *(const f32x4*)(cbg + 4 * i);
            const int pm_ = pm0_ + 8 * __builtin_amdgcn_readfirstlane(tid >> 8); rsl[tid] = row_rstd(SS + (size_t)(2 * l) * M, (size_t)pm_ * 256 + (tid & 255));
            __syncthreads();
        }
        {
            PH_BEGIN();
            pg8::Gemm g{XA, WIN + (size_t)l * NIN * DM, M, NIN, DM}; pg8::StaticOrder S; S.init(M, NIN, G, bxe);
            pg8::EpiInProj E{(LAS float*)(lds + CBL_OFF), (LAS float*)(lds + RSL_OFF), 16 * (bxe & 7) + ((bxe >> 3) & 7), ROT, ws};
            pg8::gemm_phase<pg8::EpiInProj, pg8::StaticOrder, true, true>(lds + RING_OFF, g, S, E, tid);
        }
        XCC_BAR();
#if !(MIX_GLA_V1)
        {
            PH_BEGIN(); const float *gla_wa2 = IN_PTR(7), *gla_ba = IN_PTR(8);
            float w0[16], w1[16];
#pragma unroll
            for (int r = 0; r < 16; ++r) { w0[r] = gla_wa2[((size_t)l * 16 + r) * 128 + lane]; w1[r] = gla_wa2[((size_t)l * 16 + r) * 128 + 64 + lane]; }
            const float b0 = gla_ba[l * 128 + lane], b1 = gla_ba[l * 128 + 64 + lane];
            for (int m = gw; m < M; m += NGW) {
                const float grv = GR[(size_t)m * 16 + (lane & 15)];
                float u0 = b0, u1 = b1;
#pragma unroll
                for (int r = 0; r < 16; ++r) { const float gr = rdl(grv, r); u0 = fmaf(gr, w0[r], u0); u1 = fmaf(gr, w1[r], u1); }
                const float l0 = fminf(u0, 0.f) - __logf(1.0f + __expf(-fabsf(u0))), l1 = fminf(u1, 0.f) - __logf(1.0f + __expf(-fabsf(u1)));
                GA[(size_t)m * 128 + lane] = __expf(l0 * (1.0f / 16.0f)); GA[(size_t)m * 128 + 64 + lane] = __expf(l1 * (1.0f / 16.0f));
            }
        }
        GRID_BAR();
#endif
#if MIX_GLA_V1 || MIX_RET_V1 || MIX_SB_V1
        {
            const int ord = wave_k >> 2;
#pragma unroll 1
            for (int step = 0; step < 3; ++step) {
                const int which = ord ? (step == 0 ? 2 : step - 1) : step;
                if (which == 0) { PH_BEGIN(); const float *gla_wa2 = IN_PTR(7), *gla_ba = IN_PTR(8); LAS unsigned char* wlds = lds + RING_OFF + wave * 16384;
                    for (int ch = gw; ch < 2048; ch += NGW) chunk_sum_unit<32, true>(ch, GQ, GK, GV, GR, gla_wa2 + (size_t)l * 16 * 128, gla_ba + l * 128, (float*)(ws + WS_KVTG), (float*)(ws + WS_DEC), wlds, lane_now()); }
                else if (which == 1) { PH_BEGIN(); LAS unsigned char* wlds = lds + RING_OFF + wave * 16384;
                    for (int ch = gw; ch < 2048; ch += NGW) chunk_sum_unit<64, false>(ch, RQ, RK, RV, nullptr, nullptr, nullptr, (float*)(ws + WS_KVTR), nullptr, wlds, lane_now()); }
                else { PH_BEGIN(); LAS unsigned char* wlds = lds + RING_OFF + wave * 16384;
                    { const int g_ = gw >> 8, u_ = gw & 255; sb_unit_v1(((g_ * 8 + (u_ >> 6)) << 6) | (u_ & 63), SQ, SK, SV, OM, wlds, lane_now()); } }
            }
        }
        XCC_BAR();
        {
            const int ord = wave_k >> 2;
#pragma unroll 1
            for (int step = 0; step < 2; ++step) {
                if ((ord ? 1 - step : step) == 0) { PH_BEGIN();
                    const int g_ = gw >> 8, u_ = gw & 255;
                    if (u_ < 64) scan_unit<32, true>(g_ * 4 + (u_ >> 4), u_ & 15, (const float*)(ws + WS_KVTG), (const float*)(ws + WS_DEC), (bf16*)(ws + WS_STG), lane);
                    else if (u_ < 192) scan_unit<64, false>(g_ * 4 + ((u_ - 64) >> 5), (u_ - 64) & 31, (const float*)(ws + WS_KVTR), nullptr, (bf16*)(ws + WS_STR), lane);
                } else { PH_BEGIN(); LAS unsigned char* wlds = lds + RING_OFF + wave * 16384;
                    { const int g_ = gw >> 8, u_ = gw & 255; sb_unit_v1(((g_ * 8 + 4 + (u_ >> 6)) << 6) | (u_ & 63), SQ, SK, SV, OM, wlds, lane_now()); } }
            }
        }
        XCC_BAR();
#endif
        {
            PH_BEGIN(); const float *gla_norm_g = IN_PTR(9), *ret_norm_g = IN_PTR(10);
            LAS unsigned char* wlds = lds + RING_OFF + wave * 16384; (void)wlds;
#if MIX_GLA_V1
            for (int ch = gw; ch < 2048; ch += NGW) chunk_out_unit<32>(ch, GQ, GK, GV, GG, (const bf16*)(ws + WS_STG), gla_norm_g + l * 64, OM, 0, wlds, (LAS float*)(lds + LDSCTL_OFF + 4096 + wave * 256), lane_now());
#else
            if (wave == 0 && vcu < 32) seq_recurrent_v0<32, true>(GQ, GK, GV, GG, GA, gla_norm_g + l * 64, OM, vcu >> 2, vcu & 3, lane, 0);
#endif
#if MIX_RET_V1
            for (int ch = gw; ch < 2048; ch += NGW) chunk_out_unit<64>(ch, RQ, RK, RV, RG, (const bf16*)(ws + WS_STR), ret_norm_g + l * 64, OM, 256, wlds, (LAS float*)(lds + LDSCTL_OFF + 4096 + wave * 256), lane_now());
#else
            if (wave == 0 && vcu >= 32 && vcu < 64) seq_recurrent_v0<64, false>(RQ, RK, RV, RG, nullptr, ret_norm_g + l * 64, OM, (vcu - 32) >> 2, (vcu - 32) & 3, lane, 256);
#endif
#if !(MIX_SB_V1)
            for (int unit = gw; unit < 4096; unit += NGW) sb_unit_v0(SQ, SK, SV, OM, unit, lane);
#endif
        }
        XCC_BAR();
#if PROBE_ON && PROBE_DUP3C
        {
            PH_BEGIN(); const float *gla_norm_g = IN_PTR(9), *ret_norm_g = IN_PTR(10);
            LAS unsigned char* wlds = lds + RING_OFF + wave * 16384; (void)wlds;
#if MIX_GLA_V1
            for (int ch = gw; ch < 2048; ch += NGW) chunk_out_unit<32>(ch, GQ, GK, GV, GG, (const bf16*)(ws + WS_STG), gla_norm_g + l * 64, OM, 0, wlds, (LAS float*)(lds + LDSCTL_OFF + 4096 + wave * 256), lane_now());
#else
            if (wave == 0 && vcu < 32) seq_recurrent_v0<32, true>(GQ, GK, GV, GG, GA, gla_norm_g + l * 64, OM, vcu >> 2, vcu & 3, lane, 0);
#endif
#if MIX_RET_V1
            for (int ch = gw; ch < 2048; ch += NGW) chunk_out_unit<64>(ch, RQ, RK, RV, RG, (const bf16*)(ws + WS_STR), ret_norm_g + l * 64, OM, 256, wlds, (LAS float*)(lds + LDSCTL_OFF + 4096 + wave * 256), lane_now());
#else
            if (wave == 0 && vcu >= 32 && vcu < 64) seq_recurrent_v0<64, false>(RQ, RK, RV, RG, nullptr, ret_norm_g + l * 64, OM, (vcu - 32) >> 2, (vcu - 32) & 3, lane, 256);
#endif
#if !(MIX_SB_V1)
            for (int unit = gw; unit < 4096; unit += NGW) sb_unit_v0(SQ, SK, SV, OM, unit, lane);
#endif
        }
        GRID_BAR();
#endif
        {
            PH_BEGIN(); const float *norm2_g = IN_PTR(5); const float* MODB = MOD + ((size_t)l * 8 + (bxe & 7)) * MODLD;
            { LAS float* gl_ = (LAS float*)(lds + CBL_OFF); LAS float* al_ = gl_ + DM;
              for (int i = tid; i < DM / 4; i += NWAVES * 64) { *(LAS f32x4*)(gl_ + 4 * i) = *(const f32x4*)(MODB + 2 * DM + 4 * i);
                  *(LAS f32x4*)(al_ + 4 * i) = *(const f32x4*)(norm2_g + l * DM + 4 * i) * (*(const f32x4*)(MODB + 4 * DM + 4 * i) + 1.0f); }
              __syncthreads(); }
            pg8::Gemm g{OM, WOUT + (size_t)l * DM * DM, M, DM, DM}; pg8::StaticOrder S; S.init(M, DM, G, bxe);
            bf16* XR = (bf16*)out;
            pg8::EpiResid E{XR, XR, (LAS float*)(lds + CBL_OFF), (LAS float*)(lds + CBL_OFF) + DM, XA, SS + (size_t)(2 * l + 1) * M, 1};
            pg8::gemm_phase<pg8::EpiResid, pg8::StaticOrder, true, true>(lds + RING_OFF, g, S, E, tid);
        }
        XCC_BAR();
#if PROBE_ON && PROBE_NULLEPI
        if (l == 0) {
            PH_BEGIN();
            pg8::Gemm g{XA, WUP + (size_t)l * NUP * DM, M, NUP, DM}; pg8::StaticOrder S; S.init(M, NUP, G, bxe);
            pg8::EpiNull E{(float*)(ws + WS_OM)};
            pg8::gemm_phase<pg8::EpiNull, pg8::StaticOrder, true, true>(lds + RING_OFF, g, S, E, tid);
            GRID_BAR();
        }
#endif
        {
            PH_BEGIN();
            LAS float* cbl = (LAS float*)(lds + CBL_OFF); LAS float* rsl = (LAS float*)(lds + RSL_OFF);
            const int pm0_ = 16 * (bxe & 7) + ((bxe >> 3) & 7);
            const float* cbg = CBUP + ((size_t)l * 8 + (bxe & 7)) * NUP;
            for (int i = tid; i < NUP / 4; i += NWAVES * 64) *(LAS f32x4*)(cbl + 4 * i) = *(const f32x4*)(cbg + 4 * i);
            const int pm_ = pm0_ + 8 * __builtin_amdgcn_readfirstlane(tid >> 8); rsl[tid] = row_rstd(SS + (size_t)(2 * l + 1) * M, (size_t)pm_ * 256 + (tid & 255));
            __syncthreads();
        }
        {
            PH_BEGIN();
            pg8::Gemm g{XA, WUP + (size_t)l * NUP * DM, M, NUP, DM}; pg8::StaticOrder S; S.init(M, NUP, G, bxe);
            pg8::EpiFfnUp E{(LAS float*)(lds + CBL_OFF), (LAS float*)(lds + RSL_OFF), 16 * (bxe & 7) + ((bxe >> 3) & 7), HB};
            pg8::gemm_phase<pg8::EpiFfnUp, pg8::StaticOrder, true, true>(lds + RING_OFF, g, S, E, tid);
        }
        XCC_BAR();
        {
            PH_BEGIN(); const float *norm1_g = IN_PTR(4); const float* MODB = MOD + ((size_t)l * 8 + (bxe & 7)) * MODLD;
            const int nl = (l + 1 < DEPTH) ? l + 1 : l;
            { LAS float* gl_ = (LAS float*)(lds + CBL_OFF); LAS float* al_ = gl_ + DM; const float* MODN = MOD + ((size_t)nl * 8 + (bxe & 7)) * MODLD;
              for (int i = tid; i < DM / 4; i += NWAVES * 64) { *(LAS f32x4*)(gl_ + 4 * i) = *(const f32x4*)(MODB + 5 * DM + 4 * i);
                  *(LAS f32x4*)(al_ + 4 * i) = *(const f32x4*)(norm1_g + nl * DM + 4 * i) * (*(const f32x4*)(MODN + 1 * DM + 4 * i) + 1.0f); }
              __syncthreads(); }
            pg8::Gemm g{HB, WDN + (size_t)l * DM * DFF, M, DM, DFF, PBS - (size_t)SEQ * DFF * 2}; pg8::StaticOrder S; S.init(M, DM, G, bxe);
            bf16* XR = (bf16*)out;
            pg8::EpiResid E{XR, (l + 1 < DEPTH) ? XR : XA, (LAS float*)(lds + CBL_OFF), (LAS float*)(lds + CBL_OFF) + DM, XA, SS + (size_t)(2 * l + 2) * M, (l + 1 < DEPTH) ? 1 : 0};
            pg8::gemm_phase<pg8::EpiResid, pg8::StaticOrder, true, true>(lds + RING_OFF, g, S, E, tid);
        }
        if (l + 1 < DEPTH) XCC_BAR(); else GRID_BAR();
    }
    {
        PH_BEGIN(); const float* final_g = IN_PTR(15);
        const unsigned long long* ssf = SS + (size_t)(2 * DEPTH) * M;
        f32x4 fg[4];
#pragma unroll
        for (int j = 0; j < 4; ++j) fg[j] = *(const f32x4*)(final_g + j * 256 + lane * 4);
        unsigned long long wcur[4], qcur;
        const int mb = (gw >> 8) * SEQ + (gw & 255);
        { const GAS unsigned long long* xr = (const GAS unsigned long long*)(XA + (size_t)mb * DM) + lane; qcur = ssf[mb];
#pragma unroll
          for (int j = 0; j < 4; ++j) wcur[j] = xr[64 * j]; }
        asm volatile("" : "+v"(wcur[0]), "+v"(wcur[1]), "+v"(wcur[2]), "+v"(wcur[3]), "+v"(qcur), "+v"(fg[0]), "+v"(fg[1]), "+v"(fg[2]), "+v"(fg[3]));
        for (int k = 0; k < SEQ / 256; ++k) { const int m = mb + 256 * k;
            unsigned long long wnx[4], qnx = 0; const bool more = k + 1 < SEQ / 256;
            if (more) { const GAS unsigned long long* xn = (const GAS unsigned long long*)(XA + (size_t)(m + 256) * DM) + lane; qnx = ssf[m + 256];
#pragma unroll
                for (int j = 0; j < 4; ++j) wnx[j] = xn[64 * j]; }
            asm volatile("" ::: "memory");
            const float r = rstd_of(qcur);
            GAS f32x4* orow = (GAS f32x4*)(out + (size_t)m * DM) + lane;
#pragma unroll
            for (int j = 0; j < 4; ++j) { const unsigned long long w = wcur[j]; const unsigned lo = (unsigned)w, hi2 = (unsigned)(w >> 32);
                const f32x4 v = {__uint_as_float(lo << 16), __uint_as_float(lo & 0xffff0000u), __uint_as_float(hi2 << 16), __uint_as_float(hi2 & 0xffff0000u)};
                orow[64 * j] = v * r * fg[j]; }
            if (more) { qcur = qnx;
#pragma unroll
                for (int j = 0; j < 4; ++j) wcur[j] = wnx[j]; }
        }
    }

#if PROBE_ON
    STAMP();
    if (blockIdx.x == 0 && TID_NOW() == 0) {
        volatile LAS unsigned long long* st_ = (volatile LAS unsigned long long*)(lds + LDSCTL_OFF + 1024);
        const unsigned long long d1 = st_[PROBE_I1B] - st_[PROBE_I1A], d2 = st_[PROBE_I2B] - st_[PROBE_I2A];
        unsigned long long q1 = (d1 + 400) / 800, q2 = (d2 + 400) / 800; if (q1 > 63) q1 = 63; if (q2 > 63) q2 = 63;
        const unsigned long long spin = (q1 + 64 * q2) * 1200ull, t0_ = __builtin_amdgcn_s_memrealtime();
        while (__builtin_amdgcn_s_memrealtime() - t0_ < spin) __builtin_amdgcn_s_sleep(8);
    }
#endif
}

extern "C" void kernel_launch(void* const* d_in, const int* in_sizes, int n_in, void* d_out, int out_size, void* d_ws, size_t ws_size, hipStream_t stream) {
    static int grid = 0;
    if (grid == 0) {
        if (n_in != 16 || in_sizes[0] != M * DM || out_size != M * DM || ws_size < WS_END) { fprintf(stderr, "kernel_launch: unexpected shapes (n_in %d, in0 %d, out %d, ws %zu); nothing launched\n", n_in, n_in > 0 ? in_sizes[0] : -1, out_size, ws_size); grid = -1; return; }
        int dev = 0, cus = 0, per_cu = 0;
        if (hipGetDevice(&dev) != hipSuccess || hipDeviceGetAttribute(&cus, hipDeviceAttributeMultiprocessorCount, dev) != hipSuccess) { grid = -1; return; }
        if (hipFuncSetAttribute((const void*)mk_fwd, hipFuncAttributeMaxDynamicSharedMemorySize, LDS_BYTES) != hipSuccess) { fprintf(stderr, "kernel_launch: hipFuncSetAttribute failed\n"); grid = -1; return; }
        if (hipOccupancyMaxActiveBlocksPerMultiprocessor(&per_cu, (const void*)mk_fwd, NWAVES * 64, LDS_BYTES) != hipSuccess || per_cu < 1) fprintf(stderr, "kernel_launch: note: occupancy query reports %d\n", per_cu);
        (void)hipGetLastError();
        if (cus != 256) { fprintf(stderr, "kernel_launch: built for a 256-CU device, found %d CUs; nothing launched\n", cus); grid = -1; return; }
        grid = cus;
    }
    if (grid < 0) return;
    if (hipMemsetAsync((char*)d_ws + WS_CTL, 0, CTL_ZERO_BYTES, stream) != hipSuccess) { fprintf(stderr, "kernel_launch: memset failed\n"); return; }
    Args a{};
    for (int i = 0; i < 16; ++i) a.in[i] = (const float*)d_in[i];
    a.out = (float*)d_out; a.ws = (unsigned char*)d_ws; a.ph_lo = 0; a.ph_hi = 99;
    hipLaunchKernelGGL(mk_fwd, dim3(grid), dim3(NWAVES * 64), LDS_BYTES, stream, a);
}
```
